# Optimizing an MI355X kernel written in HIP

```python
import math
import jax
import jax.numpy as jnp
from jax import lax
import numpy as np

D_MODEL = 1024
BATCH = 8
SEQ = 4096
DEPTH = 2

GRID_W = 64
CTX_LEN = 256
N_MOD = 6
HEAD_DIM = 64
N_HEADS_A = 8
KV_HEADS_A = 2
WINDOW = 128
ATTN_BLOCK = 128
N_HEADS_B = 4
N_HEADS_C = 4
HEAD_DIM_C = 128
MLSTM_CHUNK = 128
N_BRANCHES = 3
A_Q = N_HEADS_A * HEAD_DIM
A_KV = KV_HEADS_A * HEAD_DIM
B_QK = N_HEADS_B * 2 * HEAD_DIM
B_V = N_HEADS_B * 2 * HEAD_DIM
C_WIDTH = N_HEADS_C * HEAD_DIM_C
C_GATES = 4 * N_HEADS_C
SPLIT_SIZES = (A_Q, A_KV, A_KV, B_QK, B_QK, B_V, C_WIDTH, C_WIDTH, C_WIDTH, C_WIDTH, C_GATES, N_BRANCHES * D_MODEL)
N_IN = sum(SPLIT_SIZES)
N_EXPERTS = 64
N_GROUPS = 8
TOPK_GROUPS = 4
TOP_K = 8
D_EXPERT = 256
D_SHARED = 256
ROUTED_SCALE = 2.5
EXPERT_BLOCK = 128
ROPE_BASE = 10000.0
EPS = 1e-6

kernel_name = "hybrid_diffusion_mixer_moe_block"


def rms_norm(x, g):
    xf = x.astype(jnp.float32)
    y = xf * lax.rsqrt(jnp.mean(xf * xf, axis=-1, keepdims=True) + EPS)
    return (y * g.astype(jnp.float32)).astype(x.dtype)


def modulate(h, shift, scale):
    return h * (1 + scale) + shift


def to_heads(a, n_heads):
    return a.reshape(*a.shape[:-1], n_heads, a.shape[-1] // n_heads)


def from_heads(a):
    return a.reshape(*a.shape[:-2], a.shape[-2] * a.shape[-1])


def split_proj(p):
    parts, start = [], 0
    for size in SPLIT_SIZES:
        parts.append(p[..., start:start + size])
        start += size
    return parts


def diff_pair(a):
    a = a.reshape(*a.shape[:-2], a.shape[-2] // 2, 2, a.shape[-1])
    return a[..., 0, :], a[..., 1, :]


def axial_rope_tables(row, col):
    quarter = HEAD_DIM // 4
    inv = 1.0 / (ROPE_BASE ** (jnp.arange(quarter, dtype=jnp.float32) / quarter))
    ang = jnp.stack([row.astype(jnp.float32)[:, None] * inv, col.astype(jnp.float32)[:, None] * inv], axis=1)
    return jnp.cos(ang), jnp.sin(ang)


def apply_rope(x, cos, sin):
    b, n, h, dh = x.shape
    q = dh // 4
    xr = x.astype(jnp.float32).reshape(b, n, h, 2, 2, q)
    a, bb = xr[..., 0, :], xr[..., 1, :]
    cs, sn = cos[None, :, None], sin[None, :, None]
    out = jnp.stack([a * cs - bb * sn, bb * cs + a * sn], axis=-2)
    return out.reshape(b, n, h, dh).astype(x.dtype)


def softmax_with_sink(s, sink):
    m = jnp.maximum(jnp.max(s, axis=-1, keepdims=True), sink)
    p = jnp.exp(s - m)
    return p / (jnp.sum(p, axis=-1, keepdims=True) + jnp.exp(sink - m))


def window_sink_attention(q, k, v, kc, vc, sink):
    b, s_len, h, dh = q.shape
    g = h // KV_HEADS_A
    nb = s_len // ATTN_BLOCK
    scale = dh ** -0.5
    pad = ((0, 0), (ATTN_BLOCK, ATTN_BLOCK), (0, 0), (0, 0))
    kp, vp = jnp.pad(k, pad), jnp.pad(v, pad)
    qb = q.reshape(b, nb, ATTN_BLOCK, KV_HEADS_A, g, dh).swapaxes(0, 1)
    sk = sink.astype(jnp.float32).reshape(KV_HEADS_A, g)[:, :, None, None]
    offs_q = jnp.arange(ATTN_BLOCK)
    offs_k = jnp.arange(3 * ATTN_BLOCK) - ATTN_BLOCK
    band = jnp.abs(offs_q[:, None] - offs_k[None, :]) <= WINDOW

    def one_block(args):
        qi, bi = args
        start = bi * ATTN_BLOCK
        kb = lax.dynamic_slice_in_dim(kp, start, 3 * ATTN_BLOCK, axis=1)
        vb = lax.dynamic_slice_in_dim(vp, start, 3 * ATTN_BLOCK, axis=1)
        kpos = start + offs_k
        valid = band & ((kpos >= 0) & (kpos < s_len))[None, :]
        s_lat = jnp.einsum('bqkgd,bskd->bkgqs', qi, kb).astype(jnp.float32) * scale
        s_lat = jnp.where(valid, s_lat, -jnp.inf)
        s_ctx = jnp.einsum('bqkgd,bckd->bkgqc', qi, kc).astype(jnp.float32) * scale
        p = softmax_with_sink(jnp.concatenate([s_lat, s_ctx], axis=-1), sk).astype(v.dtype)
        return (jnp.einsum('bkgqs,bskd->bqkgd', p[..., :3 * ATTN_BLOCK], vb)
                + jnp.einsum('bkgqc,bckd->bqkgd', p[..., 3 * ATTN_BLOCK:], vc))

    out = lax.map(one_block, (qb, jnp.arange(nb)))
    return out.swapaxes(0, 1).reshape(b, s_len, h, dh)


def ctx_sink_attention(q, k, v, sink):
    b, n, h, dh = q.shape
    g = h // KV_HEADS_A
    s = jnp.einsum('bqkgd,bckd->bkgqc', q.reshape(b, n, KV_HEADS_A, g, dh), k).astype(jnp.float32) * dh ** -0.5
    p = softmax_with_sink(s, sink.astype(jnp.float32).reshape(KV_HEADS_A, g)[:, :, None, None]).astype(v.dtype)
    return jnp.einsum('bkgqc,bckd->bqkgd', p, v).reshape(b, n, h, dh)


def diff_attend(q1, q2, k1, k2, v, lam):
    b, sq, h, dh = q1.shape
    nb = sq // ATTN_BLOCK
    scale = dh ** -0.5

    def blocks(a):
        return a.reshape(b, nb, ATTN_BLOCK, h, dh).swapaxes(0, 1)

    def one_block(args):
        a1, a2 = args
        p1 = jax.nn.softmax(jnp.einsum('bqhd,bkhd->bhqk', a1, k1).astype(jnp.float32) * scale, axis=-1)
        p2 = jax.nn.softmax(jnp.einsum('bqhd,bkhd->bhqk', a2, k2).astype(jnp.float32) * scale, axis=-1)
        att = (p1 - lam * p2).astype(v.dtype)
        return jnp.einsum('bhqk,bkhe->bqhe', att, v)

    out = lax.map(one_block, (blocks(q1), blocks(q2)))
    return out.swapaxes(0, 1).reshape(b, sq, h, v.shape[-1])


def mlstm_scan(q, k, v, log_i, log_f, state):
    b, n_tok, h, _ = q.shape
    dv = v.shape[-1]
    t = MLSTM_CHUNK
    nc = n_tok // t

    def chunks(a):
        a = jnp.moveaxis(a, 2, 1)
        a = a.reshape(b, h, nc, t, *a.shape[3:])
        return jnp.moveaxis(a, 2, 0)

    tril = jnp.tril(jnp.ones((t, t), dtype=bool))

    def step(carry, inp):
        c_st, n_st, m_st = carry
        qc, kc, vc, ic, fc = inp
        bcum = jnp.cumsum(fc, axis=-1)
        dmat = jnp.where(tril, bcum[..., :, None] - bcum[..., None, :] + ic[..., None, :], -jnp.inf)
        inter = bcum + m_st[..., None]
        m_t = jnp.maximum(inter, jnp.max(dmat, axis=-1))
        s = jnp.einsum('bhtd,bhsd->bhts', qc, kc) * jnp.exp(dmat - m_t[..., None])
        a_inter = jnp.exp(inter - m_t)
        num = jnp.einsum('bhts,bhse->bhte', s, vc) + a_inter[..., None] * jnp.einsum('bhtd,bhde->bhte', qc, c_st)
        den = jnp.sum(s, axis=-1) + a_inter * jnp.einsum('bhtd,bhd->bht', qc, n_st)
        h_out = num / jnp.maximum(jnp.abs(den), jnp.exp(-m_t))[..., None]
        b_last = bcum[..., -1]
        gsum = b_last[..., None] - bcum + ic
        m_new = jnp.maximum(b_last + m_st, jnp.max(gsum, axis=-1))
        decay = jnp.exp(b_last + m_st - m_new)
        wk = jnp.exp(gsum - m_new[..., None])[..., None] * kc
        c_new = decay[..., None, None] * c_st + jnp.einsum('bhtd,bhte->bhde', wk, vc)
        n_new = decay[..., None] * n_st + jnp.sum(wk, axis=-2)
        return (c_new, n_new, m_new), h_out

    state, hs = lax.scan(step, state, (chunks(q), chunks(k), chunks(v), chunks(log_i), chunks(log_f)))
    hs = jnp.moveaxis(hs, 0, 2).reshape(b, h, n_tok, dv)
    return jnp.moveaxis(hs, 1, 2), state


def mlstm_inputs(q, k, v, g, b_gate):
    gates = g.reshape(*g.shape[:-1], 4, N_HEADS_C).astype(jnp.float32) + b_gate.astype(jnp.float32)
    return (to_heads(q, N_HEADS_C).astype(jnp.float32),
            to_heads(k, N_HEADS_C).astype(jnp.float32) * HEAD_DIM_C ** -0.5,
            to_heads(v, N_HEADS_C).astype(jnp.float32), gates)


def bidir_mlstm(q, k, v, gates, qc, kc, vc, gates_c):
    b, _, h, dk = q.shape
    dv = v.shape[-1]
    zero = (jnp.zeros((b, h, dk, dv), jnp.float32), jnp.zeros((b, h, dk), jnp.float32), jnp.zeros((b, h), jnp.float32))
    flip = lambda a: jnp.flip(a, axis=1)
    logsig = jax.nn.log_sigmoid
    hc_f, st_f = mlstm_scan(qc, kc, vc, gates_c[..., 0, :], logsig(gates_c[..., 1, :]), zero)
    hl_f, _ = mlstm_scan(q, k, v, gates[..., 0, :], logsig(gates[..., 1, :]), st_f)
    hc_b, st_b = mlstm_scan(flip(qc), flip(kc), flip(vc), flip(gates_c[..., 2, :]), flip(logsig(gates_c[..., 3, :])), zero)
    hl_b, _ = mlstm_scan(flip(q), flip(k), flip(v), flip(gates[..., 2, :]), flip(logsig(gates[..., 3, :])), st_b)
    return hl_f + flip(hl_b), hc_f + flip(hc_b)


def token_mixers(hl, hc, cos, sin, lam_init, need_ctx, w_in, b_gate, sink, lam_q1, lam_k1,
                 lam_q2, lam_k2, g_diff, g_mlstm, w_a, w_b, w_c, w_out):
    (aq, ak, av, bq, bk, bv, cq, ck, cv, co, cg, gt) = split_proj(hl @ w_in)
    (aq_c, ak_c, av_c, bq_c, bk_c, bv_c, cq_c, ck_c, cv_c, co_c, cg_c, gt_c) = split_proj(hc @ w_in)
    f32 = jnp.float32

    ka_c, va_c = to_heads(ak_c, KV_HEADS_A), to_heads(av_c, KV_HEADS_A)
    oa = window_sink_attention(apply_rope(to_heads(aq, N_HEADS_A), cos, sin),
                               apply_rope(to_heads(ak, KV_HEADS_A), cos, sin),
                               to_heads(av, KV_HEADS_A), ka_c, va_c, sink)

    lam = (jnp.exp(jnp.sum(lam_q1.astype(f32) * lam_k1.astype(f32)))
           - jnp.exp(jnp.sum(lam_q2.astype(f32) * lam_k2.astype(f32))) + lam_init)
    q1, q2 = diff_pair(apply_rope(to_heads(bq, 2 * N_HEADS_B), cos, sin))
    k1, k2 = diff_pair(apply_rope(to_heads(bk, 2 * N_HEADS_B), cos, sin))
    k1_c, k2_c = diff_pair(to_heads(bk_c, 2 * N_HEADS_B))
    vb_c = to_heads(bv_c, N_HEADS_B)
    ob = diff_attend(q1, q2, jnp.concatenate([k1, k1_c], axis=1), jnp.concatenate([k2, k2_c], axis=1),
                     jnp.concatenate([to_heads(bv, N_HEADS_B), vb_c], axis=1), lam)

    h_lat, h_ctx = bidir_mlstm(*mlstm_inputs(cq, ck, cv, cg, b_gate), *mlstm_inputs(cq_c, ck_c, cv_c, cg_c, b_gate))

    def diff_out(o):
        return from_heads(rms_norm(o, g_diff) * (1.0 - lam_init))

    def mlstm_out(hh, o):
        normed = rms_norm(hh, g_mlstm.reshape(N_HEADS_C, HEAD_DIM_C))
        return from_heads(normed * jax.nn.sigmoid(to_heads(o, N_HEADS_C).astype(f32))).astype(o.dtype)

    def merge(oa_, ob_, oc_, gt_):
        g = jax.nn.sigmoid(gt_.reshape(*gt_.shape[:-1], N_BRANCHES, D_MODEL))
        y = (g[..., 0, :] * (from_heads(oa_) @ w_a) + g[..., 1, :] * (diff_out(ob_) @ w_b)
             + g[..., 2, :] * (oc_ @ w_c))
        return y @ w_out

    out_l = merge(oa, ob, mlstm_out(h_lat, co), gt)
    if not need_ctx:
        return out_l, None
    oa_c = ctx_sink_attention(to_heads(aq_c, N_HEADS_A), ka_c, va_c, sink)
    q1_c, q2_c = diff_pair(to_heads(bq_c, 2 * N_HEADS_B))
    ob_c = diff_attend(q1_c, q2_c, k1_c, k2_c, vb_c, lam)
    out_c = merge(oa_c, ob_c, mlstm_out(h_ctx, co_c), gt_c)
    return out_l, out_c


def swiglu(h, wg, wu, wd):
    return (jax.nn.silu(h @ wg) * (h @ wu)) @ wd


def route(h, w_router, b_router):
    s = jax.nn.sigmoid((h @ w_router).astype(jnp.float32))
    sel = s + b_router.astype(jnp.float32)
    per = N_EXPERTS // N_GROUPS
    grp = sel.reshape(*sel.shape[:-1], N_GROUPS, per)
    grp_score = jnp.sum(lax.top_k(grp, 2)[0], axis=-1)
    top_g = lax.top_k(grp_score, TOPK_GROUPS)[1]
    g_mask = jnp.sum(jax.nn.one_hot(top_g, N_GROUPS, dtype=jnp.float32), axis=-2)
    e_mask = jnp.repeat(g_mask, per, axis=-1) > 0
    idx = lax.top_k(jnp.where(e_mask, sel, -jnp.inf), TOP_K)[1]
    w = jnp.take_along_axis(s, idx, axis=-1)
    w = w / jnp.sum(w, axis=-1, keepdims=True) * ROUTED_SCALE
    return idx, w.astype(h.dtype)


def grouped_experts(hs, idx, wts, w_eg, w_eu, w_ed):
    n_tok, d = hs.shape
    n_assign = n_tok * TOP_K
    flat_e = idx.reshape(n_assign)
    order = jnp.argsort(flat_e)
    sorted_e = flat_e[order]
    tok = order // TOP_K
    counts = jnp.bincount(flat_e, length=N_EXPERTS)
    padded = (counts + EXPERT_BLOCK - 1) // EXPERT_BLOCK * EXPERT_BLOCK
    pad_end = jnp.cumsum(padded)
    pad_start = pad_end - padded
    grp_start = jnp.cumsum(counts) - counts
    dest = pad_start[sorted_e] + jnp.arange(n_assign) - grp_start[sorted_e]
    n_blocks = -(-n_assign // EXPERT_BLOCK) + N_EXPERTS
    rows = jnp.full((n_blocks * EXPERT_BLOCK,), n_tok, dtype=jnp.int32).at[dest].set(tok)
    block_e = jnp.minimum(jnp.searchsorted(pad_end, jnp.arange(n_blocks) * EXPERT_BLOCK, side='right'), N_EXPERTS - 1)
    xs = jnp.concatenate([hs, jnp.zeros((1, d), hs.dtype)], axis=0)[rows].reshape(n_blocks, EXPERT_BLOCK, d)

    def run_block(args):
        xb, e = args
        return swiglu(xb, w_eg[e], w_eu[e], w_ed[e])

    ys = lax.map(run_block, (xs, block_e)).reshape(n_blocks * EXPERT_BLOCK, d)
    contrib = ys[dest] * wts.reshape(n_assign)[order][:, None]
    return jnp.zeros((n_tok, d), ys.dtype).at[tok].add(contrib)


def moe_ffn(h, w_router, b_router, w_eg, w_eu, w_ed, w_sg, w_su, w_sd):
    idx, wts = route(h, w_router, b_router)
    routed = lax.map(lambda a: grouped_experts(a[0], a[1], a[2], w_eg, w_eu, w_ed), (h, idx, wts))
    return routed + swiglu(h, w_sg, w_su, w_sd)


def setup_inputs(seed: int = 0) -> dict:
    key = jax.random.key(seed)
    ks = jax.random.split(key, 32)
    f32 = jnp.float32
    d = D_MODEL

    def nrm(k, shape, scale):
        return jax.random.normal(k, shape, f32) * scale

    b_i = nrm(ks[9], (DEPTH, 2, N_HEADS_C), 0.1)
    b_f = 3.0 + 3.0 * jax.random.uniform(ks[10], (DEPTH, 2, N_HEADS_C), f32)
    return {
        'x': nrm(ks[0], (BATCH, SEQ, d), 1.0),
        'c': nrm(ks[1], (BATCH, d), 1.0),
        'ctx': nrm(ks[2], (BATCH, CTX_LEN, d), 1.0),
        'c_ctx': nrm(ks[3], (d,), 1.0),
        'w_mod': nrm(ks[4], (DEPTH, d, N_MOD * d), 0.5 * d ** -0.5),
        'b_mod': nrm(ks[5], (DEPTH, N_MOD * d), 0.02),
        'g_mix': 1.0 + nrm(ks[6], (DEPTH, d), 0.05),
        'g_ffn': 1.0 + nrm(ks[7], (DEPTH, d), 0.05),
        'w_in': nrm(ks[8], (DEPTH, d, N_IN), d ** -0.5),
        'b_gate': jnp.stack([b_i[:, 0], b_f[:, 0], b_i[:, 1], b_f[:, 1]], axis=1),
        'sink': nrm(ks[11], (DEPTH, N_HEADS_A), 0.5),
        'lam_q1': nrm(ks[12], (DEPTH, HEAD_DIM), 0.1),
        'lam_k1': nrm(ks[13], (DEPTH, HEAD_DIM), 0.1),
        'lam_q2': nrm(ks[14], (DEPTH, HEAD_DIM), 0.1),
        'lam_k2': nrm(ks[15], (DEPTH, HEAD_DIM), 0.1),
        'g_diff': 1.0 + nrm(ks[16], (DEPTH, 2 * HEAD_DIM), 0.05),
        'g_mlstm': 1.0 + nrm(ks[17], (DEPTH, C_WIDTH), 0.05),
        'w_a': nrm(ks[18], (DEPTH, A_Q, d), A_Q ** -0.5),
        'w_b': nrm(ks[19], (DEPTH, B_V, d), B_V ** -0.5),
        'w_c': nrm(ks[20], (DEPTH, C_WIDTH, d), C_WIDTH ** -0.5),
        'w_out': nrm(ks[21], (DEPTH, d, d), d ** -0.5),
        'w_router': nrm(ks[22], (DEPTH, d, N_EXPERTS), d ** -0.5),
        'b_router': nrm(ks[23], (DEPTH, N_EXPERTS), 0.01),
        'w_exp_gate': nrm(ks[24], (DEPTH, N_EXPERTS, d, D_EXPERT), d ** -0.5),
        'w_exp_up': nrm(ks[25], (DEPTH, N_EXPERTS, d, D_EXPERT), d ** -0.5),
        'w_exp_down': nrm(ks[26], (DEPTH, N_EXPERTS, D_EXPERT, d), D_EXPERT ** -0.5),
        'w_sh_gate': nrm(ks[27], (DEPTH, d, D_SHARED), d ** -0.5),
        'w_sh_up': nrm(ks[28], (DEPTH, d, D_SHARED), d ** -0.5),
        'w_sh_down': nrm(ks[29], (DEPTH, D_SHARED, d), D_SHARED ** -0.5),
        'g_final': 1.0 + nrm(ks[30], (d,), 0.05),
    }


def reference(x, c, ctx, c_ctx, w_mod, b_mod, g_mix, g_ffn, w_in, b_gate, sink, lam_q1, lam_k1,
              lam_q2, lam_k2, g_diff, g_mlstm, w_a, w_b, w_c, w_out, w_router, b_router,
              w_exp_gate, w_exp_up, w_exp_down, w_sh_gate, w_sh_up, w_sh_down, g_final):
    b, s_len, d = x.shape
    ctx_len = ctx.shape[1]
    rows = s_len // GRID_W
    row = jnp.repeat(jnp.arange(rows), GRID_W)
    col = jnp.tile(jnp.arange(GRID_W), rows)
    cos, sin = axial_rope_tables(row, col)
    xc = ctx
    for layer in range(DEPTH):
        need_ctx = layer < DEPTH - 1
        lam_init = 0.8 - 0.6 * math.exp(-0.3 * layer)
        mod = (jax.nn.silu(c) @ w_mod[layer] + b_mod[layer]).reshape(b, N_MOD, 1, d)
        mod_c = (jax.nn.silu(c_ctx) @ w_mod[layer] + b_mod[layer]).reshape(N_MOD, d)
        hl = modulate(rms_norm(x, g_mix[layer]), mod[:, 0], mod[:, 1])
        hc = modulate(rms_norm(xc, g_mix[layer]), mod_c[0], mod_c[1])
        out_l, out_c = token_mixers(hl, hc, cos, sin, lam_init, need_ctx, w_in[layer], b_gate[layer],
                                    sink[layer], lam_q1[layer], lam_k1[layer], lam_q2[layer], lam_k2[layer],
                                    g_diff[layer], g_mlstm[layer], w_a[layer], w_b[layer], w_c[layer], w_out[layer])
        x = x + mod[:, 2] * out_l
        hl = modulate(rms_norm(x, g_ffn[layer]), mod[:, 3], mod[:, 4])
        moe = (w_router[layer], b_router[layer], w_exp_gate[layer], w_exp_up[layer], w_exp_down[layer],
               w_sh_gate[layer], w_sh_up[layer], w_sh_down[layer])
        if need_ctx:
            xc = xc + mod_c[2] * out_c
            hc = modulate(rms_norm(xc, g_ffn[layer]), mod_c[3], mod_c[4])
            y = moe_ffn(jnp.concatenate([hc, hl], axis=1), *moe)
            xc = xc + mod_c[5] * y[:, :ctx_len]
            x = x + mod[:, 5] * y[:, ctx_len:]
        else:
            x = x + mod[:, 5] * moe_ffn(hl, *moe)
    return rms_norm(x, g_final)
```

```cpp
#include <hip/hip_runtime.h>
#include <cstdio>
#include <cstdint>

#ifndef ONE_LAUNCH
#define ONE_LAUNCH 1
#endif
#define DBG_NPH NPHASE
#define DBG_H 0
#define DBG_I 0
#define DBG_AMP 0
#define DBG_X1 1
#define DBG_B0 WS_QC
#define DBG_L0 ((size_t)MA * 2048 * 2)
#define DBG_B1 WS_HF
#define DBG_L1 ((size_t)MA * 512 * 2)
#define DBG_B2 WS_HB
#define DBG_L2 ((size_t)MA * 512 * 2)
#define DBG_B3 WS_OB
#define DBG_L3 ((size_t)MA * 512 * 2)

#define LAS __attribute__((address_space(3)))
#define GAS __attribute__((address_space(1)))
typedef unsigned short bf16;
typedef short bf16x8 __attribute__((ext_vector_type(8)));
typedef short s16x4 __attribute__((ext_vector_type(4)));
typedef float f32x2 __attribute__((ext_vector_type(2)));
typedef float f32x4 __attribute__((ext_vector_type(4)));
typedef float f32x16 __attribute__((ext_vector_type(16)));
typedef unsigned u32x2 __attribute__((ext_vector_type(2)));
typedef unsigned u32x4 __attribute__((ext_vector_type(4)));
typedef __bf16 bf16x2_t __attribute__((ext_vector_type(2)));

constexpr int D = 1024, NBATCH = 8, SEQ = 4096, CTXL = 256;
constexpr int ML = NBATCH * SEQ;
constexpr int MC = NBATCH * CTXL;
constexpr int MA = ML + MC;
constexpr int NIN = 7440;
constexpr int N1 = 4608;
constexpr int NGT = 3072;
constexpr int LDA_ = 768, LDB_ = 1536, LDC_ = 2048;
constexpr float EPS = 1e-6f;
constexpr float LOG2E = 1.4426950408889634f;
constexpr int NPH = 16;
constexpr int NPHASE = 1 + 2 * NPH;
constexpr int CAP = 17408;

constexpr size_t MiB = 1ull << 20;
constexpr size_t WS_CTL = 0;
constexpr size_t WS_MODS = 1 * MiB;
constexpr size_t WS_ROPE = 1 * MiB + 512 * 1024;
constexpr size_t WS_LAM = WS_ROPE + 16384;
constexpr size_t WS_WIN = 8 * MiB;
constexpr size_t WS_WGT = 17 * MiB;
constexpr size_t WS_WA = 23 * MiB, WS_WB = 24 * MiB, WS_WC = 25 * MiB;
constexpr size_t WS_WO = 26 * MiB;
constexpr size_t WS_WR = 28 * MiB;
constexpr size_t WS_XWC = 29 * MiB;
constexpr size_t WS_HL = 38 * MiB;
constexpr size_t WS_CG = 106 * MiB;
constexpr size_t WS_LOG = 109 * MiB;
constexpr size_t WS_TOKE = 118 * MiB;
constexpr size_t WS_TOKP = 119 * MiB + 512 * 1024;
constexpr size_t WS_ELIST = 121 * MiB;
constexpr size_t WS_WLIST = 130 * MiB;
constexpr size_t WS_BIG = 140 * MiB;
constexpr size_t WS_QA = WS_BIG;
constexpr size_t WS_QB = WS_BIG + 51 * MiB;
constexpr size_t WS_QC = WS_BIG + 153 * MiB;
constexpr size_t WS_OA = WS_BIG + 289 * MiB;
constexpr size_t WS_OB = WS_BIG + 323 * MiB;
constexpr size_t WS_HF = WS_BIG + 357 * MiB;
constexpr size_t WS_HB = WS_BIG + 391 * MiB;
constexpr size_t WS_GT = WS_BIG;
constexpr size_t WS_Y = WS_BIG + 425 * MiB;
constexpr size_t WS_WGU = WS_BIG;
constexpr size_t WS_WD = WS_BIG + 65 * MiB;
constexpr size_t WS_A2 = WS_BIG + 98 * MiB;
constexpr size_t WS_Y2 = WS_BIG + 183 * MiB;
constexpr size_t WS_END = WS_BIG + 493 * MiB;
static_assert(WS_Y2 + 155584ull * 2048 <= WS_END && WS_A2 + 172992ull * 512 <= WS_Y2, "ws map");
constexpr int CW_BAR = 4096;
constexpr int CW_WQ = 8192;
constexpr int CW_CNT = 16384;

constexpr int LDS_TAB = 143360;
constexpr int LDS_MISC = 147456;
constexpr int LDS_BYTES = 151552;

struct Args { const GAS float* in[30]; GAS float* out; GAS unsigned char* ws; int lo, hi; };
typedef const __attribute__((address_space(4))) Args* CArgsP;
__device__ __forceinline__ CArgsP launder_args(CArgsP p) { asm volatile("" : "+s"(p)); return p; }

__device__ __forceinline__ unsigned pk2(float lo, float hi) { f32x2 v = {lo, hi}; bf16x2_t b = __builtin_convertvector(v, bf16x2_t); return __builtin_bit_cast(unsigned, b); }
__device__ __forceinline__ float bflo(unsigned u) { return __uint_as_float(u << 16); }
__device__ __forceinline__ float bfhi(unsigned u) { return __uint_as_float(u & 0xffff0000u); }
__device__ __forceinline__ float ex2(float x) { return __builtin_amdgcn_exp2f(x); }
__device__ __forceinline__ float sigm(float x) { return __builtin_amdgcn_rcpf(1.f + ex2(-LOG2E * x)); }
__device__ __forceinline__ float wave_sum(float v) {
#pragma unroll
    for (int o = 1; o < 64; o <<= 1) v += __shfl_xor(v, o);
    return v;
}
__device__ __forceinline__ int crow(int i, int hi) { return (i & 3) + 8 * (i >> 2) + 4 * hi; }
__device__ __forceinline__ int offb(int row, int ch) { return 256 * row + 16 * (ch ^ (((row & 3) << 2) | ((row >> 2) & 3))); }
typedef short v4i16_t __attribute__((ext_vector_type(4)));
__device__ __forceinline__ s16x4 trrd(LAS unsigned char* p) { return __builtin_bit_cast(s16x4, __builtin_amdgcn_ds_read_tr16_b64_v4i16((LAS v4i16_t*)p)); }
__device__ __forceinline__ bf16x8 cat8(s16x4 a, s16x4 b) { return (bf16x8){a[0], a[1], a[2], a[3], b[0], b[1], b[2], b[3]}; }
#define LDS_WAIT() asm volatile("s_waitcnt lgkmcnt(0)" ::: "memory")

#define XB_TMO      128
#define XB_XCNT(j)  (256  + 64 * (j))
#define XB_XSUB(j)  (1280 + 64 * (j))
#define XB_XGEN(j)  (2304 + 64 * (j))
#define XB_TOP      3328
#define XB_TOPGEN   3392
#define XCD_BAR_WORDS 3456
#define XB_SPIN_CAP (1u << 18)
__device__ __forceinline__ unsigned xb_ld(unsigned* p)              { return __hip_atomic_load(p, __ATOMIC_RELAXED, __HIP_MEMORY_SCOPE_AGENT); }
__device__ __forceinline__ unsigned xb_add(unsigned* p, unsigned v) { return __hip_atomic_fetch_add(p, v, __ATOMIC_RELAXED, __HIP_MEMORY_SCOPE_AGENT); }
__device__ __forceinline__ unsigned xb_xcc_id() { return (unsigned)__builtin_amdgcn_s_getreg((3 << 11) | 20) & 0xFu; }
#define XB_SPIN(cond, bar) do { unsigned _sp = 0; while (cond) { __builtin_amdgcn_s_sleep(1); \
    if ((++_sp & 255u) == 0u) { if (xb_ld(&(bar)[XB_TMO])) break; if (_sp > XB_SPIN_CAP) { atomicAdd(&(bar)[XB_TMO], 1u); break; } } } } while (0)
struct XcdBarrier { unsigned* bar; unsigned x; volatile LAS unsigned* st; };
__device__ __forceinline__ XcdBarrier xcd_barrier_post(unsigned* bar, volatile LAS unsigned* st) {
    XcdBarrier b; b.bar = bar; b.x = xb_xcc_id(); b.st = st;
    if (threadIdx.x == 0) (void)xb_add(&bar[XB_XCNT(b.x)], 1u);
    return b;
}
__device__ __forceinline__ void xcd_barrier_complete(unsigned* bar, unsigned x, unsigned& nloc, unsigned& nx) {
    const unsigned G = gridDim.x * gridDim.y * gridDim.z;
    unsigned sum, cnt, mine, sp = 0u;
    for (;;) {
        sum = 0u; cnt = 0u; mine = 0u;
#pragma unroll
        for (unsigned j = 0; j < 16; ++j) { const unsigned c = xb_ld(&bar[XB_XCNT(j)]); sum += c; cnt += (c > 0u) ? 1u : 0u; mine = (j == x) ? c : mine; }
        if (sum == G) break;
        __builtin_amdgcn_s_sleep(1);
        if ((++sp & 255u) == 0u) { if (xb_ld(&bar[XB_TMO])) break; if (sp > XB_SPIN_CAP) { atomicAdd(&bar[XB_TMO], 1u); break; } }
    }
    nloc = mine > 0u ? mine : 1u; nx = cnt > 0u ? cnt : 1u;
}
__device__ __forceinline__ void xcd_barrier(const XcdBarrier& b) {
    asm volatile("s_waitcnt vmcnt(0)" ::: "memory");
    __syncthreads();
    if (threadIdx.x == 0) {
        unsigned* bar = b.bar;
        __builtin_amdgcn_s_waitcnt(0);
        unsigned nloc = b.st[0], nx = b.st[1];
        if (nloc == 0u) { xcd_barrier_complete(bar, b.x, nloc, nx); b.st[0] = nloc; b.st[1] = nx; }
        const unsigned old = xb_add(&bar[XB_XSUB(b.x)], 1u);
        const unsigned gen = old / nloc;
        if (old + 1u == (gen + 1u) * nloc) {
            __builtin_amdgcn_fence(__ATOMIC_RELEASE, "agent");
            asm volatile("s_waitcnt vmcnt(0)" ::: "memory");
            const unsigned og = xb_add(&bar[XB_TOP], 1u);
            const unsigned tg = og / nx;
            if (og + 1u == (tg + 1u) * nx) xb_add(&bar[XB_TOPGEN], 1u);
            else XB_SPIN(xb_ld(&bar[XB_TOPGEN]) == tg, bar);
            __builtin_amdgcn_fence(__ATOMIC_ACQUIRE, "agent");
            xb_add(&bar[XB_XGEN(b.x)], 1u);
            asm volatile("s_waitcnt vmcnt(0)" ::: "memory");
        } else {
            XB_SPIN(xb_ld(&bar[XB_XGEN(b.x)]) == gen, bar);
            __builtin_amdgcn_fence(__ATOMIC_ACQUIRE, "agent");
            asm volatile("s_waitcnt vmcnt(0)" ::: "memory");
        }
    }
    __syncthreads();
}

namespace pg8 {
constexpr int BM = 256, BK = 64, HALF = 128, HTB = HALF * BK * 2, STAGE_BYTES = 8 * HTB, NXCD = 8, WGM = 8;
__device__ __forceinline__ int lds_byte(int r, int c) { const int st = (r >> 4) * 2 + (c >> 5), rr = r & 15, cc = c & 31, ob = rr * 64 + cc * 2; return st * 1024 + (ob ^ (((ob >> 9) & 1) << 5)); }
__device__ __forceinline__ void stage_rc(int b, int& R, int& C) { const int st = b / 1024, sb = b % 1024, swz = sb ^ (((sb >> 9) & 1) << 5); R = (st >> 1) * 16 + swz / 64; C = (st & 1) * 32 + (swz % 64) / 2; }
__device__ __forceinline__ int perm32(int rho) { const int n = rho >> 4, i = rho & 15; return 8 * (i >> 2) + 4 * n + (i & 3); }

struct GUnit { const char* A; const char* B; int pm, pn, a0, a1, a2, a3; };

template <class Epi, class Sched>
__device__ __forceinline__ void gemm_phase(LAS unsigned char* lds, const int K_, const Sched& S, const Epi& E) {
    int tid_l = threadIdx.x; asm volatile("" : "+v"(tid_l));
    const int tid = tid_l, wid = __builtin_amdgcn_readfirstlane(tid >> 6), lane = tid & 63, wr = wid >> 2, wc = wid & 3, fr = lane & 15, fq = lane >> 4;
    int K = K_; asm volatile("" : "+s"(K));
    const int nt = K / BK;
    int Rr[2], Cc[2]; unsigned voffA[2], voffB[2];
#pragma unroll
    for (int i = 0; i < 2; ++i) { int R, C; stage_rc(tid * 16 + i * 8192, R, C); const int Rb = Epi::PERM ? ((R & ~31) + perm32(R & 31)) : R;
        Rr[i] = R; Cc[i] = C; voffA[i] = (unsigned)(R * K + C) * 2u; voffB[i] = (unsigned)(Rb * K + C) * 2u; }
    const size_t kstep = (size_t)(BK * 2);
    const size_t hstep = (size_t)HALF * K * 2;
    const unsigned ldsw = (unsigned)wid * 1024u;
    const int aoff = lds_byte(wr * 64 + fr, fq * 8), boff = lds_byte(wc * 32 + fr, fq * 8);
#define PG8_SA(b, h) (((b) * 2 + (h)) * HTB)
#define PG8_SB(b, h) ((4 + (b) * 2 + (h)) * HTB)
#define PG8_STAGE(bufoff, gbase, voff) do { _Pragma("unroll") for (int _i = 0; _i < 2; ++_i) \
        __builtin_amdgcn_global_load_lds((const unsigned*)((const char*)(gbase) + (voff)[_i]), (LAS unsigned*)(lds + (bufoff) + ldsw + _i * 8192), 16, 0, 0); } while (0)
#define PG8_LDA(dst, b, h) do { _Pragma("unroll") for (int m = 0; m < 4; ++m) _Pragma("unroll") for (int k = 0; k < 2; ++k) dst[m][k] = *(const LAS bf16x8*)(lds + PG8_SA(b, h) + aoff + m * 2048 + k * 1024); } while (0)
#define PG8_LDB(dst, b, h) do { _Pragma("unroll") for (int n = 0; n < 2; ++n) _Pragma("unroll") for (int k = 0; k < 2; ++k) dst[n][k] = *(const LAS bf16x8*)(lds + PG8_SB(b, h) + boff + n * 2048 + k * 1024); } while (0)
#define PG8_MMA(ai, bj, At, Bt) do { __builtin_amdgcn_s_setprio(1); _Pragma("unroll") for (int m = 0; m < 4; ++m) _Pragma("unroll") for (int n = 0; n < 2; ++n) _Pragma("unroll") for (int k = 0; k < 2; ++k) \
        acc[ai][bj][m][n] = __builtin_amdgcn_mfma_f32_16x16x32_bf16(Bt[n][k], At[m][k], acc[ai][bj][m][n], 0, 0, 0); __builtin_amdgcn_s_setprio(0); } while (0)
#define PG8_WAIT_V(n) asm volatile("s_waitcnt vmcnt(" #n ")" ::: "memory")
#define PG8_WAIT_L(n) asm volatile("s_waitcnt lgkmcnt(" #n ")" ::: "memory")
#define PG8_BAR __builtin_amdgcn_s_barrier()
#define PG8_SCHED __builtin_amdgcn_sched_barrier(0)
#define PG8_SETA(v, u) do { if constexpr (Sched::GATHER) { _Pragma("unroll") for (int _h = 0; _h < 2; ++_h) _Pragma("unroll") for (int _i = 0; _i < 2; ++_i) \
        v[_h][_i] = S.arow(u, Rr[_i] + 128 * _h) + (unsigned)Cc[_i] * 2u; } } while (0)
#define PG8_STAGEA(bufoff, p, v, h) do { if constexpr (Sched::GATHER) { PG8_STAGE(bufoff, p, v[h]); } else { PG8_STAGE(bufoff, (p) + (h) * hstep, voffA); } } while (0)
    GUnit cur, nxt; int ui = 0;
    if (!S.next(0, cur)) return;
    f32x4 acc[2][2][4][2];
#pragma unroll
    for (int a = 0; a < 2; ++a)
#pragma unroll
        for (int b = 0; b < 2; ++b)
#pragma unroll
            for (int m = 0; m < 4; ++m)
#pragma unroll
                for (int n = 0; n < 2; ++n) acc[a][b][m][n] = (f32x4){0.f, 0.f, 0.f, 0.f};
    bf16x8 At[4][2], B0[2][2], B1[2][2];
    unsigned vAc[2][2], vAn[2][2];
    PG8_SETA(vAc, cur);
    const char* cA = cur.A; const char* cB = cur.B;
    PG8_STAGE(PG8_SB(0, 0), cB, voffB); PG8_STAGEA(PG8_SA(0, 0), cA, vAc, 0); PG8_STAGE(PG8_SB(0, 1), cB + hstep, voffB); PG8_STAGEA(PG8_SA(0, 1), cA, vAc, 1);
    if (wr == 1) PG8_BAR;
    PG8_WAIT_V(4); PG8_BAR;
    PG8_STAGE(PG8_SB(1, 0), cB + kstep, voffB); PG8_STAGEA(PG8_SA(1, 0), cA + kstep, vAc, 0); PG8_STAGE(PG8_SB(1, 1), cB + hstep + kstep, voffB);
    PG8_WAIT_V(6); PG8_BAR;
    for (;;) {
        const bool has_next = S.next(ui + 1, nxt);
        const char* nA = has_next ? nxt.A : cA; const char* nB = has_next ? nxt.B : cB;
        if constexpr (Sched::GATHER) { if (has_next) { PG8_SETA(vAn, nxt); } else {
#pragma unroll
            for (int _h = 0; _h < 2; ++_h)
#pragma unroll
                for (int _i = 0; _i < 2; ++_i) vAn[_h][_i] = vAc[_h][_i]; } }
        for (int t = 0; t < nt; t += 2) {
            const bool last = (t == nt - 2);
            const char* a1 = cA + (size_t)(t + 1) * kstep;
            const char* a2 = last ? nA : cA + (size_t)(t + 2) * kstep; const char* b2 = last ? nB : cB + (size_t)(t + 2) * kstep;
            const char* a3 = a2 + kstep; const char* b3 = b2 + kstep;
            unsigned v2[2][2];
            if constexpr (Sched::GATHER) {
#pragma unroll
            for (int _h = 0; _h < 2; ++_h)
#pragma unroll
                for (int _i = 0; _i < 2; ++_i) v2[_h][_i] = last ? vAn[_h][_i] : vAc[_h][_i]; }
            PG8_LDB(B0, 0, 0); PG8_SCHED; PG8_LDA(At, 0, 0); PG8_STAGEA(PG8_SA(1, 1), a1, vAc, 1);
            PG8_WAIT_L(8); PG8_BAR; PG8_WAIT_L(0); PG8_MMA(0, 0, At, B0); PG8_BAR; PG8_SCHED;
            PG8_LDB(B1, 0, 1); PG8_STAGE(PG8_SB(0, 0), b2, voffB);
            PG8_BAR; PG8_WAIT_L(0); PG8_MMA(0, 1, At, B1); PG8_BAR;
            PG8_LDA(At, 0, 1); PG8_STAGEA(PG8_SA(0, 0), a2, v2, 0);
            PG8_BAR; PG8_WAIT_L(0); PG8_MMA(1, 0, At, B0); PG8_BAR; PG8_SCHED;
            PG8_STAGE(PG8_SB(0, 1), b2 + hstep, voffB);
            PG8_WAIT_V(6); PG8_BAR; PG8_MMA(1, 1, At, B1); PG8_BAR;
            PG8_LDB(B0, 1, 0); PG8_SCHED; PG8_LDA(At, 1, 0); PG8_STAGEA(PG8_SA(0, 1), a2, v2, 1);
            PG8_WAIT_L(8); PG8_BAR; PG8_WAIT_L(0); PG8_MMA(0, 0, At, B0); PG8_BAR; PG8_SCHED;
            PG8_LDB(B1, 1, 1); PG8_STAGE(PG8_SB(1, 0), b3, voffB);
            PG8_BAR; PG8_WAIT_L(0); PG8_MMA(0, 1, At, B1); PG8_BAR;
            PG8_LDA(At, 1, 1); PG8_STAGEA(PG8_SA(1, 0), a3, v2, 0);
            PG8_BAR; PG8_WAIT_L(0); PG8_MMA(1, 0, At, B0); PG8_BAR; PG8_SCHED;
            PG8_STAGE(PG8_SB(1, 1), b3 + hstep, voffB);
            PG8_WAIT_V(6); PG8_BAR; PG8_MMA(1, 1, At, B1); PG8_BAR;
        }
        E(acc, cur, wr, wc, fr, fq);
        if (!has_next) break;
#pragma unroll
        for (int a = 0; a < 2; ++a)
#pragma unroll
            for (int b = 0; b < 2; ++b)
#pragma unroll
                for (int m = 0; m < 4; ++m)
#pragma unroll
                    for (int n = 0; n < 2; ++n) acc[a][b][m][n] = (f32x4){0.f, 0.f, 0.f, 0.f};
        cur = nxt; cA = nA; cB = nB; ++ui;
        if constexpr (Sched::GATHER) {
#pragma unroll
        for (int _h = 0; _h < 2; ++_h)
#pragma unroll
            for (int _i = 0; _i < 2; ++_i) vAc[_h][_i] = vAn[_h][_i]; }
    }
    PG8_WAIT_V(0);
    if (wr == 0) PG8_BAR;
    PG8_BAR;
#undef PG8_SA
#undef PG8_SB
#undef PG8_STAGE
#undef PG8_LDA
#undef PG8_LDB
#undef PG8_MMA
#undef PG8_WAIT_V
#undef PG8_WAIT_L
#undef PG8_BAR
#undef PG8_SCHED
#undef PG8_SETA
#undef PG8_STAGEA
}

struct DenseSched {
    static constexpr bool GATHER = false;
    const char* A; const char* Bt; int K, nM, nN, nwg, G, c;
    __device__ __forceinline__ void init(const void* A_, const void* B_, int M, int N, int K_, int G_, int c_) { A = (const char*)A_; Bt = (const char*)B_; K = K_; nM = M / BM; nN = N / BM; nwg = nM * nN; G = G_; c = c_; }
    __device__ __forceinline__ bool next(int i, GUnit& u) const {
        const long L = (long)i * G + c; if (L >= nwg) return false;
        int wgid = (int)L; { const int q = nwg / NXCD, r = nwg % NXCD, xcd = wgid % NXCD, off = wgid / NXCD; wgid = (xcd < r ? xcd * (q + 1) : r * (q + 1) + (xcd - r) * q) + off; }
        const int nig = WGM * nN, gid = wgid / nig, fm = gid * WGM, gsz = (nM - fm) < WGM ? (nM - fm) : WGM;
        u.pm = fm + ((wgid % nig) % gsz); u.pn = (wgid % nig) / gsz;
        u.A = A + (size_t)u.pm * BM * K * 2; u.B = Bt + (size_t)u.pn * BM * K * 2; u.a0 = u.a1 = u.a2 = u.a3 = 0; return true;
    }
    __device__ __forceinline__ unsigned arow(const GUnit&, int) const { return 0u; }
};

template <int NPN, bool G_> struct MoeSched {
    static constexpr bool GATHER = G_;
    const char* Abase; const char* Bbase; size_t bstride; int K; const int* elist; const LAS int* tab; int hbase, nU, G, c, NE;
    __device__ __forceinline__ bool next(int i, GUnit& u) const {
        const long L = (long)i * G + c; if (L >= nU) return false;
        int wgid = (int)L; { const int q = nU / NXCD, r = nU % NXCD, xcd = wgid % NXCD, off = wgid / NXCD; wgid = (xcd < r ? xcd * (q + 1) : r * (q + 1) + (xcd - r) * q) + off; }
        int e = 0; while (e < NE - 1 && wgid >= tab[130 + e + 1]) ++e;
        e = __builtin_amdgcn_readfirstlane(e);
        const int r = wgid - tab[130 + e], rb = r / NPN, pn = r % NPN;
        u.pm = rb; u.pn = pn; u.a0 = e; u.a1 = __builtin_amdgcn_readfirstlane(tab[65 + e]) + 256 * rb; u.a2 = __builtin_amdgcn_readfirstlane(tab[e]); u.a3 = 0;
        u.A = G_ ? Abase : Abase + (size_t)u.a1 * K * 2;
        u.B = Bbase + (size_t)e * bstride + (size_t)pn * BM * K * 2;
        return true;
    }
    __device__ __forceinline__ unsigned arow(const GUnit& u, int R) const {
        const int idx = 256 * u.pm + R; int tok;
        if (u.a0 == 64) tok = hbase + idx;
        else tok = (idx < u.a2) ? elist[(size_t)u.a0 * CAP + idx] : hbase;
        return (unsigned)tok * (unsigned)(K * 2);
    }
};
}
using pg8::GUnit;

typedef f32x4 AccT[2][2][4][2];
struct EpiG1 {
    static constexpr bool PERM = true;
    bf16 *QA, *QB, *QC; float* CG; const float* rope;
    __device__ __forceinline__ void operator()(const AccT& acc, const GUnit& u, int wr, int wc, int fr, int fq) const {
        const int pn = u.pn;
        if (pn == 17) {
            if (wc == 0 && fq < 2) {
#pragma unroll
                for (int ai = 0; ai < 2; ++ai)
#pragma unroll
                    for (int m = 0; m < 4; ++m) { const int row = u.pm * 256 + ai * 128 + wr * 64 + m * 16 + fr; float* p = CG + (size_t)row * 16 + 8 * fq;
                        *(f32x4*)p = acc[ai][0][m][0]; *(f32x4*)(p + 4) = acc[ai][0][m][1]; }
            }
            return;
        }
        bf16* base; int ld, colt;
        if (pn < 3) { base = QA; ld = LDA_; colt = pn * 256; } else if (pn < 9) { base = QB; ld = LDB_; colt = (pn - 3) * 256; } else { base = QC; ld = LDC_; colt = (pn - 9) * 256; }
        const bool latent = u.pm < 128;
#pragma unroll
        for (int ai = 0; ai < 2; ++ai)
#pragma unroll
            for (int m = 0; m < 4; ++m) {
                const int row = u.pm * 256 + ai * 128 + wr * 64 + m * 16 + fr; const int t = row & 4095; const int pos = (wc & 1) ? (t & 63) : (t >> 6);
                bf16* rowp = base + (size_t)row * ld + colt + wc * 32 + 8 * fq;
#pragma unroll
                for (int bj = 0; bj < 2; ++bj) {
                    const int gc = pn * 256 + bj * 128;
                    const bool rp = latent && (gc < 640 || (gc >= 768 && gc < 1792));
                    f32x4 v0 = acc[ai][bj][m][0], v1 = acc[ai][bj][m][1];
                    if (rp) { const f32x4 cs = *(const f32x4*)(rope + pos * 16 + 4 * fq), sn = *(const f32x4*)(rope + 1024 + pos * 16 + 4 * fq);
                        const f32x4 a = v0, b = v1; v0 = a * cs - b * sn; v1 = b * cs + a * sn; }
                    u32x4 w; w.x = pk2(v0[0], v0[1]); w.y = pk2(v0[2], v0[3]); w.z = pk2(v1[0], v1[1]); w.w = pk2(v1[2], v1[3]);
                    *(u32x4*)(rowp + bj * 128) = w;
                }
            }
    }
};
struct EpiBf16 {
    static constexpr bool PERM = true;
    bf16* O; int ld;
    __device__ __forceinline__ void operator()(const AccT& acc, const GUnit& u, int wr, int wc, int fr, int fq) const {
#pragma unroll
        for (int ai = 0; ai < 2; ++ai)
#pragma unroll
            for (int m = 0; m < 4; ++m) { bf16* rowp = O + (size_t)(u.pm * 256 + ai * 128 + wr * 64 + m * 16 + fr) * ld + u.pn * 256 + wc * 32 + 8 * fq;
#pragma unroll
                for (int bj = 0; bj < 2; ++bj) { const f32x4 v0 = acc[ai][bj][m][0], v1 = acc[ai][bj][m][1];
                    u32x4 w; w.x = pk2(v0[0], v0[1]); w.y = pk2(v0[2], v0[3]); w.z = pk2(v1[0], v1[1]); w.w = pk2(v1[2], v1[3]);
                    *(u32x4*)(rowp + bj * 128) = w; } }
    }
};
struct EpiGate {
    static constexpr bool PERM = true;
    const bf16* GT; bf16* Y; int br;
    __device__ __forceinline__ void operator()(const AccT& acc, const GUnit& u, int wr, int wc, int fr, int fq) const {
#pragma unroll
        for (int ai = 0; ai < 2; ++ai)
#pragma unroll
            for (int m = 0; m < 4; ++m) { const size_t row = (size_t)(u.pm * 256 + ai * 128 + wr * 64 + m * 16 + fr); const int col0 = u.pn * 256 + wc * 32 + 8 * fq;
#pragma unroll
                for (int bj = 0; bj < 2; ++bj) { const int col = col0 + bj * 128;
                    const u32x4 g = *(const u32x4*)(GT + row * NGT + br * 1024 + col);
                    u32x4 y = (u32x4){0u, 0u, 0u, 0u}; if (br) y = *(const u32x4*)(Y + row * 1024 + col);
                    const f32x4 v0 = acc[ai][bj][m][0], v1 = acc[ai][bj][m][1];
                    float o[8];
                    o[0] = sigm(bflo(g.x)) * v0[0] + bflo(y.x); o[1] = sigm(bfhi(g.x)) * v0[1] + bfhi(y.x);
                    o[2] = sigm(bflo(g.y)) * v0[2] + bflo(y.y); o[3] = sigm(bfhi(g.y)) * v0[3] + bfhi(y.y);
                    o[4] = sigm(bflo(g.z)) * v1[0] + bflo(y.z); o[5] = sigm(bfhi(g.z)) * v1[1] + bfhi(y.z);
                    o[6] = sigm(bflo(g.w)) * v1[2] + bflo(y.w); o[7] = sigm(bfhi(g.w)) * v1[3] + bfhi(y.w);
                    u32x4 w; w.x = pk2(o[0], o[1]); w.y = pk2(o[2], o[3]); w.z = pk2(o[4], o[5]); w.w = pk2(o[6], o[7]);
                    *(u32x4*)(Y + row * 1024 + col) = w; } }
    }
};
struct EpiRes {
    static constexpr bool PERM = false;
    const float* resL; const float* resC; float* outL; float* outC; const float* modv; int rowbase;
    __device__ __forceinline__ void operator()(const AccT& acc, const GUnit& u, int wr, int wc, int fr, int fq) const {
#pragma unroll
        for (int ai = 0; ai < 2; ++ai)
#pragma unroll
            for (int m = 0; m < 4; ++m) { const int row = rowbase + u.pm * 256 + ai * 128 + wr * 64 + m * 16 + fr;
                const float* rp; float* op; const float* mv = modv + (row < ML ? (row >> 12) : 8) * 6144;
                if (row < ML) { rp = resL + (size_t)row * D; op = outL + (size_t)row * D; } else { rp = resC + (size_t)(row - ML) * D; op = outC + (size_t)(row - ML) * D; }
#pragma unroll
                for (int bj = 0; bj < 2; ++bj)
#pragma unroll
                    for (int n = 0; n < 2; ++n) { const int col = u.pn * 256 + bj * 128 + wc * 32 + n * 16 + 4 * fq;
                        const f32x4 r4 = *(const f32x4*)(rp + col), m4 = *(const f32x4*)(mv + col);
                        *(f32x4*)(op + col) = r4 + m4 * acc[ai][bj][m][n]; }
                asm volatile("" ::: "memory"); }
    }
};
struct EpiLogits {
    static constexpr bool PERM = false;
    float* L;
    __device__ __forceinline__ void operator()(const AccT& acc, const GUnit& u, int wr, int wc, int fr, int fq) const {
        if (wc >= 2) return;
#pragma unroll
        for (int ai = 0; ai < 2; ++ai)
#pragma unroll
            for (int m = 0; m < 4; ++m) { const int row = u.pm * 256 + ai * 128 + wr * 64 + m * 16 + fr;
#pragma unroll
                for (int n = 0; n < 2; ++n) *(f32x4*)(L + (size_t)row * 64 + wc * 32 + n * 16 + 4 * fq) = acc[ai][0][m][n]; }
    }
};
struct EpiSwiGLU {
    static constexpr bool PERM = true;
    bf16* A2;
    __device__ __forceinline__ void operator()(const AccT& acc, const GUnit& u, int wr, int wc, int fr, int fq) const {
#pragma unroll
        for (int ai = 0; ai < 2; ++ai)
#pragma unroll
            for (int m = 0; m < 4; ++m) { bf16* rowp = A2 + (size_t)(u.a1 + ai * 128 + wr * 64 + m * 16 + fr) * 256 + u.pn * 128 + wc * 16 + 4 * fq;
#pragma unroll
                for (int bj = 0; bj < 2; ++bj) { const f32x4 g = acc[ai][bj][m][0], uu = acc[ai][bj][m][1];
                    u32x2 w; w.x = pk2(g[0] * sigm(g[0]) * uu[0], g[1] * sigm(g[1]) * uu[1]); w.y = pk2(g[2] * sigm(g[2]) * uu[2], g[3] * sigm(g[3]) * uu[3]);
                    *(u32x2*)(rowp + bj * 64) = w; } }
    }
};
struct EpiY2 {
    static constexpr bool PERM = true;
    bf16* Y2; const float* wlist;
    __device__ __forceinline__ void operator()(const AccT& acc, const GUnit& u, int wr, int wc, int fr, int fq) const {
        const int e = u.a0;
#pragma unroll
        for (int ai = 0; ai < 2; ++ai)
#pragma unroll
            for (int m = 0; m < 4; ++m) { const int lr = ai * 128 + wr * 64 + m * 16 + fr; const int idx = 256 * u.pm + lr;
                const float w = idx < u.a2 ? wlist[(size_t)e * CAP + idx] : 0.f;
                bf16* rowp = Y2 + (size_t)(u.a1 + lr) * 1024 + u.pn * 256 + wc * 32 + 8 * fq;
#pragma unroll
                for (int bj = 0; bj < 2; ++bj) { const f32x4 v0 = acc[ai][bj][m][0] * w, v1 = acc[ai][bj][m][1] * w;
                    u32x4 o; o.x = pk2(v0[0], v0[1]); o.y = pk2(v0[2], v0[3]); o.z = pk2(v1[0], v1[1]); o.w = pk2(v1[2], v1[3]);
                    *(u32x4*)(rowp + bj * 128) = o; }
                asm volatile("" ::: "memory"); }
    }
};

template <int DV, bool DIFF>
__device__ __forceinline__ void attn_core(LAS unsigned char* lds, const bf16* qptr  ,
                                          const bf16* kv0, int nt0, const bf16* kv1, int nt1, int ld, int kcol, int vcol, int stream,
                                          bool domask, int qpos, int kpos0, float& m_run, float& l_run, f32x16 (&o)[DV / 32]) {
    constexpr int NDV = DV / 32;
    constexpr int NLD = DIFF ? 4 : 2;
    constexpr int KOFF = 0, VOFF = DIFF ? 16384 : 9216, BUFB = DIFF ? 32768 : 21504;
    int tid_l = threadIdx.x; asm volatile("" : "+v"(tid_l));
    const int tid = tid_l;
    bf16x8 qf[4];
#pragma unroll
    for (int d0 = 0; d0 < 4; ++d0) qf[d0] = *(const bf16x8*)(qptr + 16 * d0);
    const int NT = nt0 + nt1;
    u32x4 st[NLD];
#define AT_LOAD(t) do { const bf16* _b = ((t) < nt0) ? kv0 + (size_t)((t) * 64) * ld : kv1 + (size_t)(((t) - nt0) * 64) * ld; \
        _Pragma("unroll") for (int _p = 0; _p < NLD; ++_p) { const int _idx = tid + 512 * _p; \
            if (DIFF) { const int _w = _idx >> 10, _rem = _idx & 1023, _row = _rem >> 4, _ch = _rem & 15; st[_p] = *(const u32x4*)(_b + (size_t)_row * ld + (_w ? vcol : kcol) + _ch * 8); } \
            else { const int _w = _idx >> 9, _rem = _idx & 511, _row = _rem >> 3, _ch = _rem & 7; st[_p] = *(const u32x4*)(_b + (size_t)_row * ld + (_w ? vcol : kcol) + _ch * 8); } } } while (0)
#define AT_WRITE(buf) do { _Pragma("unroll") for (int _p = 0; _p < NLD; ++_p) { const int _idx = tid + 512 * _p; \
            if (DIFF) { const int _w = _idx >> 10, _rem = _idx & 1023, _row = _rem >> 4, _ch = _rem & 15; *(LAS u32x4*)(lds + (buf) * BUFB + (_w ? VOFF : KOFF) + offb(_row, _ch)) = st[_p]; } \
            else { const int _w = _idx >> 9, _rem = _idx & 511, _row = _rem >> 3, _ch = _rem & 7; *(LAS u32x4*)(lds + (buf) * BUFB + (_w ? VOFF + _row * 192 : KOFF + _row * 144) + _ch * 16) = st[_p]; } } } while (0)
    AT_LOAD(0); AT_WRITE(0);
    __syncthreads();
    for (int t = 0; t < NT; ++t) {
        int lane_l = tid_l & 63; asm volatile("" : "+v"(lane_l));
        const int lane = lane_l, r32 = lane & 31, hi = lane >> 5, q4 = (lane & 15) >> 2, p4 = lane & 3, g1 = (lane >> 4) & 1;
        const int buf = t & 1;
        if (t + 1 < NT) AT_LOAD(t + 1);
        LAS unsigned char* kb_ = lds + buf * BUFB + KOFF; LAS unsigned char* vb_ = lds + buf * BUFB + VOFF;
        f32x16 p0, p1;
#pragma unroll
        for (int i = 0; i < 16; ++i) { p0[i] = 0.f; p1[i] = 0.f; }
#pragma unroll
        for (int d0 = 0; d0 < 4; ++d0) {
            bf16x8 k0, k1;
            if (DIFF) { const int ch = 8 * stream + 2 * d0 + hi; k0 = *(const LAS bf16x8*)(kb_ + offb(r32, ch)); k1 = *(const LAS bf16x8*)(kb_ + offb(32 + r32, ch)); }
            else { k0 = *(const LAS bf16x8*)(kb_ + r32 * 144 + (16 * d0 + 8 * hi) * 2); k1 = *(const LAS bf16x8*)(kb_ + (32 + r32) * 144 + (16 * d0 + 8 * hi) * 2); }
            p0 = __builtin_amdgcn_mfma_f32_32x32x16_bf16(k0, qf[d0], p0, 0, 0, 0);
            p1 = __builtin_amdgcn_mfma_f32_32x32x16_bf16(k1, qf[d0], p1, 0, 0, 0);
        }
        if (!DIFF) { if (domask && t < nt0) { const int kp = kpos0 + 64 * t;
#pragma unroll
            for (int i = 0; i < 16; ++i) { const int d0_ = kp + crow(i, hi) - qpos; const int d1_ = d0_ + 32;
                if (d0_ > 128 || d0_ < -128) p0[i] = -1e30f; if (d1_ > 128 || d1_ < -128) p1[i] = -1e30f; } } }
        float mx = p0[0];
#pragma unroll
        for (int i = 1; i < 16; ++i) mx = fmaxf(mx, p0[i]);
#pragma unroll
        for (int i = 0; i < 16; ++i) mx = fmaxf(mx, p1[i]);
        mx = fmaxf(mx, __shfl_xor(mx, 32));
        const float mnew = fmaxf(m_run, mx); const float alpha = ex2(m_run - mnew); m_run = mnew;
        float ls = 0.f;
#pragma unroll
        for (int i = 0; i < 16; ++i) { p0[i] = ex2(p0[i] - mnew); p1[i] = ex2(p1[i] - mnew); ls += p0[i] + p1[i]; }
        l_run = l_run * alpha + ls;
#pragma unroll
        for (int dv = 0; dv < NDV; ++dv)
#pragma unroll
            for (int i = 0; i < 16; ++i) o[dv][i] *= alpha;
#pragma unroll
        for (int kb = 0; kb < 2; ++kb)
#pragma unroll
            for (int ks = 0; ks < 2; ++ks) {
                u32x4 pw;
                if (kb == 0) { pw.x = pk2(p0[8 * ks], p0[8 * ks + 1]); pw.y = pk2(p0[8 * ks + 2], p0[8 * ks + 3]); pw.z = pk2(p0[8 * ks + 4], p0[8 * ks + 5]); pw.w = pk2(p0[8 * ks + 6], p0[8 * ks + 7]); }
                else { pw.x = pk2(p1[8 * ks], p1[8 * ks + 1]); pw.y = pk2(p1[8 * ks + 2], p1[8 * ks + 3]); pw.z = pk2(p1[8 * ks + 4], p1[8 * ks + 5]); pw.w = pk2(p1[8 * ks + 6], p1[8 * ks + 7]); }
                const bf16x8 pf = __builtin_bit_cast(bf16x8, pw);
                const int krow = 32 * kb + 16 * ks + 4 * hi + q4;
#pragma unroll
                for (int dv = 0; dv < NDV; ++dv) {
                    s16x4 lo, hh;
                    if (DIFF) { const int ch = 4 * dv + 2 * g1 + (p4 >> 1); lo = trrd(vb_ + offb(krow, ch) + 8 * (p4 & 1)); hh = trrd(vb_ + offb(krow + 8, ch) + 8 * (p4 & 1)); }
                    else { lo = trrd(vb_ + krow * 192 + (32 * dv + 16 * g1 + 4 * p4) * 2); hh = trrd(vb_ + (krow + 8) * 192 + (32 * dv + 16 * g1 + 4 * p4) * 2); }
                    o[dv] = __builtin_amdgcn_mfma_f32_32x32x16_bf16(cat8(lo, hh), pf, o[dv], 0, 0, 0);
                }
            }
        if (t + 1 < NT) AT_WRITE(buf ^ 1);
        __syncthreads();
    }
#undef AT_LOAD
#undef AT_WRITE
}

__device__ __forceinline__ void mixB_unit(LAS unsigned char* lds, int ub, const bf16* QB, bf16* OB, const float* gdiff, float lam, float lam_init) {
    int tid_l = threadIdx.x; asm volatile("" : "+v"(tid_l));
    const int tid = tid_l, lane = tid & 63, r32 = lane & 31, hi = lane >> 5, wid = __builtin_amdgcn_readfirstlane(tid >> 6), s = wid >> 2, qs = wid & 3;
    int b, h, qrow0, nt0, nt1; const bf16 *kv0, *kv1;
    if (ub < 1024) { b = ub >> 7; h = (ub >> 5) & 3; const int qb = ub & 31; qrow0 = b * 4096 + qb * 128; kv0 = QB + (size_t)(b * 4096) * LDB_; nt0 = 64; kv1 = QB + (size_t)(ML + b * 256) * LDB_; nt1 = 4; }
    else { const int uc = ub - 1024; b = uc >> 3; h = (uc >> 1) & 3; const int qb = uc & 1; qrow0 = ML + b * 256 + qb * 128; kv0 = QB + (size_t)(ML + b * 256) * LDB_; nt0 = 4; kv1 = kv0; nt1 = 0; }
    const int qrow = qrow0 + 32 * qs + r32;
    const bf16* qptr = QB + (size_t)qrow * LDB_ + (2 * h + s) * 64 + 8 * hi;
    float m_run = -1e30f, l_run = 0.f; f32x16 o[4];
#pragma unroll
    for (int dv = 0; dv < 4; ++dv)
#pragma unroll
        for (int i = 0; i < 16; ++i) o[dv][i] = 0.f;
    attn_core<128, true>(lds, qptr, kv0, nt0, kv1, nt1, LDB_, 512 + 128 * h, 1024 + 128 * h, s, false, 0, 0, m_run, l_run, o);
    const float inv = 1.f / (l_run + __shfl_xor(l_run, 32));
    LAS float* X = (LAS float*)(lds + 65536);
    if (s == 1) {
#pragma unroll
        for (int dv = 0; dv < 4; ++dv)
#pragma unroll
            for (int i = 0; i < 16; ++i) X[(qs * 64 + dv * 16 + i) * 64 + lane] = o[dv][i] * inv;
    }
    __syncthreads();
    if (s == 0) {
        float ss = 0.f;
#pragma unroll
        for (int dv = 0; dv < 4; ++dv)
#pragma unroll
            for (int i = 0; i < 16; ++i) { const float d = o[dv][i] * inv - lam * X[(qs * 64 + dv * 16 + i) * 64 + lane]; o[dv][i] = d; ss += d * d; }
        ss += __shfl_xor(ss, 32);
        const float rs = __builtin_amdgcn_rsqf(ss * (1.f / 128.f) + EPS) * (1.f - lam_init);
        bf16* op = OB + (size_t)qrow * 512 + h * 128;
#pragma unroll
        for (int dv = 0; dv < 4; ++dv)
#pragma unroll
            for (int i4 = 0; i4 < 4; ++i4) { const int e0 = 32 * dv + 8 * i4 + 4 * hi; const f32x4 g = *(const f32x4*)(gdiff + e0);
                u32x2 w; w.x = pk2(o[dv][4 * i4] * rs * g[0], o[dv][4 * i4 + 1] * rs * g[1]); w.y = pk2(o[dv][4 * i4 + 2] * rs * g[2], o[dv][4 * i4 + 3] * rs * g[3]);
                *(u32x2*)(op + e0) = w; }
    }
    __syncthreads();
}

__device__ __forceinline__ void mixA_unit(LAS unsigned char* lds, int ua, const bf16* QA, bf16* OA, const float* sink) {
    int tid_l = threadIdx.x; asm volatile("" : "+v"(tid_l));
    const int tid = tid_l, lane = tid & 63, r32 = lane & 31, hi = lane >> 5, wid = __builtin_amdgcn_readfirstlane(tid >> 6), qs = wid & 3;
    int b, qb, kvh, pair, qrow0, nt0, nt1, kpos0; const bf16 *kv0, *kv1; bool domask;
    if (ua < 1024) { b = ua >> 7; qb = (ua >> 2) & 31; kvh = (ua >> 1) & 1; pair = ua & 1; qrow0 = b * 4096 + qb * 128;
        const int ks = qb * 128 - 128 < 0 ? 0 : qb * 128 - 128, ke = qb * 128 + 256 > SEQ ? SEQ : qb * 128 + 256;
        kpos0 = ks; nt0 = (ke - ks) >> 6; kv0 = QA + (size_t)(b * 4096 + ks) * LDA_; kv1 = QA + (size_t)(ML + b * 256) * LDA_; nt1 = 4; domask = true; }
    else { const int uc = ua - 1024; b = uc >> 3; qb = (uc >> 2) & 1; kvh = (uc >> 1) & 1; pair = uc & 1; qrow0 = ML + b * 256 + qb * 128;
        kpos0 = 0; nt0 = 4; kv0 = QA + (size_t)(ML + b * 256) * LDA_; kv1 = kv0; nt1 = 0; domask = false; }
    const int head = 4 * kvh + 2 * pair + (wid >> 2);
    const int qrow = qrow0 + 32 * qs + r32;
    const bf16* qptr = QA + (size_t)qrow * LDA_ + head * 64 + 8 * hi;
    float m_run = sink[head] * LOG2E, l_run = hi == 0 ? 1.f : 0.f; f32x16 o[2];
#pragma unroll
    for (int dv = 0; dv < 2; ++dv)
#pragma unroll
        for (int i = 0; i < 16; ++i) o[dv][i] = 0.f;
    attn_core<64, false>(lds, qptr, kv0, nt0, kv1, nt1, LDA_, 512 + 64 * kvh, 640 + 64 * kvh, 0, domask, qb * 128 + 32 * qs + r32, kpos0, m_run, l_run, o);
    const float inv = 1.f / (l_run + __shfl_xor(l_run, 32));
    bf16* op = OA + (size_t)qrow * 512 + head * 64;
#pragma unroll
    for (int dv = 0; dv < 2; ++dv)
#pragma unroll
        for (int i4 = 0; i4 < 4; ++i4) { const int e0 = 32 * dv + 8 * i4 + 4 * hi;
            u32x2 w; w.x = pk2(o[dv][4 * i4] * inv, o[dv][4 * i4 + 1] * inv); w.y = pk2(o[dv][4 * i4 + 2] * inv, o[dv][4 * i4 + 3] * inv);
            *(u32x2*)(op + e0) = w; }
}

constexpr int ML_QI = 0, ML_KI = 34816, ML_VI = 67584, ML_CI = 100352, ML_VEC = 135168;
__device__ __forceinline__ void mlstm_unit(LAS unsigned char* lds, int unit, const bf16* QC, const float* CG, const float* bgate, bf16* HF, bf16* HB, bool need_ctx) {
    int tid_l = threadIdx.x; asm volatile("" : "+v"(tid_l));
    const int wid = __builtin_amdgcn_readfirstlane(tid_l >> 6);
    const int b = unit >> 3, h = (unit >> 1) & 3, dir = unit & 1;
    bf16* Hout = dir ? HB : HF;
    const int gi_col = 8 * dir + h, gf_col = 8 * dir + 4 + h;
    const float bi = bgate[gi_col], bfb = bgate[gf_col];
    LAS float* cvec = (LAS float*)(lds + ML_VEC);
    LAS float* rvec = cvec + 128;
    LAS float* avec = cvec + 256;
    LAS float* evec = cvec + 384;
    LAS float* nvec = cvec + 512;
    for (int i = tid_l; i < 34816 / 4; i += 512) ((LAS unsigned*)(lds + ML_CI))[i] = 0u;
    if (tid_l < 128) nvec[tid_l] = 0.f;
    f32x16 Cst[2];
#pragma unroll
    for (int et = 0; et < 2; ++et)
#pragma unroll
        for (int i = 0; i < 16; ++i) Cst[et][i] = 0.f;
    float m_st = 0.f;
    for (int step = 0; step < 34; ++step) {
        asm volatile("" : "+v"(tid_l));
        const int tid = tid_l, lane = tid & 63, r32 = lane & 31, hi = lane >> 5;
        const int q4 = (lane & 15) >> 2, p4 = lane & 3, g1 = (lane >> 4) & 1;
        int base;
        if (step < 2) { const int cj = dir ? 1 - step : step; base = ML + b * 256 + 128 * cj; }
        else { const int lj = step - 2; const int cj = dir ? 31 - lj : lj; base = b * 4096 + 128 * cj; }
        u32x4 st[12];
        {
            const int tau = (tid >> 4), ch = tid & 15;
#pragma unroll
            for (int p = 0; p < 12; ++p) { const int tt = (p & 3) * 32 + tau; const int gr = base + (dir ? 127 - tt : tt);
                st[p] = *(const u32x4*)(QC + (size_t)gr * LDC_ + (p >> 2) * 512 + h * 128 + ch * 8); }
        }
        float decay_r, factor_r;
        {
            const int t0 = lane, t1 = lane + 64;
            const int gr0 = base + (dir ? 127 - t0 : t0), gr1 = base + (dir ? 127 - t1 : t1);
            const float gi0 = CG[(size_t)gr0 * 16 + gi_col] + bi, gf0 = CG[(size_t)gr0 * 16 + gf_col] + bfb;
            const float gi1 = CG[(size_t)gr1 * 16 + gi_col] + bi, gf1 = CG[(size_t)gr1 * 16 + gf_col] + bfb;
            const float f0 = fminf(gf0, 0.f) - __logf(1.f + __expf(-fabsf(gf0))), f1 = fminf(gf1, 0.f) - __logf(1.f + __expf(-fabsf(gf1)));
            float s0 = f0, s1 = f1;
#pragma unroll
            for (int o = 1; o < 64; o <<= 1) { const float a = __shfl_up(s0, o), c = __shfl_up(s1, o); if (lane >= o) { s0 += a; s1 += c; } }
            s1 += __shfl(s0, 63);
            const float blast = __shfl(s1, 63);
            const float a0 = gi0 - s0, a1 = gi1 - s1;
            float pm0 = a0, pm1 = a1;
#pragma unroll
            for (int o = 1; o < 64; o <<= 1) { const float a = __shfl_up(pm0, o), c = __shfl_up(pm1, o); if (lane >= o) { pm0 = fmaxf(pm0, a); pm1 = fmaxf(pm1, c); } }
            pm1 = fmaxf(pm1, __shfl(pm0, 63));
            const float A0 = __shfl(pm1, 63);
            const float M0 = fmaxf(m_st, pm0), M1 = fmaxf(m_st, pm1);
            if (wid == 0) {
                cvec[t0] = __expf(a0 - A0); cvec[t1] = __expf(a1 - A0);
                rvec[t0] = __expf(A0 - M0); rvec[t1] = __expf(A0 - M1);
                avec[t0] = __expf(m_st - M0); avec[t1] = __expf(m_st - M1);
                evec[t0] = __expf(-s0 - M0); evec[t1] = __expf(-s1 - M1);
            }
            const float Ml = fmaxf(m_st, A0);
            decay_r = __expf(m_st - Ml); factor_r = __expf(A0 - Ml);
            m_st = blast + Ml;
        }
        __syncthreads();
        {
            const int tau = (tid >> 4), ch = tid & 15;
#pragma unroll
            for (int p = 0; p < 12; ++p) { const int tt = (p & 3) * 32 + tau;
                if (p < 4) *(LAS u32x4*)(lds + ML_QI + tt * 272 + ch * 16) = st[p];
                else if (p < 8) { const float c = cvec[tt]; u32x4 v = st[p];
                    v.x = pk2(bflo(v.x) * c, bfhi(v.x) * c); v.y = pk2(bflo(v.y) * c, bfhi(v.y) * c); v.z = pk2(bflo(v.z) * c, bfhi(v.z) * c); v.w = pk2(bflo(v.w) * c, bfhi(v.w) * c);
                    *(LAS u32x4*)(lds + ML_KI + offb(tt, ch)) = v; }
                else *(LAS u32x4*)(lds + ML_VI + offb(tt, ch)) = st[p]; }
        }
        __syncthreads();
        {
            const int tb = wid & 3, eh = wid >> 2, t = 32 * tb + r32;
            const float rr = rvec[t], aa = avec[t], em = evec[t];
            bf16x8 qf[8];
#pragma unroll
            for (int d0 = 0; d0 < 8; ++d0) qf[d0] = *(const LAS bf16x8*)(lds + ML_QI + t * 272 + (16 * d0 + 8 * hi) * 2);
            f32x16 hh2[2]; float den1 = 0.f;
#pragma unroll
            for (int et = 0; et < 2; ++et) {
#pragma unroll
                for (int i = 0; i < 16; ++i) hh2[et][i] = 0.f;
#pragma unroll
                for (int d0 = 0; d0 < 8; ++d0) { const bf16x8 cf = *(const LAS bf16x8*)(lds + ML_CI + (32 * (2 * eh + et) + r32) * 272 + (16 * d0 + 8 * hi) * 2);
                    hh2[et] = __builtin_amdgcn_mfma_f32_32x32x16_bf16(cf, qf[d0], hh2[et], 0, 0, 0); }
#pragma unroll
                for (int i = 0; i < 16; ++i) hh2[et][i] *= aa;
            }
            float den2 = 0.f;
#pragma unroll
            for (int d0 = 0; d0 < 8; ++d0) { const f32x4 n0 = *(const LAS f32x4*)(nvec + 16 * d0 + 8 * hi), n1 = *(const LAS f32x4*)(nvec + 16 * d0 + 8 * hi + 4);
                const u32x4 qq = __builtin_bit_cast(u32x4, qf[d0]);
                den2 += bflo(qq.x) * n0[0] + bfhi(qq.x) * n0[1] + bflo(qq.y) * n0[2] + bfhi(qq.y) * n0[3] + bflo(qq.z) * n1[0] + bfhi(qq.z) * n1[1] + bflo(qq.w) * n1[2] + bfhi(qq.w) * n1[3]; }
            for (int sb = 0; sb <= tb; ++sb) {
                f32x16 g;
#pragma unroll
                for (int i = 0; i < 16; ++i) g[i] = 0.f;
#pragma unroll
                for (int d0 = 0; d0 < 8; ++d0) { const bf16x8 kf = *(const LAS bf16x8*)(lds + ML_KI + offb(32 * sb + r32, 2 * d0 + hi)); g = __builtin_amdgcn_mfma_f32_32x32x16_bf16(kf, qf[d0], g, 0, 0, 0); }
                if (sb == tb) {
#pragma unroll
                    for (int i = 0; i < 16; ++i) if (crow(i, hi) > r32) g[i] = 0.f; }
#pragma unroll
                for (int i = 0; i < 16; ++i) { g[i] *= rr; den1 += g[i]; }
#pragma unroll
                for (int ks = 0; ks < 2; ++ks) {
                    u32x4 pw; pw.x = pk2(g[8 * ks], g[8 * ks + 1]); pw.y = pk2(g[8 * ks + 2], g[8 * ks + 3]); pw.z = pk2(g[8 * ks + 4], g[8 * ks + 5]); pw.w = pk2(g[8 * ks + 6], g[8 * ks + 7]);
                    const bf16x8 pf = __builtin_bit_cast(bf16x8, pw);
                    const int krow = 32 * sb + 16 * ks + 4 * hi + q4;
#pragma unroll
                    for (int et = 0; et < 2; ++et) { const int ch = 4 * (2 * eh + et) + 2 * g1 + (p4 >> 1);
                        const s16x4 lo = trrd(lds + ML_VI + offb(krow, ch) + 8 * (p4 & 1)), hh = trrd(lds + ML_VI + offb(krow + 8, ch) + 8 * (p4 & 1));
                        hh2[et] = __builtin_amdgcn_mfma_f32_32x32x16_bf16(cat8(lo, hh), pf, hh2[et], 0, 0, 0); }
                }
            }
            den1 += __shfl_xor(den1, 32); den2 += __shfl_xor(den2, 32);
            const float den = den1 + aa * den2; const float inv = 1.f / fmaxf(fabsf(den), em);
            if (need_ctx || step >= 2) {
                const int gr = base + (dir ? 127 - t : t);
                bf16* op = Hout + (size_t)gr * 512 + h * 128;
#pragma unroll
                for (int et = 0; et < 2; ++et)
#pragma unroll
                    for (int i4 = 0; i4 < 4; ++i4) { const int e0 = 32 * (2 * eh + et) + 8 * i4 + 4 * hi;
                        u32x2 w; w.x = pk2(hh2[et][4 * i4] * inv, hh2[et][4 * i4 + 1] * inv); w.y = pk2(hh2[et][4 * i4 + 2] * inv, hh2[et][4 * i4 + 3] * inv);
                        *(u32x2*)(op + e0) = w; }
            }
        }
        __syncthreads();
        {
            const int db = wid & 3, eg = wid >> 2;
            f32x16 cl[2]; float nl = 0.f;
#pragma unroll
            for (int et = 0; et < 2; ++et)
#pragma unroll
                for (int i = 0; i < 16; ++i) cl[et][i] = 0.f;
#pragma unroll 2
            for (int ks = 0; ks < 8; ++ks) {
                const int trow = 16 * ks + 8 * hi + q4;
                const int chk = 4 * db + 2 * g1 + (p4 >> 1);
                const s16x4 klo = trrd(lds + ML_KI + offb(trow, chk) + 8 * (p4 & 1)), khi = trrd(lds + ML_KI + offb(trow + 4, chk) + 8 * (p4 & 1));
                const bf16x8 kT = cat8(klo, khi);
                const u32x4 kk = __builtin_bit_cast(u32x4, kT);
                nl += bflo(kk.x) + bfhi(kk.x) + bflo(kk.y) + bfhi(kk.y) + bflo(kk.z) + bfhi(kk.z) + bflo(kk.w) + bfhi(kk.w);
#pragma unroll
                for (int et = 0; et < 2; ++et) { const int chv = 4 * (2 * eg + et) + 2 * g1 + (p4 >> 1);
                    const s16x4 vlo = trrd(lds + ML_VI + offb(trow, chv) + 8 * (p4 & 1)), vhi = trrd(lds + ML_VI + offb(trow + 4, chv) + 8 * (p4 & 1));
                    cl[et] = __builtin_amdgcn_mfma_f32_32x32x16_bf16(kT, cat8(vlo, vhi), cl[et], 0, 0, 0); }
            }
            nl += __shfl_xor(nl, 32);
            const float decay = decay_r, factor = factor_r;
#pragma unroll
            for (int et = 0; et < 2; ++et) {
#pragma unroll
                for (int i = 0; i < 16; ++i) Cst[et][i] = decay * Cst[et][i] + factor * cl[et][i];
                const int e = 32 * (2 * eg + et) + r32;
#pragma unroll
                for (int i4 = 0; i4 < 4; ++i4) { u32x2 w; w.x = pk2(Cst[et][4 * i4], Cst[et][4 * i4 + 1]); w.y = pk2(Cst[et][4 * i4 + 2], Cst[et][4 * i4 + 3]);
                    *(LAS u32x2*)(lds + ML_CI + e * 272 + (32 * db + 8 * i4 + 4 * hi) * 2) = w; }
            }
            if (eg == 0 && hi == 0) nvec[32 * db + r32] = decay * nvec[32 * db + r32] + factor * nl;
        }
        __syncthreads();
    }
}

__device__ __forceinline__ void load_row(const float* p, int lane, f32x4 (&v)[4]) {
#pragma unroll
    for (int j = 0; j < 4; ++j) v[j] = *(const f32x4*)(p + 4 * lane + 256 * j);
}
__device__ __forceinline__ float row_rstd(const f32x4 (&v)[4]) {
    float s = 0.f;
#pragma unroll
    for (int j = 0; j < 4; ++j) s += v[j][0] * v[j][0] + v[j][1] * v[j][1] + v[j][2] * v[j][2] + v[j][3] * v[j][3];
    return __builtin_amdgcn_rsqf(wave_sum(s) * (1.f / D) + EPS);
}
__device__ __forceinline__ void norm_mod_store(const f32x4 (&v)[4], const float* g, const float* shift, const float* scale, bf16* out, int lane) {
    const float rs = row_rstd(v);
#pragma unroll
    for (int j = 0; j < 4; ++j) { const int c = 4 * lane + 256 * j; const f32x4 gg = *(const f32x4*)(g + c), sh = *(const f32x4*)(shift + c), sc = *(const f32x4*)(scale + c);
        const f32x4 y = (v[j] * rs * gg) * (sc + 1.f) + sh;
        u32x2 w; w.x = pk2(y[0], y[1]); w.y = pk2(y[2], y[3]); *(u32x2*)(out + c) = w; }
}

template <class MapF>
__device__ __forceinline__ void wt_item(const MapF& mf, int K, int src_ld, bf16* dst, int item, int nblk, LAS float* scr, int lane) {
    const int kb = item / nblk, nb = item % nblk, k0 = 64 * kb, n0 = 32 * nb;
    const float* sp; float sc; mf(n0 + (lane & 31), sp, sc);
#pragma unroll 8
    for (int i = 0; i < 32; ++i) { const int kk = 2 * i + (lane >> 5); scr[kk * 33 + (lane & 31)] = sp ? sp[(size_t)(k0 + kk) * src_ld] * sc : 0.f; }
    LDS_WAIT(); asm volatile("" ::: "memory");
    const int c = lane & 7;
#pragma unroll
    for (int j = 0; j < 4; ++j) { const int n = (lane >> 3) + 8 * j; const LAS float* s = scr + (8 * c) * 33 + n;
        u32x4 o; o.x = pk2(s[0 * 33], s[1 * 33]); o.y = pk2(s[2 * 33], s[3 * 33]); o.z = pk2(s[4 * 33], s[5 * 33]); o.w = pk2(s[6 * 33], s[7 * 33]);
        *(u32x4*)(dst + (size_t)(n0 + n) * K + k0 + 8 * c) = o; }
    LDS_WAIT(); asm volatile("" ::: "memory");
}
__device__ __forceinline__ int permd(int p) { const int i = p >> 3, w = p & 7; return (i < 4 ? 0 : 32) + (w < 4 ? 0 : 16) + 4 * (i & 3) + (w & 3); }
struct MapWin { const float* w;
    __device__ __forceinline__ void operator()(int n, const float*& sp, float& sc) const {
        if (n >= 4368) { sp = nullptr; sc = 0.f; return; }
        int col = n; sc = 1.f;
        if (n < 640 || (n >= 768 && n < 1792)) col = (n & ~63) + permd(n & 63);
        if (n < 512 || (n >= 768 && n < 1280)) sc = 0.125f * LOG2E;
        if (n >= 2816 && n < 3328) sc = 0.08838834764831845f;
        sp = w + col; } };
struct MapLin { const float* w; int off, nvalid;
    __device__ __forceinline__ void operator()(int n, const float*& sp, float& sc) const { sc = 1.f; sp = n < nvalid ? w + off + n : nullptr; } };
struct MapGU { const float* g; long du;
    __device__ __forceinline__ void operator()(int n, const float*& sp, float& sc) const { const int i = n >> 3, w = n & 7, j = 4 * i + (w & 3); sc = 1.f; sp = g + (j + (w < 4 ? 0l : du)); } };

__global__ void __launch_bounds__(512, 2) fwd_kernel(Args args) {
    extern __shared__ __attribute__((aligned(16))) unsigned char lds_raw[];
    LAS unsigned char* lds = (LAS unsigned char*)lds_raw;
    const int G = gridDim.x, bx = blockIdx.x, NGW = G * 8;
    GAS unsigned char* const ws0 = args.ws;
    unsigned* ctl = (unsigned*)(ws0 + WS_CTL);
#define PH_BEGIN int tid_p = threadIdx.x; asm volatile("" : "+v"(tid_p)); const int tid = tid_p, lane = tid & 63, wid = __builtin_amdgcn_readfirstlane(tid >> 6), gw = bx * 8 + wid; \
    GAS unsigned char* ws = ws0; asm volatile("" : "+s"(ws)); (void)lane; (void)gw;
    volatile LAS unsigned* MISC = (volatile LAS unsigned*)(lds + LDS_MISC);
    LAS int* tab = (LAS int*)(lds + LDS_TAB);
    if (threadIdx.x < 32) MISC[threadIdx.x] = 0u;
    __syncthreads();
#if ONE_LAUNCH
    XcdBarrier bar = xcd_barrier_post(ctl + CW_BAR, MISC + 8);
#define GRID_BAR() xcd_barrier(bar)
#else
#define GRID_BAR() do {} while (0)
#endif
    const int lo = args.lo, hi_ = args.hi;
#define IN(k) (lo <= (k) && (k) < hi_)
    CArgsP akp = (CArgsP)__builtin_amdgcn_kernarg_segment_ptr();
#define AIN(i) ((const float*)(launder_args(akp)->in[i]))
#define SEAM(k) do { if (IN(k) && IN((k) + 1)) GRID_BAR(); } while (0)

#define x_in AIN(0)
#define c_in AIN(1)
#define ctx_in AIN(2)
#define cctx_in AIN(3)
#define mods ((float*)(ws + WS_MODS))
#define rope ((float*)(ws + WS_ROPE))
#define lamv ((float*)(ws + WS_LAM))
#define HL ((bf16*)(ws + WS_HL))
#define XWC ((float*)(ws + WS_XWC))
#define XWL ((float*)(launder_args(akp)->out))
#define QA ((bf16*)(ws + WS_QA))
#define QB ((bf16*)(ws + WS_QB))
#define QC ((bf16*)(ws + WS_QC))
#define OA ((bf16*)(ws + WS_OA))
#define OB ((bf16*)(ws + WS_OB))
#define HF ((bf16*)(ws + WS_HF))
#define HB ((bf16*)(ws + WS_HB))
#define GT ((bf16*)(ws + WS_GT))
#define Y ((bf16*)(ws + WS_Y))
#define CG ((float*)(ws + WS_CG))
#define LOG ((float*)(ws + WS_LOG))
#define TOKE ((int*)(ws + WS_TOKE))
#define TOKP ((int*)(ws + WS_TOKP))
#define ELIST ((int*)(ws + WS_ELIST))
#define WLIST ((float*)(ws + WS_WLIST))
#define WIN ((bf16*)(ws + WS_WIN))
#define WGT ((bf16*)(ws + WS_WGT))
#define WA ((bf16*)(ws + WS_WA))
#define WB ((bf16*)(ws + WS_WB))
#define WC ((bf16*)(ws + WS_WC))
#define WO ((bf16*)(ws + WS_WO))
#define WR ((bf16*)(ws + WS_WR))
#define WGU ((bf16*)(ws + WS_WGU))
#define WD ((bf16*)(ws + WS_WD))
#define A2 ((bf16*)(ws + WS_A2))
#define Y2 ((bf16*)(ws + WS_Y2))
    if (IN(0)) {
        PH_BEGIN
        LAS float* sc = (LAS float*)lds;
        for (int i = tid; i < 9 * 1024; i += 512) { const int b = i >> 10, k = i & 1023; const float cv = b < 8 ? c_in[b * 1024 + k] : cctx_in[k]; sc[i] = cv * sigm(cv); }
        __syncthreads();
        LAS float* red = sc + 9 * 1024;
        for (int unit = bx; unit < 192; unit += G) {
            const int l = unit / 96, n0 = (unit % 96) * 64, cl = tid & 63, ks = tid >> 6;
            float acc[9];
#pragma unroll
            for (int b = 0; b < 9; ++b) acc[b] = 0.f;
            const float* w = AIN(4) + (size_t)l * 1024 * 6144 + n0 + cl;
            for (int k = 128 * ks; k < 128 * ks + 128; ++k) { const float wv = w[(size_t)k * 6144];
#pragma unroll
                for (int b = 0; b < 9; ++b) acc[b] += sc[b * 1024 + k] * wv; }
#pragma unroll
            for (int b = 0; b < 9; ++b) red[(ks * 9 + b) * 64 + cl] = acc[b];
            __syncthreads();
            for (int i = tid; i < 9 * 64; i += 512) { const int b = i >> 6, c2 = i & 63; float s = 0.f;
#pragma unroll
                for (int k2 = 0; k2 < 8; ++k2) s += red[(k2 * 9 + b) * 64 + c2];
                mods[(size_t)(l * 9 + b) * 6144 + n0 + c2] = s + AIN(5)[l * 6144 + n0 + c2]; }
            __syncthreads();
        }
        if (bx == G - 1) {
            for (int i = tid; i < 1024; i += 512) { const int pos = i >> 4, j = i & 15; const float inv = ex2(-(float)j * (13.287712379549449f / 16.f)); const float ang = (float)pos * inv;
                rope[i] = __cosf(ang); rope[1024 + i] = __sinf(ang); }
            if (wid == 0) {
#pragma unroll
                for (int l = 0; l < 2; ++l) { const float a = wave_sum(AIN(11)[l * 64 + lane] * AIN(12)[l * 64 + lane]), b2 = wave_sum(AIN(13)[l * 64 + lane] * AIN(14)[l * 64 + lane]);
                    const float li = 0.8f - 0.6f * __expf(-0.3f * (float)l);
                    if (lane == 0) lamv[l] = __expf(a) - __expf(b2) + li; }
            }
        }
    }
    SEAM(0);

    for (int layer = 0; layer < 2; ++layer) {
        const int P0 = 1 + layer * NPH;
        const bool need_ctx = layer == 0;
        const int Mx = need_ctx ? MA : ML;
        const int Mh = Mx / 2;
#define modl (mods + (size_t)layer * 9 * 6144)
        const float lam_init = 0.8f - 0.6f * __expf(-0.3f * (float)layer);

        if (IN(P0 + 0)) {
            PH_BEGIN
            LAS float* scr = (LAS float*)(lds + wid * 8448);
            const float* w_in = AIN(8) + (size_t)layer * 1024 * NIN;
            for (int it = gw; it < 5248; it += NGW) {
                int r = it;
                if (r < 2304) { MapWin mf{w_in}; wt_item(mf, 1024, NIN, WIN, r, 144, scr, lane); continue; } r -= 2304;
                if (r < 1536) { MapLin mf{w_in, 4368, 3072}; wt_item(mf, 1024, NIN, WGT, r, 96, scr, lane); continue; } r -= 1536;
                if (r < 768) { const int which = r >> 8; const float* src = AIN(17 + which) + (size_t)layer * 512 * 1024; MapLin mf{src, 0, 1024};
                    wt_item(mf, 512, 1024, which == 0 ? WA : (which == 1 ? WB : WC), r & 255, 32, scr, lane); continue; } r -= 768;
                if (r < 512) { MapLin mf{AIN(20) + (size_t)layer * 1024 * 1024, 0, 1024}; wt_item(mf, 1024, 1024, WO, r, 32, scr, lane); continue; } r -= 512;
                { MapLin mf{AIN(21) + (size_t)layer * 1024 * 64, 0, 64}; wt_item(mf, 1024, 64, WR, r, 8, scr, lane); }
            }
            if (layer == 0) {
                for (int m = gw; m < MA; m += NGW) {
                    const float* xr = m < ML ? x_in + (size_t)m * D : ctx_in + (size_t)(m - ML) * D;
                    const float* mv = modl + (m < ML ? (m >> 12) : 8) * 6144;
                    f32x4 v[4]; load_row(xr, lane, v);
                    norm_mod_store(v, AIN(6) + layer * D, mv, mv + 1024, HL + (size_t)m * D, lane);
                }
            }
        }
        SEAM(P0 + 0);

        if (IN(P0 + 1)) {
            PH_BEGIN
            pg8::DenseSched S; S.init(HL, WIN, MA, N1, 1024, G, bx);
            EpiG1 E{QA, QB, QC, CG, rope};
            pg8::gemm_phase(lds, 1024, S, E);
        }
        SEAM(P0 + 1);

        if (IN(P0 + 2)) {
            PH_BEGIN
            unsigned* wq = ctl + CW_WQ + 64 * (layer * 4);
            for (;;) {
                if (tid == 0) MISC[0] = atomicAdd(wq, 1u);
                __syncthreads();
                const int u = (int)MISC[0];
                __syncthreads();
                if (u >= 64) break;
                mlstm_unit(lds, u, QC, CG, AIN(9) + layer * 16, HF, HB, need_ctx);
            }
            const int nB = need_ctx ? 1088 : 1024;
            const float lam = lamv[layer];
            for (;;) {
                if (tid == 0) MISC[0] = atomicAdd(wq + 64, 1u);
                __syncthreads();
                const int u = (int)MISC[0];
                __syncthreads();
                if (u >= nB) break;
                mixB_unit(lds, u, QB, OB, AIN(15) + layer * 128, lam, lam_init);
            }
            for (;;) {
                if (tid == 0) MISC[0] = atomicAdd(wq + 128, 1u);
                __syncthreads();
                const int u = (int)MISC[0];
                __syncthreads();
                if (u >= nB) break;
                mixA_unit(lds, u, QA, OA, AIN(10) + layer * 8);
                __syncthreads();
            }
        }
        SEAM(P0 + 2);

        if (IN(P0 + 3)) {
            PH_BEGIN
            const float* gm = AIN(16) + layer * 512;
            for (int m = gw; m < Mx; m += NGW) {
                const u32x4 a = *(const u32x4*)(HF + (size_t)m * 512 + 8 * lane), b = *(const u32x4*)(HB + (size_t)m * 512 + 8 * lane);
                const u32x4 co = *(const u32x4*)(QC + (size_t)m * LDC_ + 1536 + 8 * lane);
                float v[8];
                v[0] = bflo(a.x) + bflo(b.x); v[1] = bfhi(a.x) + bfhi(b.x); v[2] = bflo(a.y) + bflo(b.y); v[3] = bfhi(a.y) + bfhi(b.y);
                v[4] = bflo(a.z) + bflo(b.z); v[5] = bfhi(a.z) + bfhi(b.z); v[6] = bflo(a.w) + bflo(b.w); v[7] = bfhi(a.w) + bfhi(b.w);
                float ss = 0.f;
#pragma unroll
                for (int k = 0; k < 8; ++k) ss += v[k] * v[k];
                ss += __shfl_xor(ss, 1); ss += __shfl_xor(ss, 2); ss += __shfl_xor(ss, 4); ss += __shfl_xor(ss, 8);
                const float rs = __builtin_amdgcn_rsqf(ss * (1.f / 128.f) + EPS);
                const f32x4 g0 = *(const f32x4*)(gm + 8 * lane), g1v = *(const f32x4*)(gm + 8 * lane + 4);
                u32x4 w;
                w.x = pk2(v[0] * rs * g0[0] * sigm(bflo(co.x)), v[1] * rs * g0[1] * sigm(bfhi(co.x)));
                w.y = pk2(v[2] * rs * g0[2] * sigm(bflo(co.y)), v[3] * rs * g0[3] * sigm(bfhi(co.y)));
                w.z = pk2(v[4] * rs * g1v[0] * sigm(bflo(co.z)), v[5] * rs * g1v[1] * sigm(bfhi(co.z)));
                w.w = pk2(v[6] * rs * g1v[2] * sigm(bflo(co.w)), v[7] * rs * g1v[3] * sigm(bfhi(co.w)));
                *(u32x4*)(HF + (size_t)m * 512 + 8 * lane) = w;
            }
        }
        SEAM(P0 + 3);

        if (IN(P0 + 4)) {
            PH_BEGIN
            pg8::DenseSched S; S.init(HL, WGT, Mx, NGT, 1024, G, bx);
            EpiBf16 E{GT, NGT};
            pg8::gemm_phase(lds, 1024, S, E);
        }
        SEAM(P0 + 4);

        if (IN(P0 + 5)) {
            PH_BEGIN
            { pg8::DenseSched S; S.init(OA, WA, Mx, 1024, 512, G, bx); EpiGate E{GT, Y, 0}; pg8::gemm_phase(lds, 512, S, E); }
            { pg8::DenseSched S; S.init(OB, WB, Mx, 1024, 512, G, bx); EpiGate E{GT, Y, 1}; pg8::gemm_phase(lds, 512, S, E); }
            { pg8::DenseSched S; S.init(HF, WC, Mx, 1024, 512, G, bx); EpiGate E{GT, Y, 2}; pg8::gemm_phase(lds, 512, S, E); }
        }
        SEAM(P0 + 5);

        if (IN(P0 + 6)) {
            PH_BEGIN
            pg8::DenseSched S; S.init(Y, WO, Mx, 1024, 1024, G, bx);
            EpiRes E{layer == 0 ? x_in : XWL, layer == 0 ? ctx_in : XWC, XWL, XWC, modl + 2 * 1024, 0};
            pg8::gemm_phase(lds, 1024, S, E);
        }
        SEAM(P0 + 6);

        if (IN(P0 + 7)) {
            PH_BEGIN
            for (int m = gw; m < Mx; m += NGW) {
                const float* xr = m < ML ? XWL + (size_t)m * D : XWC + (size_t)(m - ML) * D;
                const float* mv = modl + (m < ML ? (m >> 12) : 8) * 6144;
                f32x4 v[4]; load_row(xr, lane, v);
                norm_mod_store(v, AIN(7) + layer * D, mv + 3 * 1024, mv + 4 * 1024, HL + (size_t)m * D, lane);
            }
            LAS float* scr = (LAS float*)(lds + wid * 8448);
            for (int it = gw; it < 24960; it += NGW) {
                if (it < 16640) { const int e = it >> 8, r = it & 255;
                    const float* gsrc = e < 64 ? AIN(23) + (size_t)(layer * 64 + e) * 1024 * 256 : AIN(26) + (size_t)layer * 1024 * 256;
                    const float* usrc = e < 64 ? AIN(24) + (size_t)(layer * 64 + e) * 1024 * 256 : AIN(27) + (size_t)layer * 1024 * 256;
                    MapGU mf{gsrc, (long)(usrc - gsrc)}; wt_item(mf, 1024, 256, WGU + (size_t)e * 512 * 1024, r, 16, scr, lane); }
                else { const int r2 = it - 16640, e = r2 >> 7, r = r2 & 127;
                    const float* src = e < 64 ? AIN(25) + (size_t)(layer * 64 + e) * 256 * 1024 : AIN(28) + (size_t)layer * 256 * 1024;
                    MapLin mf{src, 0, 1024}; wt_item(mf, 256, 1024, WD + (size_t)e * 1024 * 256, r, 32, scr, lane); }
            }
        }
        SEAM(P0 + 7);

        if (IN(P0 + 8)) {
            PH_BEGIN
            pg8::DenseSched S; S.init(HL, WR, Mx, 256, 1024, G, bx);
            EpiLogits E{LOG};
            pg8::gemm_phase(lds, 1024, S, E);
        }
        SEAM(P0 + 8);

        if (IN(P0 + 9)) {
            PH_BEGIN
            const float* br = AIN(22) + layer * 64;
            const float bias = br[lane];
            for (int m = gw; m < Mx; m += NGW) {
                const int half = m >= Mh ? 1 : 0;
                const float sg = sigm(LOG[(size_t)m * 64 + lane]);
                const float sel = sg + bias;
                float m1 = sel; m1 = fmaxf(m1, __shfl_xor(m1, 1)); m1 = fmaxf(m1, __shfl_xor(m1, 2)); m1 = fmaxf(m1, __shfl_xor(m1, 4));
                const unsigned long long bm = __ballot(sel == m1);
                const unsigned gmask = (unsigned)(bm >> (lane & 56)) & 0xffu;
                const int first = __builtin_ctz(gmask);
                float v2 = ((lane & 7) == first) ? -3.0e38f : sel;
                v2 = fmaxf(v2, __shfl_xor(v2, 1)); v2 = fmaxf(v2, __shfl_xor(v2, 2)); v2 = fmaxf(v2, __shfl_xor(v2, 4));
                const float gsc = m1 + v2; const int g = lane >> 3;
                int gr = 0;
#pragma unroll
                for (int g2 = 0; g2 < 8; ++g2) { const float o = __shfl(gsc, 8 * g2); gr += (o > gsc || (o == gsc && g2 < g)) ? 1 : 0; }
                const bool gsel = gr < 4;
                const float mv = gsel ? sel : -3.0e38f;
                int rank = 0;
#pragma unroll 8
                for (int e2 = 0; e2 < 64; ++e2) { const float o = __shfl(mv, e2); rank += (o > mv || (o == mv && e2 < lane)) ? 1 : 0; }
                const bool chosen = gsel && rank < 8;
                const float ssum = wave_sum(chosen ? sg : 0.f);
                if (chosen) {
                    const float w = sg / ssum * 2.5f;
                    const int pos = (int)atomicAdd(ctl + CW_CNT + 16 * ((layer * 2 + half) * 64 + lane), 1u);
                    ELIST[((size_t)half * 64 + lane) * CAP + pos] = m; WLIST[((size_t)half * 64 + lane) * CAP + pos] = w;
                    TOKE[(size_t)m * 8 + rank] = lane; TOKP[(size_t)m * 8 + rank] = pos;
#if DBG_I
                    if (m < ML) { XWL[(size_t)m * D + rank] = (float)lane; XWL[(size_t)m * D + 8 + rank] = w; }
#endif
                }
            }
        }
        SEAM(P0 + 9);

        for (int half = 0; half < 2; ++half) {
            const int PH = P0 + 10 + 3 * half;
            const int hbase = half * Mh;
            if (IN(PH) || IN(PH + 1) || IN(PH + 2)) {
                PH_BEGIN
                if (tid < 65) tab[tid] = tid < 64 ? (int)__hip_atomic_load(ctl + CW_CNT + 16 * ((layer * 2 + half) * 64 + tid), __ATOMIC_RELAXED, __HIP_MEMORY_SCOPE_AGENT) : Mh;
                __syncthreads();
                if (tid == 0) { int off = 0; for (int e = 0; e < 65; ++e) { tab[65 + e] = off; off += (tab[e] + 255) & ~255; } }
                __syncthreads();
            }
            if (IN(PH)) {
                PH_BEGIN
                if (tid == 0) { int us = 0; for (int e = 0; e < 65; ++e) { tab[130 + e] = us; us += ((tab[e] + 255) >> 8) * 2; } tab[195] = us; }
                __syncthreads();
                pg8::MoeSched<2, true> S; S.Abase = (const char*)HL; S.Bbase = (const char*)WGU; S.bstride = (size_t)512 * 1024 * 2; S.K = 1024; S.elist = ELIST + (size_t)half * 64 * CAP; S.tab = tab;
                S.hbase = hbase; S.nU = tab[195]; S.G = G; S.c = bx; S.NE = 65;
                EpiSwiGLU E{A2};
                pg8::gemm_phase(lds, 1024, S, E);
            }
            SEAM(PH);
            if (IN(PH + 1) && !DBG_H) {
                PH_BEGIN
                __syncthreads();
                if (tid == 0) { int us = 0; for (int e = 0; e < 64; ++e) { tab[130 + e] = us; us += ((tab[e] + 255) >> 8) * 4; } tab[194] = us; tab[195] = us; }
                __syncthreads();
                {
                    pg8::MoeSched<4, false> S; S.Abase = (const char*)A2; S.Bbase = (const char*)WD; S.bstride = (size_t)1024 * 256 * 2; S.K = 256; S.elist = nullptr; S.tab = tab;
                    S.hbase = hbase; S.nU = tab[195]; S.G = G; S.c = bx; S.NE = 64;
                    EpiY2 E{Y2, WLIST + (size_t)half * 64 * CAP};
                    pg8::gemm_phase(lds, 256, S, E);
                }
                {
                    pg8::DenseSched S; S.init(A2 + (size_t)tab[65 + 64] * 256, WD + (size_t)64 * 1024 * 256, Mh, 1024, 256, G, bx);
                    EpiRes E{XWL, XWC, XWL, XWC, modl + 5 * 1024, hbase};
                    pg8::gemm_phase(lds, 256, S, E);
                }
            }
            SEAM(PH + 1);
            if (IN(PH + 2)) {
                PH_BEGIN
                for (int m = hbase + gw; m < hbase + Mh; m += NGW) {
                    float* xr = m < ML ? XWL + (size_t)m * D : XWC + (size_t)(m - ML) * D;
                    const float* mv = modl + (m < ML ? (m >> 12) : 8) * 6144;
#if DBG_H
                    { f32x4 sa = (f32x4){0.f, 0.f, 0.f, 0.f};
                      for (int k = 0; k < 8; ++k) { const int e = TOKE[(size_t)m * 8 + k], pos = TOKP[(size_t)m * 8 + k];
                          const u32x2 y = *(const u32x2*)(A2 + (size_t)(tab[65 + e] + pos) * 256 + 4 * lane); sa[0] += bflo(y.x); sa[1] += bfhi(y.x); sa[2] += bflo(y.y); sa[3] += bfhi(y.y); }
                      *(f32x4*)(xr + 4 * lane) = sa; continue; }
#endif
                    f32x4 v[4]; load_row(xr, lane, v);
                    f32x4 s[4];
#pragma unroll
                    for (int j = 0; j < 4; ++j) s[j] = (f32x4){0.f, 0.f, 0.f, 0.f};
#pragma unroll
                    for (int k = 0; k < 8; ++k) {
                        const int e = TOKE[(size_t)m * 8 + k], pos = TOKP[(size_t)m * 8 + k];
                        const bf16* yr = Y2 + (size_t)(tab[65 + e] + pos) * 1024;
#pragma unroll
                        for (int j = 0; j < 4; ++j) { const u32x2 y = *(const u32x2*)(yr + 4 * lane + 256 * j); s[j][0] += bflo(y.x); s[j][1] += bfhi(y.x); s[j][2] += bflo(y.y); s[j][3] += bfhi(y.y); }
                    }
#pragma unroll
                    for (int j = 0; j < 4; ++j) { const f32x4 m5 = *(const f32x4*)(mv + 5 * 1024 + 4 * lane + 256 * j); v[j] = v[j] + m5 * s[j]; }
                    if (layer == 0) {
#pragma unroll
                        for (int j = 0; j < 4; ++j) *(f32x4*)(xr + 4 * lane + 256 * j) = v[j];
                        const float* mn = mods + (size_t)9 * 6144 + (m < ML ? (m >> 12) : 8) * 6144;
                        norm_mod_store(v, AIN(6) + D, mn, mn + 1024, HL + (size_t)m * D, lane);
                    } else {
                        const float rs = row_rstd(v);
#pragma unroll
                        for (int j = 0; j < 4; ++j) { const f32x4 gg = *(const f32x4*)(AIN(29) + 4 * lane + 256 * j); *(f32x4*)(xr + 4 * lane + 256 * j) = v[j] * rs * gg; }
                    }
                }
            }
            SEAM(PH + 2);
        }
    }
}

#if DBG_AMP
__global__ void dbg_sum(const unsigned* buf, size_t nwords, unsigned long long* acc) {
    unsigned long long s = 0;
    for (size_t i = (size_t)blockIdx.x * blockDim.x + threadIdx.x; i < nwords; i += (size_t)gridDim.x * blockDim.x) s += (unsigned long long)buf[i] * (unsigned long long)(i * 2654435761ull + 12345ull);
    for (int o = 32; o > 0; o >>= 1) s += __shfl_xor(s, o);
    if ((threadIdx.x & 63) == 0) atomicAdd(acc, s);
}
__global__ void dbg_fill(float* o, size_t off, size_t n, const unsigned long long* acc, float weight) {
    const unsigned long long a = *acc;
    for (size_t i = (size_t)blockIdx.x * blockDim.x + threadIdx.x; i < n; i += (size_t)gridDim.x * blockDim.x) {
        unsigned long long h = (a + i) * 0x9E3779B97F4A7C15ull; h ^= h >> 29; h *= 0xBF58476D1CE4E5B9ull; h ^= h >> 32;
        o[off + i] = weight * (float)(h & 0xffffff) * (1.f / 16777216.f); }
}
#endif
extern "C" void kernel_launch(void* const* d_in, const int* in_sizes, int n_in, void* d_out, int out_size, void* d_ws, size_t ws_size, hipStream_t stream) {
    static int grid = 0;
    if (grid == 0) {
        if (n_in != 30 || out_size != ML * D || ws_size < WS_END) { fprintf(stderr, "kernel_launch: unexpected problem (n_in %d, out %d, ws %zu < %zu)\n", n_in, out_size, ws_size, (size_t)WS_END); grid = -1; return; }
        int dev = 0, cus = 0, per_cu = 0;
        if (hipGetDevice(&dev) != hipSuccess || hipDeviceGetAttribute(&cus, hipDeviceAttributeMultiprocessorCount, dev) != hipSuccess) { grid = -1; return; }
        if (hipFuncSetAttribute((const void*)fwd_kernel, hipFuncAttributeMaxDynamicSharedMemorySize, LDS_BYTES) != hipSuccess) { fprintf(stderr, "kernel_launch: hipFuncSetAttribute failed\n"); grid = -1; return; }
        if (hipOccupancyMaxActiveBlocksPerMultiprocessor(&per_cu, (const void*)fwd_kernel, 512, LDS_BYTES) != hipSuccess || per_cu < 1) fprintf(stderr, "kernel_launch: occupancy query reports %d\n", per_cu);
        (void)hipGetLastError();
        grid = cus;
    }
    if (grid < 0) return;
    (void)hipMemsetAsync((char*)d_ws + WS_CTL, 0, 1 * MiB, stream);
    Args a{};
    for (int i = 0; i < 30; ++i) a.in[i] = (const GAS float*)d_in[i];
    a.out = (GAS float*)d_out; a.ws = (GAS unsigned char*)d_ws;
#if ONE_LAUNCH
    a.lo = 0; a.hi = NPHASE;
    hipLaunchKernelGGL(fwd_kernel, dim3(grid), dim3(512), LDS_BYTES, stream, a);
#else
#ifndef DBG_NPH
#define DBG_NPH NPHASE
#endif
    for (int p = 0; p < DBG_NPH; ++p) { a.lo = p; a.hi = p + 1; hipLaunchKernelGGL(fwd_kernel, dim3(grid), dim3(512), LDS_BYTES, stream, a); }
#if DBG_AMP
    {
        unsigned long long* accs = (unsigned long long*)((char*)d_ws + 2048);
        const size_t seg = (size_t)ML * D / 4;
        const size_t offs[4] = {DBG_B0, DBG_B1, DBG_B2, DBG_B3}; const size_t lens[4] = {DBG_L0, DBG_L1, DBG_L2, DBG_L3}; const float wts[4] = {1.f, 0.3f, 0.09f, 0.027f};
        for (int k = 0; k < 4; ++k) {
            hipLaunchKernelGGL(dbg_sum, dim3(2048), dim3(256), 0, stream, (const unsigned*)((char*)d_ws + offs[k]), lens[k] / 4, accs + k);
            hipLaunchKernelGGL(dbg_fill, dim3(2048), dim3(256), 0, stream, (float*)d_out, seg * k, seg, accs + k, wts[k]);
        }
    }
#endif
#endif
}
```

```cpp
#include <hip/hip_runtime.h>
#include <cstdio>
#include <cstdint>

#ifndef ONE_LAUNCH
#define ONE_LAUNCH 1
#endif
#ifndef REP_A
#define REP_A 1
#endif
#ifndef REP_B
#define REP_B 1
#endif
#ifndef REP_C
#define REP_C 1
#endif
#ifndef REP_G1
#define REP_G1 1
#endif
#ifndef REP_E1
#define REP_E1 1
#endif
#ifndef REP_E2
#define REP_E2 1
#endif
#ifndef DBG_DUP
#define DBG_DUP 0
#endif
#ifndef PROBE_MASK
#define PROBE_MASK 0
#endif
#define DBG_NPH NPHASE
#define DBG_H 0
#define DBG_I 0
#define DBG_AMP 0
#define DBG_X1 1
#define DBG_B0 WS_QC
#define DBG_L0 ((size_t)MA * 2048 * 2)
#define DBG_B1 WS_HF
#define DBG_L1 ((size_t)MA * 512 * 2)
#define DBG_B2 WS_HB
#define DBG_L2 ((size_t)MA * 512 * 2)
#define DBG_B3 WS_HB
#define DBG_L3 ((size_t)MA * 512 * 2)

#define LAS __attribute__((address_space(3)))
#define GAS __attribute__((address_space(1)))
typedef unsigned short bf16;
typedef short bf16x8 __attribute__((ext_vector_type(8)));
typedef short s16x4 __attribute__((ext_vector_type(4)));
typedef float f32x2 __attribute__((ext_vector_type(2)));
typedef float f32x4 __attribute__((ext_vector_type(4)));
typedef float f32x16 __attribute__((ext_vector_type(16)));
typedef unsigned u32x2 __attribute__((ext_vector_type(2)));
typedef unsigned u32x4 __attribute__((ext_vector_type(4)));
typedef __bf16 bf16x2_t __attribute__((ext_vector_type(2)));

constexpr int D = 1024, NBATCH = 8, SEQ = 4096, CTXL = 256;
constexpr int ML = NBATCH * SEQ;
constexpr int MC = NBATCH * CTXL;
constexpr int MA = ML + MC;
constexpr int NIN = 7440;
constexpr int N1 = 4608;
constexpr int NGT = 3072;
constexpr int LDA_ = 768, LDB_ = 1536, LDC_ = 2048;
constexpr float EPS = 1e-6f;
constexpr float LOG2E = 1.4426950408889634f;
constexpr int NPH = 16;
constexpr int NPHASE = 1 + 2 * NPH;
constexpr int CAP = 17408;

constexpr size_t MiB = 1ull << 20;
constexpr size_t WS_CTL = 0;
constexpr size_t WS_MODS = 1 * MiB;
constexpr size_t WS_ROPE = 1 * MiB + 512 * 1024;
constexpr size_t WS_LAM = WS_ROPE + 16384;
constexpr size_t WS_WIN = 8 * MiB;
constexpr size_t WS_WGT = 17 * MiB;
constexpr size_t WS_WA = 23 * MiB, WS_WB = 24 * MiB, WS_WC = 25 * MiB;
constexpr size_t WS_WO = 26 * MiB;
constexpr size_t WS_WR = 28 * MiB;
constexpr size_t WS_HL = 38 * MiB;
constexpr size_t WS_CG = 106 * MiB;
constexpr size_t WS_LOG = 109 * MiB;
constexpr size_t WS_TOKE = 118 * MiB;
constexpr size_t WS_TOKP = 119 * MiB + 512 * 1024;
constexpr size_t WS_ELIST = 121 * MiB;
constexpr size_t WS_WLIST = 130 * MiB;
constexpr size_t WS_BIG = 140 * MiB;
constexpr size_t WS_QA = WS_BIG;
constexpr size_t WS_QB = WS_BIG + 51 * MiB;
constexpr size_t WS_QC = WS_BIG + 153 * MiB;
constexpr size_t WS_XS = WS_BIG + 289 * MiB;
constexpr size_t WS_HF = WS_BIG + 357 * MiB;
constexpr size_t WS_HB = WS_BIG + 391 * MiB;
constexpr size_t WS_GT = WS_BIG;
constexpr size_t WS_Y = WS_BIG + 425 * MiB;
constexpr size_t WS_WGU = WS_BIG;
constexpr size_t WS_WD = WS_BIG + 33 * MiB;
constexpr size_t WS_A2 = WS_BIG + 50 * MiB;
constexpr size_t WS_Y2 = WS_BIG + 93 * MiB;
constexpr size_t WS_END = WS_BIG + 493 * MiB;
static_assert(WS_WGU + 65ull * 512 * 1024 <= WS_WD && WS_WD + 65ull * 1024 * 256 <= WS_A2 && WS_A2 + 172992ull * 256 <= WS_Y2 && WS_Y2 + 155584ull * 1024 <= WS_XS && WS_XS + (size_t)MA * 2048 <= WS_HF, "ws map");
constexpr int CW_BAR = 4096;
constexpr int CW_WQ = 8192;
constexpr int CW_CNT = 16384;

constexpr int LDS_TAB = 143360;
constexpr int LDS_MISC = 147456;
constexpr int LDS_BYTES = 151552;

struct Args { const GAS float* in[30]; GAS float* out; GAS unsigned char* ws; int lo, hi; };
typedef const __attribute__((address_space(4))) Args* CArgsP;
__device__ __forceinline__ CArgsP launder_args(CArgsP p) { asm volatile("" : "+s"(p)); return p; }

__device__ __forceinline__ unsigned pk2(float lo, float hi) { f32x2 v = {lo, hi}; bf16x2_t b = __builtin_convertvector(v, bf16x2_t); return __builtin_bit_cast(unsigned, b); }
__device__ __forceinline__ float bflo(unsigned u) { return __uint_as_float(u << 16); }
__device__ __forceinline__ float bfhi(unsigned u) { return __uint_as_float(u & 0xffff0000u); }
__device__ __forceinline__ float ex2(float x) { return __builtin_amdgcn_exp2f(x); }
__device__ __forceinline__ float sigm(float x) { return __builtin_amdgcn_rcpf(1.f + ex2(-LOG2E * x)); }
__device__ __forceinline__ float fadd_s(float a, float b) { float r = a + b; asm("" : "+v"(r)); return r; }
__device__ __forceinline__ float wave_sum(float v) {
#pragma unroll
    for (int o = 1; o < 64; o <<= 1) v += __shfl_xor(v, o);
    return v;
}
__device__ __forceinline__ int crow(int i, int hi) { return (i & 3) + 8 * (i >> 2) + 4 * hi; }
__device__ __forceinline__ int offb(int row, int ch) { return 256 * row + 16 * (ch ^ (((row & 3) << 2) | ((row >> 2) & 3))); }
typedef short v4i16_t __attribute__((ext_vector_type(4)));
__device__ __forceinline__ s16x4 trrd(LAS unsigned char* p) { return __builtin_bit_cast(s16x4, __builtin_amdgcn_ds_read_tr16_b64_v4i16((LAS v4i16_t*)p)); }
__device__ __forceinline__ bf16x8 cat8(s16x4 a, s16x4 b) { return (bf16x8){a[0], a[1], a[2], a[3], b[0], b[1], b[2], b[3]}; }
#define LDS_WAIT() asm volatile("s_waitcnt lgkmcnt(0)" ::: "memory")

#define XB_TMO      128
#define XB_XCNT(j)  (256  + 64 * (j))
#define XB_XSUB(j)  (1280 + 64 * (j))
#define XB_XGEN(j)  (2304 + 64 * (j))
#define XB_TOP      3328
#define XB_TOPGEN   3392
#define XCD_BAR_WORDS 3456
#define XB_SPIN_CAP (1u << 18)
__device__ __forceinline__ unsigned xb_ld(unsigned* p)              { return __hip_atomic_load(p, __ATOMIC_RELAXED, __HIP_MEMORY_SCOPE_AGENT); }
__device__ __forceinline__ unsigned xb_add(unsigned* p, unsigned v) { return __hip_atomic_fetch_add(p, v, __ATOMIC_RELAXED, __HIP_MEMORY_SCOPE_AGENT); }
__device__ __forceinline__ unsigned xb_xcc_id() { return (unsigned)__builtin_amdgcn_s_getreg((3 << 11) | 20) & 0xFu; }
#define XB_SPIN(cond, bar) do { unsigned _sp = 0; while (cond) { __builtin_amdgcn_s_sleep(1); \
    if ((++_sp & 255u) == 0u) { if (xb_ld(&(bar)[XB_TMO])) break; if (_sp > XB_SPIN_CAP) { atomicAdd(&(bar)[XB_TMO], 1u); break; } } } } while (0)
struct XcdBarrier { unsigned* bar; unsigned x; volatile LAS unsigned* st; };
__device__ __forceinline__ XcdBarrier xcd_barrier_post(unsigned* bar, volatile LAS unsigned* st) {
    XcdBarrier b; b.bar = bar; b.x = xb_xcc_id(); b.st = st;
    if (threadIdx.x == 0) (void)xb_add(&bar[XB_XCNT(b.x)], 1u);
    return b;
}
__device__ __forceinline__ void xcd_barrier_complete(unsigned* bar, unsigned x, unsigned& nloc, unsigned& nx) {
    const unsigned G = gridDim.x * gridDim.y * gridDim.z;
    unsigned sum, cnt, mine, sp = 0u;
    for (;;) {
        sum = 0u; cnt = 0u; mine = 0u;
#pragma unroll
        for (unsigned j = 0; j < 16; ++j) { const unsigned c = xb_ld(&bar[XB_XCNT(j)]); sum += c; cnt += (c > 0u) ? 1u : 0u; mine = (j == x) ? c : mine; }
        if (sum == G) break;
        __builtin_amdgcn_s_sleep(1);
        if ((++sp & 255u) == 0u) { if (xb_ld(&bar[XB_TMO])) break; if (sp > XB_SPIN_CAP) { atomicAdd(&bar[XB_TMO], 1u); break; } }
    }
    nloc = mine > 0u ? mine : 1u; nx = cnt > 0u ? cnt : 1u;
}
__device__ __forceinline__ void xcd_barrier(const XcdBarrier& b) {
    asm volatile("s_waitcnt vmcnt(0)" ::: "memory");
    __syncthreads();
    if (threadIdx.x == 0) {
        unsigned* bar = b.bar;
        __builtin_amdgcn_s_waitcnt(0);
        unsigned nloc = b.st[0], nx = b.st[1];
        if (nloc == 0u) { xcd_barrier_complete(bar, b.x, nloc, nx); b.st[0] = nloc; b.st[1] = nx; }
        const unsigned old = xb_add(&bar[XB_XSUB(b.x)], 1u);
        const unsigned gen = old / nloc;
        if (old + 1u == (gen + 1u) * nloc) {
            __builtin_amdgcn_fence(__ATOMIC_RELEASE, "agent");
            asm volatile("s_waitcnt vmcnt(0)" ::: "memory");
            const unsigned og = xb_add(&bar[XB_TOP], 1u);
            const unsigned tg = og / nx;
            if (og + 1u == (tg + 1u) * nx) xb_add(&bar[XB_TOPGEN], 1u);
            else XB_SPIN(xb_ld(&bar[XB_TOPGEN]) == tg, bar);
            __builtin_amdgcn_fence(__ATOMIC_ACQUIRE, "agent");
            xb_add(&bar[XB_XGEN(b.x)], 1u);
            asm volatile("s_waitcnt vmcnt(0)" ::: "memory");
        } else {
            XB_SPIN(xb_ld(&bar[XB_XGEN(b.x)]) == gen, bar);
            __builtin_amdgcn_fence(__ATOMIC_ACQUIRE, "agent");
            asm volatile("s_waitcnt vmcnt(0)" ::: "memory");
        }
    }
    __syncthreads();
}

namespace pg8 {
constexpr int BM = 256, BK = 64, HALF = 128, HTB = HALF * BK * 2, STAGE_BYTES = 8 * HTB, NXCD = 8, WGM = 8;
__device__ __forceinline__ int lds_byte(int r, int c) { const int st = (r >> 4) * 2 + (c >> 5), rr = r & 15, cc = c & 31, ob = rr * 64 + cc * 2; return st * 1024 + (ob ^ (((ob >> 9) & 1) << 5)); }
__device__ __forceinline__ void stage_rc(int b, int& R, int& C) { const int st = b / 1024, sb = b % 1024, swz = sb ^ (((sb >> 9) & 1) << 5); R = (st >> 1) * 16 + swz / 64; C = (st & 1) * 32 + (swz % 64) / 2; }
__device__ __forceinline__ int perm32(int rho) { const int n = rho >> 4, i = rho & 15; return 8 * (i >> 2) + 4 * n + (i & 3); }

struct GUnit { const char* A; const char* B; int pm, pn, a0, a1, a2, a3; };

template <class Epi, class Sched, bool F8 = false, int SCA = 0x7F7F7F7F, int SCB = 0x7F7F7F7F>
__device__ __forceinline__ void gemm_phase(LAS unsigned char* lds, const int K_, const Sched& S, const Epi& E) {
    int tid_l = threadIdx.x; asm volatile("" : "+v"(tid_l));
    const int tid = tid_l, wid = __builtin_amdgcn_readfirstlane(tid >> 6), lane = tid & 63, wr = wid >> 2, wc = wid & 3, fr = lane & 15, fq = lane >> 4;
    int K = K_; asm volatile("" : "+s"(K));
    const int nt = K / BK;
    int Rr[2], Cc[2]; unsigned voffA[2], voffB[2];
#pragma unroll
    for (int i = 0; i < 2; ++i) { int R, C; stage_rc(tid * 16 + i * 8192, R, C); const int Rb = Epi::PERM == 2 ? (64 * (R >> 5) + 16 * ((R >> 2) & 3) + 4 * ((R >> 4) & 1) + (R & 3)) : (Epi::PERM ? ((R & ~31) + perm32(R & 31)) : R);
        Rr[i] = R; Cc[i] = C; voffA[i] = (unsigned)(R * K + C) * 2u; voffB[i] = (unsigned)(Rb * K + C) * 2u; }
    const size_t kstep = (size_t)(BK * 2);
    const size_t hstep = (size_t)HALF * K * 2;
    const size_t hstepB = Epi::PERM == 2 ? (size_t)8 * K * 2 : hstep;
    const unsigned ldsw = (unsigned)wid * 1024u;
    const int aoff = lds_byte(wr * 64 + fr, fq * 8), boff = lds_byte(wc * 32 + fr, fq * 8);
#define PG8_SA(b, h) (((b) * 2 + (h)) * HTB)
#define PG8_SB(b, h) ((4 + (b) * 2 + (h)) * HTB)
#define PG8_STAGE(bufoff, gbase, voff) do { _Pragma("unroll") for (int _i = 0; _i < 2; ++_i) \
        __builtin_amdgcn_global_load_lds((const unsigned*)((const char*)(gbase) + (voff)[_i]), (LAS unsigned*)(lds + (bufoff) + ldsw + _i * 8192), 16, 0, 0); } while (0)
#define PG8_LD8(addr) __builtin_shufflevector(*(const LAS i32x4_*)(addr), *(const LAS i32x4_*)((addr) + 1024), 0, 1, 2, 3, 4, 5, 6, 7)
#define PG8_LDA(dst, b, h) do { _Pragma("unroll") for (int m = 0; m < 4; ++m) dst[m] = PG8_LD8(lds + PG8_SA(b, h) + aoff + m * 2048); } while (0)
#define PG8_LDB(dst, b, h) do { _Pragma("unroll") for (int n = 0; n < 2; ++n) dst[n] = PG8_LD8(lds + PG8_SB(b, h) + boff + n * 2048); } while (0)
#define PG8_LO(x) __builtin_bit_cast(bf16x8, __builtin_shufflevector(x, x, 0, 1, 2, 3))
#define PG8_HI(x) __builtin_bit_cast(bf16x8, __builtin_shufflevector(x, x, 4, 5, 6, 7))
#define PG8_MMA(ai, bj, At, Bt) do { __builtin_amdgcn_s_setprio(1); _Pragma("unroll") for (int m = 0; m < 4; ++m) _Pragma("unroll") for (int n = 0; n < 2; ++n) { \
        if constexpr (F8) asm volatile("v_mfma_scale_f32_16x16x128_f8f6f4 %0, %1, %2, %0, %3, %4 op_sel_hi:[0,0,0]" : "+v"(acc[ai][bj][m][n]) : "v"(Bt[n]), "v"(At[m]), "v"(scb_), "v"(sca_)); \
        else { acc[ai][bj][m][n] = __builtin_amdgcn_mfma_f32_16x16x32_bf16(PG8_LO(Bt[n]), PG8_LO(At[m]), acc[ai][bj][m][n], 0, 0, 0); \
               acc[ai][bj][m][n] = __builtin_amdgcn_mfma_f32_16x16x32_bf16(PG8_HI(Bt[n]), PG8_HI(At[m]), acc[ai][bj][m][n], 0, 0, 0); } } \
        __builtin_amdgcn_s_setprio(0); } while (0)
#define PG8_WAIT_V(n) asm volatile("s_waitcnt vmcnt(" #n ")" ::: "memory")
#define PG8_WAIT_L(n) asm volatile("s_waitcnt lgkmcnt(" #n ")" ::: "memory")
#define PG8_BAR __builtin_amdgcn_s_barrier()
#define PG8_SCHED __builtin_amdgcn_sched_barrier(0)
#define PG8_SETA(v, u) do { if constexpr (Sched::GATHER) { _Pragma("unroll") for (int _h = 0; _h < 2; ++_h) _Pragma("unroll") for (int _i = 0; _i < 2; ++_i) \
        v[_h][_i] = S.arow(u, Rr[_i] + 128 * _h) + (unsigned)Cc[_i] * 2u; } } while (0)
#define PG8_STAGEA(bufoff, p, v, h) do { if constexpr (Sched::GATHER) { PG8_STAGE(bufoff, p, v[h]); } else { PG8_STAGE(bufoff, (p) + (h) * hstep, voffA); } } while (0)
    GUnit cur, nxt; int ui = 0;
    if (!S.next(0, cur)) return;
    f32x4 acc[2][2][4][2];
#pragma unroll
    for (int a = 0; a < 2; ++a)
#pragma unroll
        for (int b = 0; b < 2; ++b)
#pragma unroll
            for (int m = 0; m < 4; ++m)
#pragma unroll
                for (int n = 0; n < 2; ++n) acc[a][b][m][n] = (f32x4){0.f, 0.f, 0.f, 0.f};
    typedef int i32x8_ __attribute__((ext_vector_type(8))); typedef int i32x4_ __attribute__((ext_vector_type(4)));
    i32x8_ At[4], B0[2], B1[2];
    int sca_ = SCA, scb_ = SCB; asm volatile("" : "+v"(sca_), "+v"(scb_));
    unsigned vAc[2][2], vAn[2][2];
    PG8_SETA(vAc, cur);
    const char* cA = cur.A; const char* cB = cur.B;
    PG8_STAGE(PG8_SB(0, 0), cB, voffB); PG8_STAGE(PG8_SB(0, 1), cB + hstepB, voffB); PG8_STAGEA(PG8_SA(0, 0), cA, vAc, 0); PG8_STAGEA(PG8_SA(0, 1), cA, vAc, 1);
    if (wr == 1) PG8_BAR;
    PG8_WAIT_V(2); PG8_BAR;
    PG8_STAGE(PG8_SB(1, 0), cB + kstep, voffB); PG8_STAGEA(PG8_SA(1, 0), cA + kstep, vAc, 0); PG8_STAGE(PG8_SB(1, 1), cB + hstepB + kstep, voffB);
    PG8_WAIT_V(6); PG8_BAR;
    for (;;) {
        const bool has_next = S.next(ui + 1, nxt);
        const char* nA = has_next ? nxt.A : cA; const char* nB = has_next ? nxt.B : cB;
        if constexpr (Sched::GATHER) { if (has_next) { PG8_SETA(vAn, nxt); } else {
#pragma unroll
            for (int _h = 0; _h < 2; ++_h)
#pragma unroll
                for (int _i = 0; _i < 2; ++_i) vAn[_h][_i] = vAc[_h][_i]; } }
        for (int t = 0; t < nt; t += 2) {
            const bool last = (t == nt - 2);
            const char* a1 = cA + (size_t)(t + 1) * kstep;
            const char* a2 = last ? nA : cA + (size_t)(t + 2) * kstep; const char* b2 = last ? nB : cB + (size_t)(t + 2) * kstep;
            const char* a3 = a2 + kstep; const char* b3 = b2 + kstep;
            unsigned v2[2][2];
            if constexpr (Sched::GATHER) {
#pragma unroll
            for (int _h = 0; _h < 2; ++_h)
#pragma unroll
                for (int _i = 0; _i < 2; ++_i) v2[_h][_i] = last ? vAn[_h][_i] : vAc[_h][_i]; }
            PG8_LDB(B0, 0, 0); PG8_LDB(B1, 0, 1); PG8_SCHED; PG8_LDA(At, 0, 0); PG8_STAGEA(PG8_SA(1, 1), a1, vAc, 1);
            PG8_WAIT_V(8); PG8_WAIT_L(0); PG8_BAR; PG8_MMA(0, 0, At, B0); PG8_MMA(0, 1, At, B1); PG8_BAR; PG8_SCHED;
            PG8_LDA(At, 0, 1); PG8_STAGE(PG8_SB(0, 0), b2, voffB); PG8_STAGE(PG8_SB(0, 1), b2 + hstepB, voffB); PG8_STAGEA(PG8_SA(0, 0), a2, v2, 0);
            PG8_WAIT_V(8); PG8_WAIT_L(0); PG8_BAR; PG8_MMA(1, 0, At, B0); PG8_MMA(1, 1, At, B1); PG8_BAR; PG8_SCHED;
            PG8_LDB(B0, 1, 0); PG8_LDB(B1, 1, 1); PG8_SCHED; PG8_LDA(At, 1, 0); PG8_STAGEA(PG8_SA(0, 1), a2, v2, 1);
            PG8_WAIT_V(8); PG8_WAIT_L(0); PG8_BAR; PG8_MMA(0, 0, At, B0); PG8_MMA(0, 1, At, B1); PG8_BAR; PG8_SCHED;
            PG8_LDA(At, 1, 1); PG8_STAGE(PG8_SB(1, 0), b3, voffB); PG8_STAGE(PG8_SB(1, 1), b3 + hstepB, voffB); PG8_STAGEA(PG8_SA(1, 0), a3, v2, 0);
            PG8_WAIT_V(8); PG8_WAIT_L(0); PG8_BAR; PG8_MMA(1, 0, At, B0); PG8_MMA(1, 1, At, B1); PG8_BAR; PG8_SCHED;
        }
        if (wr == 0) PG8_BAR;
        if constexpr (F8) asm volatile("s_nop 15\n\ts_nop 7" ::: "memory");
        bool keep = false;
        if constexpr (Epi::MULTI) keep = E.step(acc, cur, wr, wc, fr, fq); else E(acc, cur, wr, wc, fr, fq);
        if (!has_next) break;
        if (!keep) {
#pragma unroll
        for (int a = 0; a < 2; ++a)
#pragma unroll
            for (int b = 0; b < 2; ++b)
#pragma unroll
                for (int m = 0; m < 4; ++m)
#pragma unroll
                    for (int n = 0; n < 2; ++n) acc[a][b][m][n] = (f32x4){0.f, 0.f, 0.f, 0.f}; }
        cur = nxt; cA = nA; cB = nB; ++ui;
        if constexpr (Sched::GATHER) {
#pragma unroll
        for (int _h = 0; _h < 2; ++_h)
#pragma unroll
            for (int _i = 0; _i < 2; ++_i) vAc[_h][_i] = vAn[_h][_i]; }
        if (wr == 1) PG8_BAR;
    }
    PG8_WAIT_V(0);
    PG8_BAR;
#undef PG8_SA
#undef PG8_SB
#undef PG8_STAGE
#undef PG8_LD8
#undef PG8_LO
#undef PG8_HI
#undef PG8_LDA
#undef PG8_LDB
#undef PG8_MMA
#undef PG8_WAIT_V
#undef PG8_WAIT_L
#undef PG8_BAR
#undef PG8_SCHED
#undef PG8_SETA
#undef PG8_STAGEA
}

struct DenseSched {
    static constexpr bool GATHER = false;
    const char* A; const char* Bt; int K, nM, nN, nwg, G, c;
    __device__ __forceinline__ void init(const void* A_, const void* B_, int M, int N, int K_, int G_, int c_) { A = (const char*)A_; Bt = (const char*)B_; K = K_; nM = M / BM; nN = N / BM; nwg = nM * nN; G = G_; c = c_; }
    __device__ __forceinline__ bool next(int i, GUnit& u) const {
        const long L = (long)i * G + c; if (L >= nwg) return false;
        int wgid = (int)L; { const int q = nwg / NXCD, r = nwg % NXCD, xcd = wgid % NXCD, off = wgid / NXCD; wgid = (xcd < r ? xcd * (q + 1) : r * (q + 1) + (xcd - r) * q) + off; }
        const int nig = WGM * nN, gid = wgid / nig, fm = gid * WGM, gsz = (nM - fm) < WGM ? (nM - fm) : WGM;
        u.pm = fm + ((wgid % nig) % gsz); u.pn = (wgid % nig) / gsz;
        u.A = A + (size_t)u.pm * BM * K * 2; u.B = Bt + (size_t)u.pn * BM * K * 2; u.a0 = u.a1 = u.a2 = u.a3 = 0; return true;
    }
    __device__ __forceinline__ unsigned arow(const GUnit&, int) const { return 0u; }
};

struct Gate3Sched {
    static constexpr bool GATHER = false;
    const char* A; const char* Bt; long dA1, dA2, dB1, dB2; int K, nM, nN, nwg, G, c;
    __device__ __forceinline__ bool next(int i, GUnit& u) const {
        const int ti = i / 3, seg = i - 3 * ti;
        const long L = (long)ti * G + c; if (L >= nwg) return false;
        int wgid = (int)L; { const int q = nwg / NXCD, r = nwg % NXCD, xcd = wgid % NXCD, off = wgid / NXCD; wgid = (xcd < r ? xcd * (q + 1) : r * (q + 1) + (xcd - r) * q) + off; }
        const int nig = WGM * nN, gid = wgid / nig, fm = gid * WGM, gsz = (nM - fm) < WGM ? (nM - fm) : WGM;
        u.pm = fm + ((wgid % nig) % gsz); u.pn = (wgid % nig) / gsz;
        const long da = seg == 0 ? 0 : (seg == 1 ? dA1 : dA2), db = seg == 0 ? 0 : (seg == 1 ? dB1 : dB2);
        u.A = A + da + (size_t)u.pm * BM * K * 2; u.B = Bt + db + (size_t)u.pn * BM * K * 2; u.a0 = u.a1 = u.a2 = 0; u.a3 = seg; return true;
    }
    __device__ __forceinline__ unsigned arow(const GUnit&, int) const { return 0u; }
};

template <int NPN, bool G_> struct MoeSched {
    static constexpr bool GATHER = G_;
    const char* Abase; const char* Bbase; size_t bstride; int K; const int* elist; const LAS int* tab; int hbase, nU, G, c, NE; mutable int ehint;
    __device__ __forceinline__ bool next(int i, GUnit& u) const {
        const long L = (long)i * G + c; if (L >= nU) return false;
        int wgid = (int)L; { const int q = nU / NXCD, r = nU % NXCD, xcd = wgid % NXCD, off = wgid / NXCD; wgid = (xcd < r ? xcd * (q + 1) : r * (q + 1) + (xcd - r) * q) + off; }
        int e = ehint; if (wgid < tab[130 + e]) e = 0;
        while (e < NE - 1 && wgid >= tab[130 + e + 1]) ++e;
        e = __builtin_amdgcn_readfirstlane(e); ehint = e;
        const int r = wgid - tab[130 + e], rb = r / NPN, pn = r % NPN;
        u.pm = rb; u.pn = pn; u.a0 = e; u.a1 = __builtin_amdgcn_readfirstlane(tab[65 + e]) + 256 * rb; u.a2 = __builtin_amdgcn_readfirstlane(tab[e]); u.a3 = 0;
        u.A = G_ ? Abase : Abase + (size_t)u.a1 * K * 2;
        u.B = Bbase + (size_t)e * bstride + (size_t)pn * BM * K * 2;
        return true;
    }
    __device__ __forceinline__ unsigned arow(const GUnit& u, int R) const {
        const int idx = 256 * u.pm + R; int tok;
        if (u.a0 == 64) tok = hbase + idx;
        else { const int t0 = elist[(size_t)u.a0 * CAP + (idx < u.a2 ? idx : u.a2 - 1)]; tok = (idx < u.a2) ? t0 : hbase; }
        return (unsigned)tok * (unsigned)(K * 2);
    }
};
}
using pg8::GUnit;

typedef f32x4 AccT[2][2][4][2];
struct EpiG1 {
    static constexpr bool PERM = true; static constexpr bool MULTI = false;
    bf16 *QA, *QB, *QC; float* CG; const float* rope;
    __device__ __forceinline__ void operator()(const AccT& acc, const GUnit& u, int wr, int wc, int fr, int fq) const {
        const int pn = u.pn;
        if (pn == 17) {
            if (wc == 0 && fq < 2) {
#pragma unroll
                for (int ai = 0; ai < 2; ++ai)
#pragma unroll
                    for (int m = 0; m < 4; ++m) { const int row = u.pm * 256 + ai * 128 + wr * 64 + m * 16 + fr; float* p = CG + (size_t)row * 16 + 8 * fq;
                        *(f32x4*)p = acc[ai][0][m][0]; *(f32x4*)(p + 4) = acc[ai][0][m][1]; }
            }
            return;
        }
        bf16* base; int ld, colt;
        if (pn < 3) { base = QA; ld = LDA_; colt = pn * 256; } else if (pn < 9) { base = QB; ld = LDB_; colt = (pn - 3) * 256; } else { base = QC; ld = LDC_; colt = (pn - 9) * 256; }
        const bool latent = u.pm < 128;
#pragma unroll
        for (int ai = 0; ai < 2; ++ai)
#pragma unroll
            for (int m = 0; m < 4; ++m) {
                const int row = u.pm * 256 + ai * 128 + wr * 64 + m * 16 + fr; const int t = row & 4095; const int pos = (wc & 1) ? (t & 63) : (t >> 6);
                bf16* rowp = base + (size_t)row * ld + colt + wc * 32 + 8 * fq;
#pragma unroll
                for (int bj = 0; bj < 2; ++bj) {
                    const int gc = pn * 256 + bj * 128;
                    const bool rp = latent && (gc < 640 || (gc >= 768 && gc < 1792));
                    f32x4 v0 = acc[ai][bj][m][0], v1 = acc[ai][bj][m][1];
                    if (rp) { const f32x4 cs = *(const f32x4*)(rope + pos * 16 + 4 * fq), sn = *(const f32x4*)(rope + 1024 + pos * 16 + 4 * fq);
                        const f32x4 a = v0, b = v1; v0 = a * cs - b * sn; v1 = b * cs + a * sn; }
                    u32x4 w; w.x = pk2(v0[0], v0[1]); w.y = pk2(v0[2], v0[3]); w.z = pk2(v1[0], v1[1]); w.w = pk2(v1[2], v1[3]);
                    *(u32x4*)(rowp + bj * 128) = w;
                }
            }
    }
};
struct EpiBf16 {
    static constexpr bool PERM = true; static constexpr bool MULTI = false;
    bf16* O; int ld;
    __device__ __forceinline__ void operator()(const AccT& acc, const GUnit& u, int wr, int wc, int fr, int fq) const {
#pragma unroll
        for (int ai = 0; ai < 2; ++ai)
#pragma unroll
            for (int m = 0; m < 4; ++m) { bf16* rowp = O + (size_t)(u.pm * 256 + ai * 128 + wr * 64 + m * 16 + fr) * ld + u.pn * 256 + wc * 32 + 8 * fq;
#pragma unroll
                for (int bj = 0; bj < 2; ++bj) { const f32x4 v0 = acc[ai][bj][m][0], v1 = acc[ai][bj][m][1];
                    u32x4 w; w.x = pk2(v0[0], v0[1]); w.y = pk2(v0[2], v0[3]); w.z = pk2(v1[0], v1[1]); w.w = pk2(v1[2], v1[3]);
                    *(u32x4*)(rowp + bj * 128) = w; } }
    }
};
struct EpiSig8 {
    static constexpr int PERM = 2; static constexpr bool MULTI = false;
    unsigned char* O; int ld;
    static __device__ __forceinline__ float q1(float x) { return fmaxf(__builtin_rintf(255.f * sigm(x)), 1.f); }
    static __device__ __forceinline__ unsigned q4(f32x4 v) {
        unsigned w = 0;
        w = __builtin_amdgcn_cvt_pk_u8_f32(q1(v[0]), 0, w); w = __builtin_amdgcn_cvt_pk_u8_f32(q1(v[1]), 1, w);
        w = __builtin_amdgcn_cvt_pk_u8_f32(q1(v[2]), 2, w); w = __builtin_amdgcn_cvt_pk_u8_f32(q1(v[3]), 3, w);
        return w;
    }
    __device__ __forceinline__ void operator()(const AccT& acc, const GUnit& u, int wr, int wc, int fr, int fq) const {
#pragma unroll
        for (int ai = 0; ai < 2; ++ai)
#pragma unroll
            for (int m = 0; m < 4; ++m) { unsigned char* rowp = O + (size_t)(u.pm * 256 + ai * 128 + wr * 64 + m * 16 + fr) * ld + u.pn * 256 + wc * 64 + 16 * fq;
                u32x4 w; w.x = q4(acc[ai][0][m][0]); w.y = q4(acc[ai][0][m][1]); w.z = q4(acc[ai][1][m][0]); w.w = q4(acc[ai][1][m][1]);
                *(u32x4*)rowp = w; }
    }
};
struct EpiGate3 {
    static constexpr int PERM = 2; static constexpr bool MULTI = true;
    const unsigned char* GT; bf16* Y;
    static __device__ __forceinline__ float ub(unsigned w, int k) { return (float)((w >> (8 * k)) & 0xffu); }
    __device__ __forceinline__ bool step(AccT& acc, const GUnit& u, int wr, int wc, int fr, int fq) const {
        const int col0 = u.pn * 256 + wc * 64 + 16 * fq, seg = u.a3;
        if (seg < 2) {
#pragma unroll
            for (int ai = 0; ai < 2; ++ai) {
                u32x4 ga[4], gb[4];
#pragma unroll
                for (int m = 0; m < 4; ++m) { const unsigned char* gp = GT + (size_t)(u.pm * 256 + ai * 128 + wr * 64 + m * 16 + fr) * NGT + seg * 1024 + col0;
                    ga[m] = *(const u32x4*)gp; gb[m] = *(const u32x4*)(gp + 1024); }
#pragma unroll
                for (int m = 0; m < 4; ++m)
#pragma unroll
                    for (int bj = 0; bj < 2; ++bj)
#pragma unroll
                        for (int n = 0; n < 2; ++n) { const unsigned a = ga[m][2 * bj + n], b = gb[m][2 * bj + n];
                            f32x4 r;
#pragma unroll
                            for (int k = 0; k < 4; ++k) r[k] = ub(a, k) * __builtin_amdgcn_rcpf(ub(b, k));
                            acc[ai][bj][m][n] *= r; }
            }
            return true;
        }
#pragma unroll
        for (int ai = 0; ai < 2; ++ai) {
            u32x4 g[4];
#pragma unroll
            for (int m = 0; m < 4; ++m) g[m] = *(const u32x4*)(GT + (size_t)(u.pm * 256 + ai * 128 + wr * 64 + m * 16 + fr) * NGT + 2048 + col0);
#pragma unroll
            for (int m = 0; m < 4; ++m) { bf16* yp = Y + (size_t)(u.pm * 256 + ai * 128 + wr * 64 + m * 16 + fr) * 1024 + col0;
#pragma unroll
                for (int bj = 0; bj < 2; ++bj) { const unsigned g0 = g[m][2 * bj], g1 = g[m][2 * bj + 1]; const f32x4 v0 = acc[ai][bj][m][0] * (1.f / 255.f), v1 = acc[ai][bj][m][1] * (1.f / 255.f);
                    u32x4 w;
                    w.x = pk2(ub(g0, 0) * v0[0], ub(g0, 1) * v0[1]); w.y = pk2(ub(g0, 2) * v0[2], ub(g0, 3) * v0[3]);
                    w.z = pk2(ub(g1, 0) * v1[0], ub(g1, 1) * v1[1]); w.w = pk2(ub(g1, 2) * v1[2], ub(g1, 3) * v1[3]);
                    *(u32x4*)(yp + 8 * bj) = w; } }
            asm volatile("" ::: "memory");
        }
        return false;
    }
};
struct EpiRes {
    static constexpr int PERM = 2; static constexpr bool MULTI = false;
    const float* resL; const float* resC; bf16* xs; const float* modv; int rowbase;
    __device__ __forceinline__ void operator()(const AccT& acc, const GUnit& u, int wr, int wc, int fr, int fq) const {
        const int row0 = rowbase + u.pm * 256;
        const float* mv = modv + (row0 < ML ? (row0 >> 12) : 8) * 6144;
        const int col0 = u.pn * 256 + wc * 64 + 16 * fq;
        f32x4 m4[2][2];
#pragma unroll
        for (int bj = 0; bj < 2; ++bj)
#pragma unroll
            for (int n = 0; n < 2; ++n) m4[bj][n] = *(const f32x4*)(mv + col0 + 8 * bj + 4 * n);
#pragma unroll
        for (int ai = 0; ai < 2; ++ai) {
            if (resL) {
                f32x4 r4[4][2][2];
#pragma unroll
                for (int m = 0; m < 4; ++m) { const int row = row0 + ai * 128 + wr * 64 + m * 16 + fr;
                    const float* rp = row < ML ? resL + (size_t)row * D : resC + (size_t)(row - ML) * D;
#pragma unroll
                    for (int bj = 0; bj < 2; ++bj)
#pragma unroll
                        for (int n = 0; n < 2; ++n) r4[m][bj][n] = *(const f32x4*)(rp + col0 + 8 * bj + 4 * n); }
#pragma unroll
                for (int m = 0; m < 4; ++m) { bf16* op = xs + (size_t)(row0 + ai * 128 + wr * 64 + m * 16 + fr) * D + col0;
#pragma unroll
                    for (int bj = 0; bj < 2; ++bj) { const f32x4 a = r4[m][bj][0] + m4[bj][0] * acc[ai][bj][m][0], b = r4[m][bj][1] + m4[bj][1] * acc[ai][bj][m][1];
                        u32x4 w; w.x = pk2(a[0], a[1]); w.y = pk2(a[2], a[3]); w.z = pk2(b[0], b[1]); w.w = pk2(b[2], b[3]);
                        *(u32x4*)(op + 8 * bj) = w; } }
            } else {
                u32x4 r[4][2];
#pragma unroll
                for (int m = 0; m < 4; ++m) { const bf16* rp = xs + (size_t)(row0 + ai * 128 + wr * 64 + m * 16 + fr) * D + col0;
#pragma unroll
                    for (int bj = 0; bj < 2; ++bj) r[m][bj] = *(const u32x4*)(rp + 8 * bj); }
#pragma unroll
                for (int m = 0; m < 4; ++m) { bf16* op = xs + (size_t)(row0 + ai * 128 + wr * 64 + m * 16 + fr) * D + col0;
#pragma unroll
                    for (int bj = 0; bj < 2; ++bj) { const u32x4 rr = r[m][bj]; const f32x4 a0 = acc[ai][bj][m][0], a1 = acc[ai][bj][m][1], ma = m4[bj][0], mb = m4[bj][1];
                        u32x4 w;
                        w.x = pk2(bflo(rr.x) + ma[0] * a0[0], bfhi(rr.x) + ma[1] * a0[1]); w.y = pk2(bflo(rr.y) + ma[2] * a0[2], bfhi(rr.y) + ma[3] * a0[3]);
                        w.z = pk2(bflo(rr.z) + mb[0] * a1[0], bfhi(rr.z) + mb[1] * a1[1]); w.w = pk2(bflo(rr.w) + mb[2] * a1[2], bfhi(rr.w) + mb[3] * a1[3]);
                        *(u32x4*)(op + 8 * bj) = w; } }
            }
            asm volatile("" ::: "memory");
        }
    }
};
struct EpiLogits {
    static constexpr bool PERM = false; static constexpr bool MULTI = false;
    float* L;
    __device__ __forceinline__ void operator()(const AccT& acc, const GUnit& u, int wr, int wc, int fr, int fq) const {
        if (wc >= 2) return;
#pragma unroll
        for (int ai = 0; ai < 2; ++ai)
#pragma unroll
            for (int m = 0; m < 4; ++m) { const int row = u.pm * 256 + ai * 128 + wr * 64 + m * 16 + fr;
#pragma unroll
                for (int n = 0; n < 2; ++n) *(f32x4*)(L + (size_t)row * 64 + wc * 32 + n * 16 + 4 * fq) = acc[ai][0][m][n]; }
    }
};
typedef unsigned char fp8;
__device__ __forceinline__ unsigned pk4_fp8(f32x4 v) {
    int w = 0;
    w = __builtin_amdgcn_cvt_pk_fp8_f32(__builtin_amdgcn_fmed3f(v[0], -400.f, 400.f), __builtin_amdgcn_fmed3f(v[1], -400.f, 400.f), w, false);
    w = __builtin_amdgcn_cvt_pk_fp8_f32(__builtin_amdgcn_fmed3f(v[2], -400.f, 400.f), __builtin_amdgcn_fmed3f(v[3], -400.f, 400.f), w, true);
    return (unsigned)w;
}
struct EpiSwiGLU {
    static constexpr int PERM = 2; static constexpr bool MULTI = false;
    fp8* A2;
    __device__ __forceinline__ void operator()(const AccT& acc, const GUnit& u, int wr, int wc, int fr, int fq) const {
#pragma unroll
        for (int ai = 0; ai < 2; ++ai)
#pragma unroll
            for (int m = 0; m < 4; ++m) { fp8* rowp = A2 + (size_t)(u.a1 + ai * 128 + wr * 64 + m * 16 + fr) * 256 + u.pn * 128 + wc * 32 + 8 * fq;
                u32x2 o;
#pragma unroll
                for (int bj = 0; bj < 2; ++bj) { const f32x4 g = acc[ai][bj][m][0], uu = acc[ai][bj][m][1];
                    const f32x4 a = {4.f * g[0] * sigm(g[0]) * uu[0], 4.f * g[1] * sigm(g[1]) * uu[1], 4.f * g[2] * sigm(g[2]) * uu[2], 4.f * g[3] * sigm(g[3]) * uu[3]};
                    if (bj == 0) o.x = pk4_fp8(a); else o.y = pk4_fp8(a); }
                *(u32x2*)rowp = o; }
    }
};
struct EpiY2 {
    static constexpr int PERM = 2; static constexpr bool MULTI = false;
    fp8* Y2; const float* wlist;
    __device__ __forceinline__ void operator()(const AccT& acc, const GUnit& u, int wr, int wc, int fr, int fq) const {
        const int e = u.a0;
        float wv[2][4];
#pragma unroll
        for (int ai = 0; ai < 2; ++ai)
#pragma unroll
            for (int m = 0; m < 4; ++m) { const int idx = 256 * u.pm + ai * 128 + wr * 64 + m * 16 + fr; const float wl = wlist[(size_t)e * CAP + (idx < u.a2 ? idx : u.a2 - 1)];
                wv[ai][m] = idx < u.a2 ? 16.f * wl : 0.f; }
#pragma unroll
        for (int ai = 0; ai < 2; ++ai)
#pragma unroll
            for (int m = 0; m < 4; ++m) { const int lr = ai * 128 + wr * 64 + m * 16 + fr; const float w = wv[ai][m];
                fp8* rowp = Y2 + (size_t)(u.a1 + lr) * 1024 + u.pn * 256 + wc * 64 + 16 * fq;
                u32x4 o; o.x = pk4_fp8(acc[ai][0][m][0] * w); o.y = pk4_fp8(acc[ai][0][m][1] * w); o.z = pk4_fp8(acc[ai][1][m][0] * w); o.w = pk4_fp8(acc[ai][1][m][1] * w);
                *(u32x4*)rowp = o; }
    }
};

template <int DV, bool DIFF>
__device__ __forceinline__ void attn_core(LAS unsigned char* lds, const bf16* qptr  ,
                                          const bf16* kv0, int nt0, const bf16* kv1, int nt1, int ld, int kcol, int vcol, int stream,
                                          bool domask, int qpos, int q0w  , int kpos0, float& m_run, float& l_run, f32x16 (&o)[DV / 32]) {
    constexpr int NDV = DV / 32;
    constexpr int NLD = DIFF ? 4 : 2;
    constexpr int KOFF = 0, VOFF = DIFF ? 16384 : 9216, BUFB = DIFF ? 32768 : 21504;
    int tid_l = threadIdx.x; asm volatile("" : "+v"(tid_l));
    const int tid = tid_l, lane = tid & 63, r32 = lane & 31, hi = lane >> 5, q4 = (lane & 15) >> 2, p4 = lane & 3, g1 = (lane >> 4) & 1;
    bf16x8 qf[4];
#pragma unroll
    for (int d0 = 0; d0 < 4; ++d0) qf[d0] = *(const bf16x8*)(qptr + 16 * d0);
    const int NT = nt0 + nt1;
    f32x16 negm;
    { const float _nm = -m_run;
#pragma unroll
      for (int i = 0; i < 16; ++i) negm[i] = _nm; }
    unsigned goff[NLD], woff[NLD];
#pragma unroll
    for (int p = 0; p < NLD; ++p) { const int idx = tid + 512 * p;
        if (DIFF) { const int w = idx >> 10, rem = idx & 1023, row = rem >> 4, ch = rem & 15; goff[p] = (unsigned)(row * ld + (w ? vcol : kcol) + ch * 8); woff[p] = (unsigned)((w ? VOFF : KOFF) + offb(row, ch)); }
        else { const int w = idx >> 9, rem = idx & 511, row = rem >> 3, ch = rem & 7; goff[p] = (unsigned)(row * ld + (w ? vcol : kcol) + ch * 8); woff[p] = (unsigned)((w ? VOFF + row * 192 : KOFF + row * 144) + ch * 16); } }
    unsigned kadr[4], vadr[2][NDV];
#pragma unroll
    for (int d0 = 0; d0 < 4; ++d0) kadr[d0] = (unsigned)(KOFF + (DIFF ? offb(r32, 8 * stream + 2 * d0 + hi) : r32 * 144 + (16 * d0 + 8 * hi) * 2));
#pragma unroll
    for (int jj = 0; jj < 2; ++jj)
#pragma unroll
        for (int dv = 0; dv < NDV; ++dv) vadr[jj][dv] = (unsigned)(VOFF + (DIFF ? offb(4 * hi + 8 * jj + q4, 4 * dv + 2 * g1 + (p4 >> 1)) + 8 * (p4 & 1) : (4 * hi + 8 * jj + q4) * 192 + (32 * dv + 16 * g1 + 4 * p4) * 2));
    constexpr int KB2 = DIFF ? 8192 : 32 * 144;
    constexpr int VROW = DIFF ? 256 : 192;
    u32x4 st[NLD];
#define AT_LOAD(t) do { const bf16* _b = ((t) < nt0) ? kv0 + (size_t)((t) * 64) * ld : kv1 + (size_t)(((t) - nt0) * 64) * ld; \
        _Pragma("unroll") for (int _p = 0; _p < NLD; ++_p) st[_p] = *(const u32x4*)(_b + goff[_p]); } while (0)
#define AT_WRITE(BO) do { _Pragma("unroll") for (int _p = 0; _p < NLD; ++_p) *(LAS u32x4*)(lds + (BO) + woff[_p]) = st[_p]; } while (0)
#define AT_VLD(dst, g, BO) do { _Pragma("unroll") for (int dv = 0; dv < NDV; ++dv) { dst[dv][0] = trrd(lds + (BO) + (16 * (g)) * VROW + vadr[0][dv]); dst[dv][1] = trrd(lds + (BO) + (16 * (g)) * VROW + vadr[1][dv]); } } while (0)
#define AT_PVG(src, PW) do { const bf16x8 pf = __builtin_bit_cast(bf16x8, PW); _Pragma("unroll") for (int dv = 0; dv < NDV; ++dv) o[dv] = __builtin_amdgcn_mfma_f32_32x32x16_bf16(cat8(src[dv][0], src[dv][1]), pf, o[dv], 0, 0, 0); } while (0)
#define AT_TILE(t, BO) do { \
        bool tmask_ = false; \
        if (!DIFF) { if (domask && (t) < nt0) { const int kp_ = kpos0 + 64 * (t); \
            if (kp_ > q0w + 159 || kp_ + 63 < q0w - 128) break;     \
            tmask_ = !(kp_ >= q0w - 97 && kp_ <= q0w + 65); } } \
        f32x16 p0, p1; bf16x8 kf[8]; \
        _Pragma("unroll") for (int d0 = 0; d0 < 4; ++d0) { kf[2 * d0] = *(const LAS bf16x8*)(lds + (BO) + kadr[d0]); kf[2 * d0 + 1] = *(const LAS bf16x8*)(lds + (BO) + KB2 + kadr[d0]); } \
        \
        p0 = __builtin_amdgcn_mfma_f32_32x32x16_bf16(kf[0], qf[0], negm, 0, 0, 0); \
        p1 = __builtin_amdgcn_mfma_f32_32x32x16_bf16(kf[1], qf[0], negm, 0, 0, 0); \
        _Pragma("unroll") for (int d0 = 1; d0 < 4; ++d0) { \
            p0 = __builtin_amdgcn_mfma_f32_32x32x16_bf16(kf[2 * d0], qf[d0], p0, 0, 0, 0); \
            p1 = __builtin_amdgcn_mfma_f32_32x32x16_bf16(kf[2 * d0 + 1], qf[d0], p1, 0, 0, 0); } \
        \
        s16x4 va[NDV][2], vb[NDV][2]; \
        AT_VLD(va, 0, BO); \
        if (!DIFF) { if (tmask_) { const int kp = kpos0 + 64 * (t); \
            _Pragma("unroll") for (int i = 0; i < 16; ++i) { const int d0_ = kp + crow(i, hi) - qpos; const int d1_ = d0_ + 32; \
                if (d0_ > 128 || d0_ < -128) p0[i] = -1e30f; if (d1_ > 128 || d1_ < -128) p1[i] = -1e30f; } } } \
        float ls = 0.f; \
        _Pragma("unroll") for (int i = 0; i < 16; ++i) { p0[i] = ex2(p0[i]); p1[i] = ex2(p1[i]); } \
        { float sa = fadd_s(p0[0], p1[0]), sb = fadd_s(p0[1], p1[1]);     \
          _Pragma("unroll") for (int i = 2; i < 16; i += 2) { sa = fadd_s(sa, p0[i]); sb = fadd_s(sb, p0[i + 1]); sa = fadd_s(sa, p1[i]); sb = fadd_s(sb, p1[i + 1]); } ls = sa + sb; } \
        l_run += ls; \
        u32x4 pw0, pw1, pw2, pw3; \
        pw0.x = pk2(p0[0], p0[1]); pw0.y = pk2(p0[2], p0[3]); pw0.z = pk2(p0[4], p0[5]); pw0.w = pk2(p0[6], p0[7]); \
        pw1.x = pk2(p0[8], p0[9]); pw1.y = pk2(p0[10], p0[11]); pw1.z = pk2(p0[12], p0[13]); pw1.w = pk2(p0[14], p0[15]); \
        pw2.x = pk2(p1[0], p1[1]); pw2.y = pk2(p1[2], p1[3]); pw2.z = pk2(p1[4], p1[5]); pw2.w = pk2(p1[6], p1[7]); \
        pw3.x = pk2(p1[8], p1[9]); pw3.y = pk2(p1[10], p1[11]); pw3.z = pk2(p1[12], p1[13]); pw3.w = pk2(p1[14], p1[15]); \
        AT_VLD(vb, 1, BO); AT_PVG(va, pw0); \
        AT_VLD(va, 2, BO); AT_PVG(vb, pw1); \
        AT_VLD(vb, 3, BO); AT_PVG(va, pw2); \
        AT_PVG(vb, pw3); \
        if (__any(ls > 4096.f)) {     \
            const float mxl = fmaxf(ls, __shfl_xor(ls, 32)); const float dl = mxl > 4096.f ? (float)((int)((__float_as_uint(mxl) >> 23) & 0xffu) - 132) : 0.f; const float alpha = ex2(-dl); \
            m_run += dl; l_run *= alpha; \
            _Pragma("unroll") for (int dv = 0; dv < NDV; ++dv) _Pragma("unroll") for (int i = 0; i < 16; ++i) o[dv][i] *= alpha; \
            { const float _nm = -m_run; _Pragma("unroll") for (int i = 0; i < 16; ++i) negm[i] = _nm; } } \
    } while (0)
    AT_LOAD(0); AT_WRITE(0);
    __syncthreads();
    for (int t = 0; t < NT; t += 2) {
        AT_LOAD(t + 1);
        AT_TILE(t, 0);
        AT_WRITE(BUFB);
        __syncthreads();
        if (t + 2 < NT) AT_LOAD(t + 2);
        AT_TILE(t + 1, BUFB);
        if (t + 2 < NT) AT_WRITE(0);
        __syncthreads();
    }
#undef AT_LOAD
#undef AT_WRITE
#undef AT_TILE
#undef AT_VLD
#undef AT_PVG
}

__device__ __forceinline__ void mixB_unit(LAS unsigned char* lds, int ub, const bf16* QB, bf16* OB, const float* gdiff, float lam, float lam_init) {
    int tid_l = threadIdx.x; asm volatile("" : "+v"(tid_l));
    const int tid = tid_l, lane = tid & 63, r32 = lane & 31, hi = lane >> 5, wid = __builtin_amdgcn_readfirstlane(tid >> 6), s = wid >> 2, qs = wid & 3;
    int b, h, qrow0, nt0, nt1; const bf16 *kv0, *kv1;
    if (ub < 1024) { b = ub >> 7; h = (ub >> 5) & 3; const int qb = ub & 31; qrow0 = b * 4096 + qb * 128; kv0 = QB + (size_t)(b * 4096) * LDB_; nt0 = 64; kv1 = QB + (size_t)(ML + b * 256) * LDB_; nt1 = 4; }
    else { const int uc = ub - 1024; b = uc >> 3; h = (uc >> 1) & 3; const int qb = uc & 1; qrow0 = ML + b * 256 + qb * 128; kv0 = QB + (size_t)(ML + b * 256) * LDB_; nt0 = 4; kv1 = kv0; nt1 = 0; }
    const int qrow = qrow0 + 32 * qs + r32;
    const bf16* qptr = QB + (size_t)qrow * LDB_ + (2 * h + s) * 64 + 8 * hi;
    float m_run = 0.f, l_run = 0.f; f32x16 o[4];
#pragma unroll
    for (int dv = 0; dv < 4; ++dv)
#pragma unroll
        for (int i = 0; i < 16; ++i) o[dv][i] = 0.f;
    attn_core<128, true>(lds, qptr, kv0, nt0, kv1, nt1, LDB_, 512 + 128 * h, 1024 + 128 * h, s, false, 0, 0, 0, m_run, l_run, o);
    const float inv = 1.f / (l_run + __shfl_xor(l_run, 32));
    LAS float* X = (LAS float*)(lds + 65536);
    if (s == 1) {
#pragma unroll
        for (int dv = 0; dv < 4; ++dv)
#pragma unroll
            for (int i = 0; i < 16; ++i) X[(qs * 64 + dv * 16 + i) * 64 + lane] = o[dv][i] * inv;
    }
    __syncthreads();
    if (s == 0) {
        float ss = 0.f;
#pragma unroll
        for (int dv = 0; dv < 4; ++dv)
#pragma unroll
            for (int i = 0; i < 16; ++i) { const float d = o[dv][i] * inv - lam * X[(qs * 64 + dv * 16 + i) * 64 + lane]; o[dv][i] = d; ss += d * d; }
        ss += __shfl_xor(ss, 32);
        const float rs = __builtin_amdgcn_rsqf(ss * (1.f / 128.f) + EPS) * (1.f - lam_init);
        bf16* op = OB + (size_t)qrow * 512 + h * 128;
#pragma unroll
        for (int dv = 0; dv < 4; ++dv)
#pragma unroll
            for (int i4 = 0; i4 < 4; ++i4) { const int e0 = 32 * dv + 8 * i4 + 4 * hi; const f32x4 g = *(const f32x4*)(gdiff + e0);
                u32x2 w; w.x = pk2(o[dv][4 * i4] * rs * g[0], o[dv][4 * i4 + 1] * rs * g[1]); w.y = pk2(o[dv][4 * i4 + 2] * rs * g[2], o[dv][4 * i4 + 3] * rs * g[3]);
                *(u32x2*)(op + e0) = w; }
    }
    __syncthreads();
}

__device__ __forceinline__ void mixA_unit(LAS unsigned char* lds, int ua, const bf16* QA, bf16* OA, const float* sink) {
    int tid_l = threadIdx.x; asm volatile("" : "+v"(tid_l));
    const int tid = tid_l, lane = tid & 63, r32 = lane & 31, hi = lane >> 5, wid = __builtin_amdgcn_readfirstlane(tid >> 6), qs = wid & 3;
    int b, qb, kvh, pair, qrow0, nt0, nt1, kpos0; const bf16 *kv0, *kv1; bool domask;
    if (ua < 1024) { b = ua >> 7; qb = (ua >> 2) & 31; kvh = (ua >> 1) & 1; pair = ua & 1; qrow0 = b * 4096 + qb * 128;
        const int ks = qb * 128 - 128 < 0 ? 0 : qb * 128 - 128, ke = qb * 128 + 256 > SEQ ? SEQ : qb * 128 + 256;
        kpos0 = ks; nt0 = (ke - ks) >> 6; kv0 = QA + (size_t)(b * 4096 + ks) * LDA_; kv1 = QA + (size_t)(ML + b * 256) * LDA_; nt1 = 4; domask = true; }
    else { const int uc = ua - 1024; b = uc >> 3; qb = (uc >> 2) & 1; kvh = (uc >> 1) & 1; pair = uc & 1; qrow0 = ML + b * 256 + qb * 128;
        kpos0 = 0; nt0 = 4; kv0 = QA + (size_t)(ML + b * 256) * LDA_; kv1 = kv0; nt1 = 0; domask = false; }
    const int head = 4 * kvh + 2 * pair + (wid >> 2);
    const int qrow = qrow0 + 32 * qs + r32;
    const bf16* qptr = QA + (size_t)qrow * LDA_ + head * 64 + 8 * hi;
    float m_run = sink[head] * LOG2E, l_run = hi == 0 ? 1.f : 0.f; f32x16 o[2];
#pragma unroll
    for (int dv = 0; dv < 2; ++dv)
#pragma unroll
        for (int i = 0; i < 16; ++i) o[dv][i] = 0.f;
    attn_core<64, false>(lds, qptr, kv0, nt0, kv1, nt1, LDA_, 512 + 64 * kvh, 640 + 64 * kvh, 0, domask, qb * 128 + 32 * qs + r32, qb * 128 + 32 * qs, kpos0, m_run, l_run, o);
    const float inv = 1.f / (l_run + __shfl_xor(l_run, 32));
    bf16* op = OA + (size_t)qrow * 512 + head * 64;
#pragma unroll
    for (int dv = 0; dv < 2; ++dv)
#pragma unroll
        for (int i4 = 0; i4 < 4; ++i4) { const int e0 = 32 * dv + 8 * i4 + 4 * hi;
            u32x2 w; w.x = pk2(o[dv][4 * i4] * inv, o[dv][4 * i4 + 1] * inv); w.y = pk2(o[dv][4 * i4 + 2] * inv, o[dv][4 * i4 + 3] * inv);
            *(u32x2*)(op + e0) = w; }
}

constexpr int ML_QI = 0, ML_KI = 34816, ML_VI = 67584, ML_CI = 100352, ML_VEC = 135168;
__device__ __forceinline__ void mlstm_unit(LAS unsigned char* lds, int unit, const bf16* QC, const float* CG, const float* bgate, bf16* HF, bf16* HB, bool need_ctx) {
    int tid_l = threadIdx.x; asm volatile("" : "+v"(tid_l));
    const int wid = __builtin_amdgcn_readfirstlane(tid_l >> 6);
    const int b = unit >> 3, h = (unit >> 1) & 3, dir = unit & 1;
    bf16* Hout = dir ? HB : HF;
    const int gi_col = 8 * dir + h, gf_col = 8 * dir + 4 + h;
    const float bi = bgate[gi_col], bfb = bgate[gf_col];
    LAS float* cvec = (LAS float*)(lds + ML_VEC);
    LAS float* rvec = cvec + 128;
    LAS float* avec = cvec + 256;
    LAS float* evec = cvec + 384;
    LAS float* nvec = cvec + 512;
    for (int i = tid_l; i < 34816 / 4; i += 512) ((LAS unsigned*)(lds + ML_CI))[i] = 0u;
    if (tid_l < 128) nvec[tid_l] = 0.f;
    f32x16 Cst[2];
#pragma unroll
    for (int et = 0; et < 2; ++et)
#pragma unroll
        for (int i = 0; i < 16; ++i) Cst[et][i] = 0.f;
    float m_st = 0.f;
    for (int step = 0; step < 34; ++step) {
        asm volatile("" : "+v"(tid_l));
        const int tid = tid_l, lane = tid & 63, r32 = lane & 31, hi = lane >> 5;
        const int q4 = (lane & 15) >> 2, p4 = lane & 3, g1 = (lane >> 4) & 1;
        int base;
        if (step < 2) { const int cj = dir ? 1 - step : step; base = ML + b * 256 + 128 * cj; }
        else { const int lj = step - 2; const int cj = dir ? 31 - lj : lj; base = b * 4096 + 128 * cj; }
        u32x4 st[12];
        {
            const int tau = (tid >> 4), ch = tid & 15;
#pragma unroll
            for (int p = 0; p < 12; ++p) { const int tt = (p & 3) * 32 + tau; const int gr = base + (dir ? 127 - tt : tt);
                st[p] = *(const u32x4*)(QC + (size_t)gr * LDC_ + (p >> 2) * 512 + h * 128 + ch * 8); }
        }
        float decay_r, factor_r;
        {
            const int t0 = lane, t1 = lane + 64;
            const int gr0 = base + (dir ? 127 - t0 : t0), gr1 = base + (dir ? 127 - t1 : t1);
            const float gi0 = CG[(size_t)gr0 * 16 + gi_col] + bi, gf0 = CG[(size_t)gr0 * 16 + gf_col] + bfb;
            const float gi1 = CG[(size_t)gr1 * 16 + gi_col] + bi, gf1 = CG[(size_t)gr1 * 16 + gf_col] + bfb;
            const float f0 = fminf(gf0, 0.f) - __logf(1.f + __expf(-fabsf(gf0))), f1 = fminf(gf1, 0.f) - __logf(1.f + __expf(-fabsf(gf1)));
            float s0 = f0, s1 = f1;
#pragma unroll
            for (int o = 1; o < 64; o <<= 1) { const float a = __shfl_up(s0, o), c = __shfl_up(s1, o); if (lane >= o) { s0 += a; s1 += c; } }
            s1 += __shfl(s0, 63);
            const float blast = __shfl(s1, 63);
            const float a0 = gi0 - s0, a1 = gi1 - s1;
            float pm0 = a0, pm1 = a1;
#pragma unroll
            for (int o = 1; o < 64; o <<= 1) { const float a = __shfl_up(pm0, o), c = __shfl_up(pm1, o); if (lane >= o) { pm0 = fmaxf(pm0, a); pm1 = fmaxf(pm1, c); } }
            pm1 = fmaxf(pm1, __shfl(pm0, 63));
            const float A0 = __shfl(pm1, 63);
            const float M0 = fmaxf(m_st, pm0), M1 = fmaxf(m_st, pm1);
            if (wid == 0) {
                cvec[t0] = __expf(a0 - A0); cvec[t1] = __expf(a1 - A0);
                rvec[t0] = __expf(A0 - M0); rvec[t1] = __expf(A0 - M1);
                avec[t0] = __expf(m_st - M0); avec[t1] = __expf(m_st - M1);
                evec[t0] = __expf(-s0 - M0); evec[t1] = __expf(-s1 - M1);
            }
            const float Ml = fmaxf(m_st, A0);
            decay_r = __expf(m_st - Ml); factor_r = __expf(A0 - Ml);
            m_st = blast + Ml;
        }
        __syncthreads();
        {
            const int tau = (tid >> 4), ch = tid & 15;
#pragma unroll
            for (int p = 0; p < 12; ++p) { const int tt = (p & 3) * 32 + tau;
                if (p < 4) *(LAS u32x4*)(lds + ML_QI + tt * 272 + ch * 16) = st[p];
                else if (p < 8) { const float c = cvec[tt]; u32x4 v = st[p];
                    v.x = pk2(bflo(v.x) * c, bfhi(v.x) * c); v.y = pk2(bflo(v.y) * c, bfhi(v.y) * c); v.z = pk2(bflo(v.z) * c, bfhi(v.z) * c); v.w = pk2(bflo(v.w) * c, bfhi(v.w) * c);
                    *(LAS u32x4*)(lds + ML_KI + offb(tt, ch)) = v; }
                else *(LAS u32x4*)(lds + ML_VI + offb(tt, ch)) = st[p]; }
        }
        __syncthreads();
        {
            const int tb = wid & 3, eh = wid >> 2, t = 32 * tb + r32;
            const float rr = rvec[t], aa = avec[t], em = evec[t];
            bf16x8 qf[8];
#pragma unroll
            for (int d0 = 0; d0 < 8; ++d0) qf[d0] = *(const LAS bf16x8*)(lds + ML_QI + t * 272 + (16 * d0 + 8 * hi) * 2);
            f32x16 hh2[2]; float den1 = 0.f;
#pragma unroll
            for (int et = 0; et < 2; ++et) {
#pragma unroll
                for (int i = 0; i < 16; ++i) hh2[et][i] = 0.f;
#pragma unroll
                for (int d0 = 0; d0 < 8; ++d0) { const bf16x8 cf = *(const LAS bf16x8*)(lds + ML_CI + (32 * (2 * eh + et) + r32) * 272 + (16 * d0 + 8 * hi) * 2);
                    hh2[et] = __builtin_amdgcn_mfma_f32_32x32x16_bf16(cf, qf[d0], hh2[et], 0, 0, 0); }
#pragma unroll
                for (int i = 0; i < 16; ++i) hh2[et][i] *= aa;
            }
            float den2 = 0.f;
#pragma unroll
            for (int d0 = 0; d0 < 8; ++d0) { const f32x4 n0 = *(const LAS f32x4*)(nvec + 16 * d0 + 8 * hi), n1 = *(const LAS f32x4*)(nvec + 16 * d0 + 8 * hi + 4);
                const u32x4 qq = __builtin_bit_cast(u32x4, qf[d0]);
                den2 += bflo(qq.x) * n0[0] + bfhi(qq.x) * n0[1] + bflo(qq.y) * n0[2] + bfhi(qq.y) * n0[3] + bflo(qq.z) * n1[0] + bfhi(qq.z) * n1[1] + bflo(qq.w) * n1[2] + bfhi(qq.w) * n1[3]; }
            for (int sb = 0; sb <= tb; ++sb) {
                f32x16 g;
#pragma unroll
                for (int i = 0; i < 16; ++i) g[i] = 0.f;
#pragma unroll
                for (int d0 = 0; d0 < 8; ++d0) { const bf16x8 kf = *(const LAS bf16x8*)(lds + ML_KI + offb(32 * sb + r32, 2 * d0 + hi)); g = __builtin_amdgcn_mfma_f32_32x32x16_bf16(kf, qf[d0], g, 0, 0, 0); }
                if (sb == tb) {
#pragma unroll
                    for (int i = 0; i < 16; ++i) if (crow(i, hi) > r32) g[i] = 0.f; }
#pragma unroll
                for (int i = 0; i < 16; ++i) { g[i] *= rr; den1 += g[i]; }
#pragma unroll
                for (int ks = 0; ks < 2; ++ks) {
                    u32x4 pw; pw.x = pk2(g[8 * ks], g[8 * ks + 1]); pw.y = pk2(g[8 * ks + 2], g[8 * ks + 3]); pw.z = pk2(g[8 * ks + 4], g[8 * ks + 5]); pw.w = pk2(g[8 * ks + 6], g[8 * ks + 7]);
                    const bf16x8 pf = __builtin_bit_cast(bf16x8, pw);
                    const int krow = 32 * sb + 16 * ks + 4 * hi + q4;
#pragma unroll
                    for (int et = 0; et < 2; ++et) { const int ch = 4 * (2 * eh + et) + 2 * g1 + (p4 >> 1);
                        const s16x4 lo = trrd(lds + ML_VI + offb(krow, ch) + 8 * (p4 & 1)), hh = trrd(lds + ML_VI + offb(krow + 8, ch) + 8 * (p4 & 1));
                        hh2[et] = __builtin_amdgcn_mfma_f32_32x32x16_bf16(cat8(lo, hh), pf, hh2[et], 0, 0, 0); }
                }
            }
            den1 += __shfl_xor(den1, 32); den2 += __shfl_xor(den2, 32);
            const float den = den1 + aa * den2; const float inv = 1.f / fmaxf(fabsf(den), em);
            if (need_ctx || step >= 2) {
                const int gr = base + (dir ? 127 - t : t);
                bf16* op = Hout + (size_t)gr * 512 + h * 128;
#pragma unroll
                for (int et = 0; et < 2; ++et)
#pragma unroll
                    for (int i4 = 0; i4 < 4; ++i4) { const int e0 = 32 * (2 * eh + et) + 8 * i4 + 4 * hi;
                        u32x2 w; w.x = pk2(hh2[et][4 * i4] * inv, hh2[et][4 * i4 + 1] * inv); w.y = pk2(hh2[et][4 * i4 + 2] * inv, hh2[et][4 * i4 + 3] * inv);
                        *(u32x2*)(op + e0) = w; }
            }
        }
        __syncthreads();
        {
            const int db = wid & 3, eg = wid >> 2;
            f32x16 cl[2]; float nl = 0.f;
#pragma unroll
            for (int et = 0; et < 2; ++et)
#pragma unroll
                for (int i = 0; i < 16; ++i) cl[et][i] = 0.f;
#pragma unroll 2
            for (int ks = 0; ks < 8; ++ks) {
                const int trow = 16 * ks + 8 * hi + q4;
                const int chk = 4 * db + 2 * g1 + (p4 >> 1);
                const s16x4 klo = trrd(lds + ML_KI + offb(trow, chk) + 8 * (p4 & 1)), khi = trrd(lds + ML_KI + offb(trow + 4, chk) + 8 * (p4 & 1));
                const bf16x8 kT = cat8(klo, khi);
                const u32x4 kk = __builtin_bit_cast(u32x4, kT);
                nl += bflo(kk.x) + bfhi(kk.x) + bflo(kk.y) + bfhi(kk.y) + bflo(kk.z) + bfhi(kk.z) + bflo(kk.w) + bfhi(kk.w);
#pragma unroll
                for (int et = 0; et < 2; ++et) { const int chv = 4 * (2 * eg + et) + 2 * g1 + (p4 >> 1);
                    const s16x4 vlo = trrd(lds + ML_VI + offb(trow, chv) + 8 * (p4 & 1)), vhi = trrd(lds + ML_VI + offb(trow + 4, chv) + 8 * (p4 & 1));
                    cl[et] = __builtin_amdgcn_mfma_f32_32x32x16_bf16(kT, cat8(vlo, vhi), cl[et], 0, 0, 0); }
            }
            nl += __shfl_xor(nl, 32);
            const float decay = decay_r, factor = factor_r;
#pragma unroll
            for (int et = 0; et < 2; ++et) {
#pragma unroll
                for (int i = 0; i < 16; ++i) Cst[et][i] = decay * Cst[et][i] + factor * cl[et][i];
                const int e = 32 * (2 * eg + et) + r32;
#pragma unroll
                for (int i4 = 0; i4 < 4; ++i4) { u32x2 w; w.x = pk2(Cst[et][4 * i4], Cst[et][4 * i4 + 1]); w.y = pk2(Cst[et][4 * i4 + 2], Cst[et][4 * i4 + 3]);
                    *(LAS u32x2*)(lds + ML_CI + e * 272 + (32 * db + 8 * i4 + 4 * hi) * 2) = w; }
            }
            if (eg == 0 && hi == 0) nvec[32 * db + r32] = decay * nvec[32 * db + r32] + factor * nl;
        }
        __syncthreads();
    }
}

__device__ __forceinline__ void load_row(const float* p, int lane, f32x4 (&v)[4]) {
#pragma unroll
    for (int j = 0; j < 4; ++j) v[j] = *(const f32x4*)(p + 4 * lane + 256 * j);
}
__device__ __forceinline__ float row_rstd(const f32x4 (&v)[4]) {
    float s = 0.f;
#pragma unroll
    for (int j = 0; j < 4; ++j) s += v[j][0] * v[j][0] + v[j][1] * v[j][1] + v[j][2] * v[j][2] + v[j][3] * v[j][3];
    return __builtin_amdgcn_rsqf(wave_sum(s) * (1.f / D) + EPS);
}
__device__ __forceinline__ void norm_mod_store(const f32x4 (&v)[4], const float* g, const float* shift, const float* scale, bf16* out, fp8* out8, int lane) {
    const float rs = row_rstd(v);
#pragma unroll
    for (int j = 0; j < 4; ++j) { const int c = 4 * lane + 256 * j; const f32x4 gg = *(const f32x4*)(g + c), sh = *(const f32x4*)(shift + c), sc = *(const f32x4*)(scale + c);
        const f32x4 y = (v[j] * rs * gg) * (sc + 1.f) + sh;
        u32x2 w; w.x = pk2(y[0], y[1]); w.y = pk2(y[2], y[3]); *(u32x2*)(out + c) = w;
        *(unsigned*)(out8 + c) = pk4_fp8(y * 8.f); }
}

template <class MapF>
__device__ __forceinline__ void wt_item(const MapF& mf, int K, int src_ld, bf16* dst, int item, int nblk, LAS float* scr, int lane) {
    const float* dummy = mf.base();
    const int kb = item / nblk, nb = item % nblk, k0 = 64 * kb, n0 = 32 * nb;
    const float* sp; float sc; mf(n0 + (lane & 31), sp, sc);
    if (!sp) { sp = dummy; sc = 0.f; }
    float tv[32];
#pragma unroll
    for (int i = 0; i < 32; ++i) tv[i] = sp[(size_t)(k0 + 2 * i + (lane >> 5)) * src_ld];
#pragma unroll
    for (int i = 0; i < 32; ++i) { const int kk = 2 * i + (lane >> 5); scr[kk * 33 + (lane & 31)] = tv[i] * sc; }
    LDS_WAIT(); asm volatile("" ::: "memory");
    const int c = lane & 7;
#pragma unroll
    for (int j = 0; j < 4; ++j) { const int n = (lane >> 3) + 8 * j; const LAS float* s = scr + (8 * c) * 33 + n;
        u32x4 o; o.x = pk2(s[0 * 33], s[1 * 33]); o.y = pk2(s[2 * 33], s[3 * 33]); o.z = pk2(s[4 * 33], s[5 * 33]); o.w = pk2(s[6 * 33], s[7 * 33]);
        *(u32x4*)(dst + (size_t)(n0 + n) * K + k0 + 8 * c) = o; }
    LDS_WAIT(); asm volatile("" ::: "memory");
}
template <class MapF>
__device__ __forceinline__ void wt_item8(const MapF& mf, int K, int src_ld, fp8* dst, int item, int nblk, float scale, LAS float* scr, int lane) {
    const float* dummy = mf.base();
    const int kb = item / nblk, nb = item % nblk, k0 = 64 * kb, n0 = 32 * nb;
    const float* sp; float sc; mf(n0 + (lane & 31), sp, sc); sc *= scale;
    if (!sp) { sp = dummy; sc = 0.f; }
    float tv[32];
#pragma unroll
    for (int i = 0; i < 32; ++i) tv[i] = sp[(size_t)(k0 + 2 * i + (lane >> 5)) * src_ld];
#pragma unroll
    for (int i = 0; i < 32; ++i) { const int kk = 2 * i + (lane >> 5); scr[kk * 33 + (lane & 31)] = tv[i] * sc; }
    LDS_WAIT(); asm volatile("" ::: "memory");
    const int c = lane & 7;
#pragma unroll
    for (int j = 0; j < 4; ++j) { const int n = (lane >> 3) + 8 * j; const LAS float* s = scr + (8 * c) * 33 + n;
        u32x2 o; o.x = pk4_fp8((f32x4){s[0 * 33], s[1 * 33], s[2 * 33], s[3 * 33]}); o.y = pk4_fp8((f32x4){s[4 * 33], s[5 * 33], s[6 * 33], s[7 * 33]});
        *(u32x2*)(dst + (size_t)(n0 + n) * K + k0 + 8 * c) = o; }
    LDS_WAIT(); asm volatile("" ::: "memory");
}
__device__ __forceinline__ int permd(int p) { const int i = p >> 3, w = p & 7; return (i < 4 ? 0 : 32) + (w < 4 ? 0 : 16) + 4 * (i & 3) + (w & 3); }
struct MapWin { const float* w;
    __device__ __forceinline__ const float* base() const { return w; }
    __device__ __forceinline__ void operator()(int n, const float*& sp, float& sc) const {
        if (n >= 4368) { sp = nullptr; sc = 0.f; return; }
        int col = n; sc = 1.f;
        if (n < 640 || (n >= 768 && n < 1792)) col = (n & ~63) + permd(n & 63);
        if (n < 512 || (n >= 768 && n < 1280)) sc = 0.125f * LOG2E;
        if (n >= 2816 && n < 3328) sc = 0.08838834764831845f;
        sp = w + col; } };
struct MapLin { const float* w; int off, nvalid;
    __device__ __forceinline__ const float* base() const { return w; }
    __device__ __forceinline__ void operator()(int n, const float*& sp, float& sc) const { sc = 1.f; sp = n < nvalid ? w + off + n : nullptr; } };
struct MapGU { const float* g; long du;
    __device__ __forceinline__ const float* base() const { return g; }
    __device__ __forceinline__ void operator()(int n, const float*& sp, float& sc) const { const int i = n >> 3, w = n & 7, j = 4 * i + (w & 3); sc = 1.f; sp = g + (j + (w < 4 ? 0l : du)); } };

__global__ void __launch_bounds__(512, 2) fwd_kernel(Args args) {
    extern __shared__ __attribute__((aligned(16))) unsigned char lds_raw[];
    LAS unsigned char* lds = (LAS unsigned char*)lds_raw;
    const int G = gridDim.x, bx = blockIdx.x, NGW = G * 8;
    GAS unsigned char* const ws0 = args.ws;
    unsigned* ctl = (unsigned*)(ws0 + WS_CTL);
#define PH_BEGIN int tid_p = threadIdx.x; asm volatile("" : "+v"(tid_p)); const int tid = tid_p, lane = tid & 63, wid = __builtin_amdgcn_readfirstlane(tid >> 6), gw = bx * 8 + wid; \
    GAS unsigned char* ws = ws0; asm volatile("" : "+s"(ws)); (void)lane; (void)gw;
    volatile LAS unsigned* MISC = (volatile LAS unsigned*)(lds + LDS_MISC);
    LAS int* tab = (LAS int*)(lds + LDS_TAB);
    if (threadIdx.x < 32) MISC[threadIdx.x] = 0u;
    __syncthreads();
#if ONE_LAUNCH
    XcdBarrier bar = xcd_barrier_post(ctl + CW_BAR, MISC + 8);
#define GRID_BAR() xcd_barrier(bar)
#else
#define GRID_BAR() do {} while (0)
#endif
    const int lo = args.lo, hi_ = args.hi;
#define IN(k) (lo <= (k) && (k) < hi_)
    CArgsP akp = (CArgsP)__builtin_amdgcn_kernarg_segment_ptr();
#define AIN(i) ((const float*)(launder_args(akp)->in[i]))
    unsigned long long pr_prev = 0ull, pr_acc = 0ull;
    if (PROBE_MASK) pr_prev = __builtin_amdgcn_s_memrealtime();
#define SEAM(k) do { if (IN(k) && IN((k) + 1)) GRID_BAR(); if (PROBE_MASK) { const unsigned long long _t = __builtin_amdgcn_s_memrealtime(); const int _b = (k) == 0 ? 16 : (((k) - 1) % NPH); \
        if ((PROBE_MASK >> _b) & 1) pr_acc += _t - pr_prev; pr_prev = _t; } } while (0)

#define x_in AIN(0)
#define c_in AIN(1)
#define ctx_in AIN(2)
#define cctx_in AIN(3)
#define mods ((float*)(ws + WS_MODS))
#define rope ((float*)(ws + WS_ROPE))
#define lamv ((float*)(ws + WS_LAM))
#define HL ((bf16*)(ws + WS_HL))
#define XS ((bf16*)(ws + WS_XS))
#define OUTF ((float*)(launder_args(akp)->out))
#define QA ((bf16*)(ws + WS_QA))
#define QB ((bf16*)(ws + WS_QB))
#define QC ((bf16*)(ws + WS_QC))
#define OA ((bf16*)(launder_args(akp)->out))
#define OB (((bf16*)(launder_args(akp)->out)) + (size_t)MA * 512)
#define HF ((bf16*)(ws + WS_HF))
#define HB ((bf16*)(ws + WS_HB))
#define GT ((unsigned char*)(ws + WS_GT))
#define Y ((bf16*)(ws + WS_Y))
#define CG ((float*)(ws + WS_CG))
#define LOG ((float*)(ws + WS_LOG))
#define TOKE ((int*)(ws + WS_TOKE))
#define TOKP ((int*)(ws + WS_TOKP))
#define ELIST ((int*)(ws + WS_ELIST))
#define WLIST ((float*)(ws + WS_WLIST))
#define WIN ((bf16*)(ws + WS_WIN))
#define WGT ((fp8*)(ws + WS_WGT))
#define HL8 ((fp8*)(ws + WS_Y))
#define WA ((bf16*)(ws + WS_WA))
#define WB ((bf16*)(ws + WS_WB))
#define WC ((bf16*)(ws + WS_WC))
#define WO ((bf16*)(ws + WS_WO))
#define WR ((bf16*)(ws + WS_WR))
#define WGU ((fp8*)(ws + WS_WGU))
#define H8 ((fp8*)(ws + WS_HF))
#define WD ((fp8*)(ws + WS_WD))
#define A2 ((fp8*)(ws + WS_A2))
#define Y2 ((fp8*)(ws + WS_Y2))
    if (IN(0)) {
        PH_BEGIN
        LAS float* sc = (LAS float*)lds;
        for (int i = tid; i < 9 * 1024; i += 512) { const int b = i >> 10, k = i & 1023; const float cv = b < 8 ? c_in[b * 1024 + k] : cctx_in[k]; sc[i] = cv * sigm(cv); }
        __syncthreads();
        LAS float* red = sc + 9 * 1024;
        for (int unit = bx; unit < 192; unit += G) {
            const int l = unit / 96, n0 = (unit % 96) * 64, cl = tid & 63, ks = tid >> 6;
            float acc[9];
#pragma unroll
            for (int b = 0; b < 9; ++b) acc[b] = 0.f;
            const float* w = AIN(4) + (size_t)l * 1024 * 6144 + n0 + cl;
#pragma unroll 16
            for (int k = 128 * ks; k < 128 * ks + 128; ++k) { const float wv = w[(size_t)k * 6144];
#pragma unroll
                for (int b = 0; b < 9; ++b) acc[b] += sc[b * 1024 + k] * wv; }
#pragma unroll
            for (int b = 0; b < 9; ++b) red[(ks * 9 + b) * 64 + cl] = acc[b];
            __syncthreads();
            for (int i = tid; i < 9 * 64; i += 512) { const int b = i >> 6, c2 = i & 63; float s = 0.f;
#pragma unroll
                for (int k2 = 0; k2 < 8; ++k2) s += red[(k2 * 9 + b) * 64 + c2];
                mods[(size_t)(l * 9 + b) * 6144 + n0 + c2] = s + AIN(5)[l * 6144 + n0 + c2]; }
            __syncthreads();
        }
        if (bx == G - 1) {
            for (int i = tid; i < 1024; i += 512) { const int pos = i >> 4, j = i & 15; const float inv = ex2(-(float)j * (13.287712379549449f / 16.f)); const float ang = (float)pos * inv;
                rope[i] = __cosf(ang); rope[1024 + i] = __sinf(ang); }
            if (wid == 0) {
#pragma unroll
                for (int l = 0; l < 2; ++l) { const float a = wave_sum(AIN(11)[l * 64 + lane] * AIN(12)[l * 64 + lane]), b2 = wave_sum(AIN(13)[l * 64 + lane] * AIN(14)[l * 64 + lane]);
                    const float li = 0.8f - 0.6f * __expf(-0.3f * (float)l);
                    if (lane == 0) lamv[l] = __expf(a) - __expf(b2) + li; }
            }
        }
    }
    SEAM(0);

    for (int layer = 0; layer < 2; ++layer) {
        const int P0 = 1 + layer * NPH;
        const bool need_ctx = layer == 0;
        const int Mx = need_ctx ? MA : ML;
        const int Mh = Mx / 2;
#define modl (mods + (size_t)layer * 9 * 6144)
        const float lam_init = 0.8f - 0.6f * __expf(-0.3f * (float)layer);

        if (IN(P0 + 0)) {
            PH_BEGIN
            LAS float* scr = (LAS float*)(lds + wid * 8448);
            const float* w_in = AIN(8) + (size_t)layer * 1024 * NIN;
            for (int it = gw; it < 5248; it += NGW) {
                int r = it;
                if (r < 2304) { MapWin mf{w_in}; wt_item(mf, 1024, NIN, WIN, r, 144, scr, lane); continue; } r -= 2304;
                if (r < 1536) { MapLin mf{w_in, 4368, 3072}; wt_item8(mf, 1024, NIN, WGT, r, 96, 64.f, scr, lane); continue; } r -= 1536;
                if (r < 768) { const int which = r >> 8; const float* src = AIN(17 + which) + (size_t)layer * 512 * 1024; MapLin mf{src, 0, 1024};
                    wt_item(mf, 512, 1024, which == 0 ? WA : (which == 1 ? WB : WC), r & 255, 32, scr, lane); continue; } r -= 768;
                if (r < 512) { MapLin mf{AIN(20) + (size_t)layer * 1024 * 1024, 0, 1024}; wt_item(mf, 1024, 1024, WO, r, 32, scr, lane); continue; } r -= 512;
                { MapLin mf{AIN(21) + (size_t)layer * 1024 * 64, 0, 64}; wt_item(mf, 1024, 64, WR, r, 8, scr, lane); }
            }
            if (layer == 0) {
                for (int m = gw; m < MA; m += NGW) {
                    const float* xr = m < ML ? x_in + (size_t)m * D : ctx_in + (size_t)(m - ML) * D;
                    const float* mv = modl + (m < ML ? (m >> 12) : 8) * 6144;
                    f32x4 v[4]; load_row(xr, lane, v);
                    norm_mod_store(v, AIN(6) + layer * D, mv, mv + 1024, HL + (size_t)m * D, HL8 + (size_t)m * D, lane);
                }
            }
        }
        SEAM(P0 + 0);

        if (IN(P0 + 1)) {
            PH_BEGIN
            for (int rep = 0; rep < REP_G1; ++rep) {
            pg8::DenseSched S; S.init(HL, WIN, MA, N1, 1024, G, bx);
            EpiG1 E{QA, QB, QC, CG, rope};
            pg8::gemm_phase(lds, 1024, S, E); }
        }
        SEAM(P0 + 1);

        if (IN(P0 + 2)) {
            PH_BEGIN
            for (int rep = 0; rep < REP_C; ++rep) {
            unsigned* wq = ctl + CW_WQ + 64 * ((layer * 2 + rep) * 4);
            for (;;) {
                if (tid == 0) MISC[0] = atomicAdd(wq, 1u);
                __syncthreads();
                const int u = (int)MISC[0];
                __syncthreads();
                if (u >= 64) break;
                mlstm_unit(lds, u, QC, CG, AIN(9) + layer * 16, HF, HB, need_ctx);
            } }
            const int nB = need_ctx ? 1088 : 1024;
            const float lam = lamv[layer];
            for (int rep = 0; rep < REP_B; ++rep) {
            unsigned* wq = ctl + CW_WQ + 64 * ((layer * 2 + rep) * 4);
            for (;;) {
                if (tid == 0) MISC[0] = atomicAdd(wq + 64, 1u);
                __syncthreads();
                const int u = (int)MISC[0];
                __syncthreads();
                if (u >= nB) break;
                mixB_unit(lds, u, QB, OB, AIN(15) + layer * 128, lam, lam_init);
            } }
            for (int rep = 0; rep < REP_A; ++rep) {
            unsigned* wq = ctl + CW_WQ + 64 * ((layer * 2 + rep) * 4);
            for (;;) {
                if (tid == 0) MISC[0] = atomicAdd(wq + 128, 1u);
                __syncthreads();
                const int u = (int)MISC[0];
                __syncthreads();
                if (u >= nB) break;
                mixA_unit(lds, u, QA, OA, AIN(10) + layer * 8);
                __syncthreads();
            } }
        }
        SEAM(P0 + 2);


        if (IN(P0 + 4)) {
            PH_BEGIN
            {
            const float* gm = AIN(16) + layer * 512;
            for (int m = gw; m < Mx; m += NGW) {
                const u32x4 a = *(const u32x4*)(HF + (size_t)m * 512 + 8 * lane), b = *(const u32x4*)(HB + (size_t)m * 512 + 8 * lane);
                const u32x4 co = *(const u32x4*)(QC + (size_t)m * LDC_ + 1536 + 8 * lane);
                float v[8];
                v[0] = bflo(a.x) + bflo(b.x); v[1] = bfhi(a.x) + bfhi(b.x); v[2] = bflo(a.y) + bflo(b.y); v[3] = bfhi(a.y) + bfhi(b.y);
                v[4] = bflo(a.z) + bflo(b.z); v[5] = bfhi(a.z) + bfhi(b.z); v[6] = bflo(a.w) + bflo(b.w); v[7] = bfhi(a.w) + bfhi(b.w);
                float ss = 0.f;
#pragma unroll
                for (int k = 0; k < 8; ++k) ss += v[k] * v[k];
                ss += __shfl_xor(ss, 1); ss += __shfl_xor(ss, 2); ss += __shfl_xor(ss, 4); ss += __shfl_xor(ss, 8);
                const float rs = __builtin_amdgcn_rsqf(ss * (1.f / 128.f) + EPS);
                const f32x4 g0 = *(const f32x4*)(gm + 8 * lane), g1v = *(const f32x4*)(gm + 8 * lane + 4);
                u32x4 w;
                w.x = pk2(v[0] * rs * g0[0] * sigm(bflo(co.x)), v[1] * rs * g0[1] * sigm(bfhi(co.x)));
                w.y = pk2(v[2] * rs * g0[2] * sigm(bflo(co.y)), v[3] * rs * g0[3] * sigm(bfhi(co.y)));
                w.z = pk2(v[4] * rs * g1v[0] * sigm(bflo(co.z)), v[5] * rs * g1v[1] * sigm(bfhi(co.z)));
                w.w = pk2(v[6] * rs * g1v[2] * sigm(bflo(co.w)), v[7] * rs * g1v[3] * sigm(bfhi(co.w)));
                *(u32x4*)(HF + (size_t)m * 512 + 8 * lane) = w;
            }
            }
            pg8::DenseSched S; S.init(HL8, WGT, Mx, NGT, 512, G, bx);
            EpiSig8 E{GT, NGT};
            pg8::gemm_phase<EpiSig8, pg8::DenseSched, true, 0x7C7C7C7C, 0x79797979>(lds, 512, S, E);
        }
        SEAM(P0 + 4);

        if (IN(P0 + 5)) {
            PH_BEGIN
            pg8::Gate3Sched S; S.A = (const char*)OA; S.Bt = (const char*)WA; S.dA1 = (const char*)OB - (const char*)OA; S.dA2 = (const char*)HF - (const char*)OA;
            S.dB1 = (const char*)WB - (const char*)WA; S.dB2 = (const char*)WC - (const char*)WA; S.K = 512; S.nM = Mx / 256; S.nN = 4; S.nwg = S.nM * 4; S.G = G; S.c = bx;
            EpiGate3 E{GT, Y};
            pg8::gemm_phase(lds, 512, S, E);
        }
        SEAM(P0 + 5);

        if (IN(P0 + 6)) {
            PH_BEGIN
            pg8::DenseSched S; S.init(Y, WO, Mx, 1024, 1024, G, bx);
            EpiRes E{layer == 0 ? x_in : (const float*)nullptr, ctx_in, XS, modl + 2 * 1024, 0};
            pg8::gemm_phase(lds, 1024, S, E);
        }
        SEAM(P0 + 6);

        if (IN(P0 + 7)) {
            PH_BEGIN
            for (int m = gw; m < Mx; m += NGW) {
                const bf16* xr = XS + (size_t)m * D;
                const float* mv = modl + (m < ML ? (m >> 12) : 8) * 6144;
                f32x4 v[4];
#pragma unroll
                for (int g2 = 0; g2 < 2; ++g2) { const u32x4 r = *(const u32x4*)(xr + g2 * 512 + 8 * lane);
                    v[2 * g2] = (f32x4){bflo(r.x), bfhi(r.x), bflo(r.y), bfhi(r.y)}; v[2 * g2 + 1] = (f32x4){bflo(r.z), bfhi(r.z), bflo(r.w), bfhi(r.w)}; }
                const float rs = row_rstd(v);
#pragma unroll
                for (int g2 = 0; g2 < 2; ++g2) { u32x4 w; u32x2 w8;
#pragma unroll
                    for (int q = 0; q < 2; ++q) { const int c = g2 * 512 + 8 * lane + 4 * q; const f32x4 gg = *(const f32x4*)(AIN(7) + layer * D + c), sh = *(const f32x4*)(mv + 3 * 1024 + c), sc = *(const f32x4*)(mv + 4 * 1024 + c);
                        const f32x4 y = (v[2 * g2 + q] * rs * gg) * (sc + 1.f) + sh;
                        if (q == 0) { w.x = pk2(y[0], y[1]); w.y = pk2(y[2], y[3]); w8.x = pk4_fp8(y * 8.f); } else { w.z = pk2(y[0], y[1]); w.w = pk2(y[2], y[3]); w8.y = pk4_fp8(y * 8.f); } }
                    *(u32x4*)(HL + (size_t)m * D + g2 * 512 + 8 * lane) = w;
                    *(u32x2*)(H8 + (size_t)m * D + g2 * 512 + 8 * lane) = w8; }
            }
            LAS float* scr = (LAS float*)(lds + wid * 8448);
            for (int it = gw; it < 24960; it += NGW) {
                if (it < 16640) { const int e = it >> 8, r = it & 255;
                    const float* gsrc = e < 64 ? AIN(23) + (size_t)(layer * 64 + e) * 1024 * 256 : AIN(26) + (size_t)layer * 1024 * 256;
                    const float* usrc = e < 64 ? AIN(24) + (size_t)(layer * 64 + e) * 1024 * 256 : AIN(27) + (size_t)layer * 1024 * 256;
                    MapGU mf{gsrc, (long)(usrc - gsrc)}; wt_item8(mf, 1024, 256, WGU + (size_t)e * 512 * 1024, r, 16, 64.f, scr, lane); }
                else { const int r2 = it - 16640, e = r2 >> 7, r = r2 & 127;
                    const float* src = e < 64 ? AIN(25) + (size_t)(layer * 64 + e) * 256 * 1024 : AIN(28) + (size_t)layer * 256 * 1024;
                    MapLin mf{src, 0, 1024}; wt_item8(mf, 256, 1024, WD + (size_t)e * 1024 * 256, r, 32, 32.f, scr, lane); }
            }
        }
        SEAM(P0 + 7);


        if (IN(P0 + 9)) {
            PH_BEGIN
            LAS int* lcnt = (LAS int*)lds; LAS int* lbase = lcnt + 128;
            LAS unsigned* st_e = (LAS unsigned*)(lds + 1024); LAS float* st_w = (LAS float*)(lds + 1024 + 8192);
            const int tpb = (Mx + G - 1) / G, m0 = bx * tpb, ntok = (m0 + tpb <= Mx) ? tpb : (Mx > m0 ? Mx - m0 : 0);
            if (tid < 128) lcnt[tid] = 0;
            LAS float* llog = (LAS float*)(lds + 32768);
            {
                const int r32 = lane & 31, hi = lane >> 5;
                const int tl = wid * 32 + r32, tlc = tl < ntok ? tl : (ntok > 0 ? ntok - 1 : 0);
                const bf16* hp = HL + (size_t)(m0 + tlc < Mx ? m0 + tlc : 0) * D + 8 * hi;
                LAS unsigned char* wl = lds + 69632;
                f32x16 c0, c1;
#pragma unroll
                for (int i = 0; i < 16; ++i) { c0[i] = 0.f; c1[i] = 0.f; }
#pragma unroll 1
                for (int kh = 0; kh < 2; ++kh) {
                    __syncthreads();
#pragma unroll
                    for (int pp = 0; pp < 8; ++pp) { const int idx = tid + 512 * pp, row = idx >> 6, ch = idx & 63;
                        *(LAS u32x4*)(wl + row * 1040 + ch * 16) = *(const u32x4*)(WR + (size_t)row * 1024 + kh * 512 + ch * 8); }
                    __syncthreads();
                    if (wid * 32 < ntok) {
#pragma unroll 1
                        for (int kb = 0; kb < 512; kb += 256) {
                            bf16x8 a[16];
#pragma unroll
                            for (int q = 0; q < 16; ++q) a[q] = *(const bf16x8*)(hp + kh * 512 + kb + 16 * q);
#pragma unroll
                            for (int q = 0; q < 16; ++q) { const LAS unsigned char* bp = wl + r32 * 1040 + (kb * 2) + (2 * q + hi) * 16;
                                const bf16x8 b0 = *(const LAS bf16x8*)bp, b1 = *(const LAS bf16x8*)(bp + 32 * 1040);
                                c0 = __builtin_amdgcn_mfma_f32_32x32x16_bf16(b0, a[q], c0, 0, 0, 0); c1 = __builtin_amdgcn_mfma_f32_32x32x16_bf16(b1, a[q], c1, 0, 0, 0); }
                        }
                    }
                }
                if (tl < ntok) {
#pragma unroll
                    for (int i = 0; i < 16; ++i) { llog[tl * 64 + crow(i, hi)] = c0[i]; llog[tl * 64 + 32 + crow(i, hi)] = c1[i]; }
                }
            }
            __syncthreads();
            const float* br = AIN(22) + layer * 64;
            const float bias = br[lane];
            for (int tl = wid; tl < ntok; tl += 8) {
                const int m = m0 + tl;
                const int half = m >= Mh ? 1 : 0;
                const float sg = sigm(llog[tl * 64 + lane]);
                const float sel = sg + bias;
                float m1 = sel; m1 = fmaxf(m1, __shfl_xor(m1, 1)); m1 = fmaxf(m1, __shfl_xor(m1, 2)); m1 = fmaxf(m1, __shfl_xor(m1, 4));
                const unsigned long long bm = __ballot(sel == m1);
                const unsigned gmask = (unsigned)(bm >> (lane & 56)) & 0xffu;
                const int first = __builtin_ctz(gmask);
                float v2 = ((lane & 7) == first) ? -3.0e38f : sel;
                v2 = fmaxf(v2, __shfl_xor(v2, 1)); v2 = fmaxf(v2, __shfl_xor(v2, 2)); v2 = fmaxf(v2, __shfl_xor(v2, 4));
                const float gsc = m1 + v2; const int g = lane >> 3;
                int gr = 0;
#pragma unroll
                for (int g2 = 0; g2 < 8; ++g2) { const float o = __int_as_float(__builtin_amdgcn_readlane(__float_as_int(gsc), 8 * g2)); gr += (o > gsc || (o == gsc && g2 < g)) ? 1 : 0; }
                const bool gsel = gr < 4;
                const float mv = gsel ? sel : -3.0e38f;
                const unsigned ub = (unsigned)__float_as_int(mv);
                const unsigned key = ((ub ^ ((ub >> 31) ? 0xFFFFFFFFu : 0x80000000u)) & ~63u) | (unsigned)(63 - lane);
                int rank = 0;
#pragma unroll
                for (int e2 = 0; e2 < 64; ++e2) { const unsigned ok = (unsigned)__builtin_amdgcn_readlane((int)key, e2); rank += ok > key ? 1 : 0;
                    if ((e2 & 7) == 7) asm volatile("" : "+v"(rank)); }
                const bool chosen = gsel && rank < 8;
                const float ssum = wave_sum(chosen ? sg : 0.f);
                if (chosen) {
                    const int lpos = __hip_atomic_fetch_add(lcnt + half * 64 + lane, 1, __ATOMIC_RELAXED, __HIP_MEMORY_SCOPE_WORKGROUP);
                    st_e[tl * 8 + rank] = (unsigned)lane | ((unsigned)lpos << 8); st_w[tl * 8 + rank] = sg / ssum * 2.5f;
                }
            }
            __syncthreads();
            if (tid < 128) { const int c = lcnt[tid]; lbase[tid] = c ? (int)atomicAdd(ctl + CW_CNT + 16 * ((layer * 2 + (tid >> 6)) * 64 + (tid & 63)), (unsigned)c) : 0; }
            __syncthreads();
            for (int idx = tid; idx < ntok * 8; idx += 512) {
                const int m = m0 + (idx >> 3), slot = idx & 7, half = m >= Mh ? 1 : 0;
                const unsigned v = st_e[idx]; const int e = (int)(v & 0xffu), pos = lbase[half * 64 + e] + (int)(v >> 8);
                ELIST[((size_t)half * 64 + e) * CAP + pos] = m; WLIST[((size_t)half * 64 + e) * CAP + pos] = st_w[idx];
                TOKE[(size_t)m * 8 + slot] = e; TOKP[(size_t)m * 8 + slot] = pos;
            }
        }
        SEAM(P0 + 9);

        for (int half = 0; half < 2; ++half) {
            const int PH = P0 + 10 + 3 * half;
            const int hbase = half * Mh;
            if (IN(PH) || IN(PH + 1) || IN(PH + 2)) {
                PH_BEGIN
                if (wid == 0) {
                    const int c = (int)__hip_atomic_load(ctl + CW_CNT + 16 * ((layer * 2 + half) * 64 + lane), __ATOMIC_RELAXED, __HIP_MEMORY_SCOPE_AGENT);
                    const int pad = (c + 255) & ~255;
                    int inc = pad;
#pragma unroll
                    for (int o = 1; o < 64; o <<= 1) { const int a = __shfl_up(inc, o); if (lane >= o) inc += a; }
                    tab[lane] = c; tab[65 + lane] = inc - pad;
                    if (lane == 63) { tab[64] = Mh; tab[65 + 64] = inc; }
                }
                __syncthreads();
            }
            if (IN(PH)) {
                PH_BEGIN
                if (wid == 0) {
                    tab[130 + lane] = (tab[65 + lane] >> 8) * 2; if (lane == 63) { tab[130 + 64] = (tab[65 + 64] >> 8) * 2; tab[195] = ((tab[65 + 64] + Mh) >> 8) * 2; } }
                __syncthreads();
                pg8::MoeSched<2, true> S; S.Abase = (const char*)H8; S.Bbase = (const char*)WGU; S.bstride = (size_t)512 * 1024; S.K = 512; S.elist = ELIST + (size_t)half * 64 * CAP; S.tab = tab;
                S.hbase = hbase; S.nU = tab[195]; S.G = G; S.c = bx; S.NE = 65; S.ehint = 0;
                EpiSwiGLU E{A2};
                pg8::gemm_phase<EpiSwiGLU, pg8::MoeSched<2, true>, true, 0x7C7C7C7C, 0x79797979>(lds, 512, S, E);
            }
            SEAM(PH);
            if (IN(PH + 1) && !DBG_H) {
                PH_BEGIN
                __syncthreads();
                if (wid == 0) { tab[130 + lane] = (tab[65 + lane] >> 8) * 4; if (lane == 63) { tab[194] = (tab[65 + 64] >> 8) * 4; tab[195] = (tab[65 + 64] >> 8) * 4; } }
                __syncthreads();
                {
                    pg8::MoeSched<4, false> S; S.Abase = (const char*)A2; S.Bbase = (const char*)WD; S.bstride = (size_t)1024 * 256; S.K = 128; S.elist = nullptr; S.tab = tab;
                    S.hbase = hbase; S.nU = tab[195]; S.G = G; S.c = bx; S.NE = 64; S.ehint = 0;
                    EpiY2 E{Y2, WLIST + (size_t)half * 64 * CAP};
                    pg8::gemm_phase<EpiY2, pg8::MoeSched<4, false>, true, 0x7D7D7D7D, 0x7A7A7A7A>(lds, 128, S, E);
                }
                {
                    pg8::DenseSched S; S.init(A2 + (size_t)tab[65 + 64] * 256, WD + (size_t)64 * 1024 * 256, Mh, 1024, 128, G, bx);
                    EpiRes E{nullptr, nullptr, XS, modl + 5 * 1024, hbase};
                    pg8::gemm_phase<EpiRes, pg8::DenseSched, true, 0x7D7D7D7D, 0x7A7A7A7A>(lds, 128, S, E);
                }
            }
            SEAM(PH + 1);
            if (IN(PH + 2)) {
                PH_BEGIN
                for (int m = hbase + gw; m < hbase + Mh; m += NGW) {
                    bf16* xr = XS + (size_t)m * D;
                    const float* mv = modl + (m < ML ? (m >> 12) : 8) * 6144;
                    f32x4 v[4], s4[4];
#pragma unroll
                    for (int g2 = 0; g2 < 2; ++g2) { const u32x4 r = *(const u32x4*)(xr + g2 * 512 + 8 * lane);
                        v[2 * g2] = (f32x4){bflo(r.x), bfhi(r.x), bflo(r.y), bfhi(r.y)}; v[2 * g2 + 1] = (f32x4){bflo(r.z), bfhi(r.z), bflo(r.w), bfhi(r.w)}; s4[2 * g2] = s4[2 * g2 + 1] = (f32x4){0.f, 0.f, 0.f, 0.f}; }
                    u32x2 yv[8][2];
#pragma unroll
                    for (int k = 0; k < 8; ++k) {
                        const int e = TOKE[(size_t)m * 8 + k], pos = TOKP[(size_t)m * 8 + k];
                        const fp8* yr = Y2 + (size_t)(tab[65 + e] + pos) * 1024 + 8 * lane;
                        yv[k][0] = *(const u32x2*)yr; yv[k][1] = *(const u32x2*)(yr + 512);
                    }
#pragma unroll
                    for (int k = 0; k < 8; ++k)
#pragma unroll
                        for (int g2 = 0; g2 < 2; ++g2) {
                            const f32x2 a = __builtin_amdgcn_cvt_pk_f32_fp8((int)yv[k][g2].x, false), b = __builtin_amdgcn_cvt_pk_f32_fp8((int)yv[k][g2].x, true);
                            const f32x2 c = __builtin_amdgcn_cvt_pk_f32_fp8((int)yv[k][g2].y, false), d = __builtin_amdgcn_cvt_pk_f32_fp8((int)yv[k][g2].y, true);
                            s4[2 * g2][0] += a[0]; s4[2 * g2][1] += a[1]; s4[2 * g2][2] += b[0]; s4[2 * g2][3] += b[1];
                            s4[2 * g2 + 1][0] += c[0]; s4[2 * g2 + 1][1] += c[1]; s4[2 * g2 + 1][2] += d[0]; s4[2 * g2 + 1][3] += d[1];
                        }
#pragma unroll
                    for (int j = 0; j < 4; ++j) { const f32x4 m5 = *(const f32x4*)(mv + 5 * 1024 + (j >> 1) * 512 + 8 * lane + 4 * (j & 1)); v[j] = v[j] + m5 * (s4[j] * 0.0625f); }
                    const float rs = row_rstd(v);
                    if (layer == 0) {
                        const float* mn = mods + (size_t)9 * 6144 + (m < ML ? (m >> 12) : 8) * 6144;
                        const float* g = AIN(6) + D;
#pragma unroll
                        for (int g2 = 0; g2 < 2; ++g2) { u32x4 w; w.x = pk2(v[2 * g2][0], v[2 * g2][1]); w.y = pk2(v[2 * g2][2], v[2 * g2][3]); w.z = pk2(v[2 * g2 + 1][0], v[2 * g2 + 1][1]); w.w = pk2(v[2 * g2 + 1][2], v[2 * g2 + 1][3]);
                            *(u32x4*)(xr + g2 * 512 + 8 * lane) = w; }
#pragma unroll
                        for (int g2 = 0; g2 < 2; ++g2) { u32x4 w; u32x2 w8;
#pragma unroll
                            for (int q = 0; q < 2; ++q) { const int c = g2 * 512 + 8 * lane + 4 * q; const f32x4 gg = *(const f32x4*)(g + c), sh = *(const f32x4*)(mn + c), sc = *(const f32x4*)(mn + 1024 + c);
                                const f32x4 y = (v[2 * g2 + q] * rs * gg) * (sc + 1.f) + sh;
                                if (q == 0) { w.x = pk2(y[0], y[1]); w.y = pk2(y[2], y[3]); w8.x = pk4_fp8(y * 8.f); } else { w.z = pk2(y[0], y[1]); w.w = pk2(y[2], y[3]); w8.y = pk4_fp8(y * 8.f); } }
                            *(u32x4*)(HL + (size_t)m * D + g2 * 512 + 8 * lane) = w; *(u32x2*)(HL8 + (size_t)m * D + g2 * 512 + 8 * lane) = w8; }
                    } else {
#pragma unroll
                        for (int j = 0; j < 4; ++j) { const int c = (j >> 1) * 512 + 8 * lane + 4 * (j & 1); const f32x4 gg = *(const f32x4*)(AIN(29) + c); *(f32x4*)(OUTF + (size_t)m * D + c) = v[j] * rs * gg; }
                    }
                }
            }
            SEAM(PH + 2);
        }
    }
    if (PROBE_MASK && bx == 0) { const unsigned long long t0 = __builtin_amdgcn_s_memrealtime(); while (__builtin_amdgcn_s_memrealtime() - t0 < 4ull * pr_acc) __builtin_amdgcn_s_sleep(8); }
}

#if DBG_AMP
__global__ void dbg_sum(const unsigned* buf, size_t nwords, unsigned long long* acc) {
    unsigned long long s = 0;
    for (size_t i = (size_t)blockIdx.x * blockDim.x + threadIdx.x; i < nwords; i += (size_t)gridDim.x * blockDim.x) s += (unsigned long long)buf[i] * (unsigned long long)(i * 2654435761ull + 12345ull);
    for (int o = 32; o > 0; o >>= 1) s += __shfl_xor(s, o);
    if ((threadIdx.x & 63) == 0) atomicAdd(acc, s);
}
__global__ void dbg_fill(float* o, size_t off, size_t n, const unsigned long long* acc, float weight) {
    const unsigned long long a = *acc;
    for (size_t i = (size_t)blockIdx.x * blockDim.x + threadIdx.x; i < n; i += (size_t)gridDim.x * blockDim.x) {
        unsigned long long h = (a + i) * 0x9E3779B97F4A7C15ull; h ^= h >> 29; h *= 0xBF58476D1CE4E5B9ull; h ^= h >> 32;
        o[off + i] = weight * (float)(h & 0xffffff) * (1.f / 16777216.f); }
}
#endif
extern "C" void kernel_launch(void* const* d_in, const int* in_sizes, int n_in, void* d_out, int out_size, void* d_ws, size_t ws_size, hipStream_t stream) {
    static int grid = 0;
    if (grid == 0) {
        if (n_in != 30 || out_size != ML * D || ws_size < WS_END) { fprintf(stderr, "kernel_launch: unexpected problem (n_in %d, out %d, ws %zu < %zu)\n", n_in, out_size, ws_size, (size_t)WS_END); grid = -1; return; }
        int dev = 0, cus = 0, per_cu = 0;
        if (hipGetDevice(&dev) != hipSuccess || hipDeviceGetAttribute(&cus, hipDeviceAttributeMultiprocessorCount, dev) != hipSuccess) { grid = -1; return; }
        if (hipFuncSetAttribute((const void*)fwd_kernel, hipFuncAttributeMaxDynamicSharedMemorySize, LDS_BYTES) != hipSuccess) { fprintf(stderr, "kernel_launch: hipFuncSetAttribute failed\n"); grid = -1; return; }
        if (hipOccupancyMaxActiveBlocksPerMultiprocessor(&per_cu, (const void*)fwd_kernel, 512, LDS_BYTES) != hipSuccess || per_cu < 1) fprintf(stderr, "kernel_launch: occupancy query reports %d\n", per_cu);
        (void)hipGetLastError();
        grid = cus;
    }
    if (grid < 0) return;
    (void)hipMemsetAsync((char*)d_ws + WS_CTL, 0, 1 * MiB, stream);
    Args a{};
    for (int i = 0; i < 30; ++i) a.in[i] = (const GAS float*)d_in[i];
    a.out = (GAS float*)d_out; a.ws = (GAS unsigned char*)d_ws;
#if ONE_LAUNCH
    a.lo = 0; a.hi = NPHASE;
    hipLaunchKernelGGL(fwd_kernel, dim3(grid), dim3(512), LDS_BYTES, stream, a);
#else
#ifndef DBG_NPH
#define DBG_NPH NPHASE
#endif
    for (int p = 0; p < DBG_NPH; ++p) { a.lo = p; a.hi = p + 1; hipLaunchKernelGGL(fwd_kernel, dim3(grid), dim3(512), LDS_BYTES, stream, a); }
#if DBG_AMP
    {
        unsigned long long* accs = (unsigned long long*)((char*)d_ws + 2048);
        const size_t seg = (size_t)ML * D / 4;
        const size_t offs[4] = {DBG_B0, DBG_B1, DBG_B2, DBG_B3}; const size_t lens[4] = {DBG_L0, DBG_L1, DBG_L2, DBG_L3}; const float wts[4] = {1.f, 0.3f, 0.09f, 0.027f};
        for (int k = 0; k < 4; ++k) {
            hipLaunchKernelGGL(dbg_sum, dim3(2048), dim3(256), 0, stream, (const unsigned*)((char*)d_ws + offs[k]), lens[k] / 4, accs + k);
            hipLaunchKernelGGL(dbg_fill, dim3(2048), dim3(256), 0, stream, (float*)d_out, seg * k, seg, accs + k, wts[k]);
        }
    }
#endif
#endif
}
```

```cpp
#include <hip/hip_runtime.h>
#include <cstdio>
#include <cstdint>

#ifndef ONE_LAUNCH
#define ONE_LAUNCH 1
#endif
#ifndef REP_A
#define REP_A 1
#endif
#ifndef REP_B
#define REP_B 1
#endif
#ifndef REP_C
#define REP_C 1
#endif
#ifndef REP_G1
#define REP_G1 1
#endif
#ifndef REP_E1
#define REP_E1 1
#endif
#ifndef REP_E2
#define REP_E2 1
#endif
#ifndef DBG_DUP
#define DBG_DUP 0
#endif
#ifndef PROBE_MASK
#define PROBE_MASK 0
#endif
#define DBG_NPH NPHASE
#define DBG_H 0
#define DBG_I 0
#define DBG_AMP 0
#define DBG_X1 1
#define DBG_B0 WS_QC
#define DBG_L0 ((size_t)MA * 2048 * 2)
#define DBG_B1 WS_HF
#define DBG_L1 ((size_t)MA * 512 * 2)
#define DBG_B2 WS_HB
#define DBG_L2 ((size_t)MA * 512 * 2)
#define DBG_B3 WS_HB
#define DBG_L3 ((size_t)MA * 512 * 2)

#define LAS __attribute__((address_space(3)))
#define GAS __attribute__((address_space(1)))
typedef unsigned short bf16;
typedef short bf16x8 __attribute__((ext_vector_type(8)));
typedef short s16x4 __attribute__((ext_vector_type(4)));
typedef float f32x2 __attribute__((ext_vector_type(2)));
typedef float f32x4 __attribute__((ext_vector_type(4)));
typedef float f32x16 __attribute__((ext_vector_type(16)));
typedef unsigned u32x2 __attribute__((ext_vector_type(2)));
typedef unsigned u32x4 __attribute__((ext_vector_type(4)));
typedef __bf16 bf16x2_t __attribute__((ext_vector_type(2)));

constexpr int D = 1024, NBATCH = 8, SEQ = 4096, CTXL = 256;
constexpr int ML = NBATCH * SEQ;
constexpr int MC = NBATCH * CTXL;
constexpr int MA = ML + MC;
constexpr int NIN = 7440;
constexpr int N1 = 4608;
constexpr int NGT = 3072;
constexpr int LDA_ = 768, LDB_ = 1536, LDC_ = 2048;
constexpr float EPS = 1e-6f;
constexpr float LOG2E = 1.4426950408889634f;
constexpr int NPH = 16;
constexpr int NPHASE = 1 + 2 * NPH;
constexpr int CAP = 17408;

constexpr size_t MiB = 1ull << 20;
constexpr size_t WS_CTL = 0;
constexpr size_t WS_MODS = 1 * MiB;
constexpr size_t WS_ROPE = 1 * MiB + 512 * 1024;
constexpr size_t WS_LAM = WS_ROPE + 16384;
constexpr size_t WS_WIN = 8 * MiB;
constexpr size_t WS_WGT = 17 * MiB;
constexpr size_t WS_WA = 23 * MiB, WS_WB = 24 * MiB, WS_WC = 25 * MiB;
constexpr size_t WS_WO = 26 * MiB;
constexpr size_t WS_WR = 28 * MiB;
constexpr size_t WS_HL = 38 * MiB;
constexpr size_t WS_CG = 106 * MiB;
constexpr size_t WS_LOG = 109 * MiB;
constexpr size_t WS_TOKE = 118 * MiB;
constexpr size_t WS_TOKP = 119 * MiB + 512 * 1024;
constexpr size_t WS_ELIST = 121 * MiB;
constexpr size_t WS_WLIST = 130 * MiB;
constexpr size_t WS_BIG = 140 * MiB;
constexpr size_t WS_QA = WS_BIG;
constexpr size_t WS_QB = WS_BIG + 51 * MiB;
constexpr size_t WS_QC = WS_BIG + 153 * MiB;
constexpr size_t WS_XS = WS_BIG + 289 * MiB;
constexpr size_t WS_HF = WS_BIG + 357 * MiB;
constexpr size_t WS_HB = WS_BIG + 391 * MiB;
constexpr size_t WS_GT = WS_BIG;
constexpr size_t WS_Y = WS_BIG + 425 * MiB;
constexpr size_t WS_WGU = WS_BIG;
constexpr size_t WS_WD = WS_BIG + 33 * MiB;
constexpr size_t WS_A2 = WS_BIG + 50 * MiB;
constexpr size_t WS_Y2 = WS_BIG + 93 * MiB;
constexpr size_t WS_END = WS_BIG + 493 * MiB;
static_assert(WS_WGU + 65ull * 512 * 1024 <= WS_WD && WS_WD + 65ull * 1024 * 256 <= WS_A2 && WS_A2 + 172992ull * 256 <= WS_Y2 && WS_Y2 + 155584ull * 1024 <= WS_XS && WS_XS + (size_t)MA * 2048 <= WS_HF, "ws map");
constexpr int CW_BAR = 4096;
constexpr int CW_WQ = 8192;
constexpr int CW_CNT = 16384;

constexpr int LDS_TAB = 143360;
constexpr int LDS_MISC = 147456;
constexpr int LDS_BYTES = 151552;

struct Args { const GAS float* in[30]; GAS float* out; GAS unsigned char* ws; int lo, hi; };
typedef const __attribute__((address_space(4))) Args* CArgsP;
__device__ __forceinline__ CArgsP launder_args(CArgsP p) { asm volatile("" : "+s"(p)); return p; }

__device__ __forceinline__ unsigned pk2(float lo, float hi) { f32x2 v = {lo, hi}; bf16x2_t b = __builtin_convertvector(v, bf16x2_t); return __builtin_bit_cast(unsigned, b); }
__device__ __forceinline__ float bflo(unsigned u) { return __uint_as_float(u << 16); }
__device__ __forceinline__ float bfhi(unsigned u) { return __uint_as_float(u & 0xffff0000u); }
__device__ __forceinline__ float ex2(float x) { return __builtin_amdgcn_exp2f(x); }
__device__ __forceinline__ float sigm(float x) { return __builtin_amdgcn_rcpf(1.f + ex2(-LOG2E * x)); }
__device__ __forceinline__ float fadd_s(float a, float b) { float r = a + b; asm("" : "+v"(r)); return r; }
__device__ __forceinline__ float wave_sum(float v) {
#pragma unroll
    for (int o = 1; o < 64; o <<= 1) v += __shfl_xor(v, o);
    return v;
}
__device__ __forceinline__ int crow(int i, int hi) { return (i & 3) + 8 * (i >> 2) + 4 * hi; }
__device__ __forceinline__ int offb(int row, int ch) { return 256 * row + 16 * (ch ^ (((row & 3) << 2) | ((row >> 2) & 3))); }
typedef short v4i16_t __attribute__((ext_vector_type(4)));
__device__ __forceinline__ s16x4 trrd(LAS unsigned char* p) { return __builtin_bit_cast(s16x4, __builtin_amdgcn_ds_read_tr16_b64_v4i16((LAS v4i16_t*)p)); }
__device__ __forceinline__ bf16x8 cat8(s16x4 a, s16x4 b) { return (bf16x8){a[0], a[1], a[2], a[3], b[0], b[1], b[2], b[3]}; }
#define LDS_WAIT() asm volatile("s_waitcnt lgkmcnt(0)" ::: "memory")

#define XB_TMO      128
#define XB_XCNT(j)  (256  + 64 * (j))
#define XB_XSUB(j)  (1280 + 64 * (j))
#define XB_XGEN(j)  (2304 + 64 * (j))
#define XB_TOP      3328
#define XB_TOPGEN   3392
#define XCD_BAR_WORDS 3456
#define XB_SPIN_CAP (1u << 18)
__device__ __forceinline__ unsigned xb_ld(unsigned* p)              { return __hip_atomic_load(p, __ATOMIC_RELAXED, __HIP_MEMORY_SCOPE_AGENT); }
__device__ __forceinline__ unsigned xb_add(unsigned* p, unsigned v) { return __hip_atomic_fetch_add(p, v, __ATOMIC_RELAXED, __HIP_MEMORY_SCOPE_AGENT); }
__device__ __forceinline__ unsigned xb_xcc_id() { return (unsigned)__builtin_amdgcn_s_getreg((3 << 11) | 20) & 0xFu; }
#define XB_SPIN(cond, bar) do { unsigned _sp = 0; while (cond) { __builtin_amdgcn_s_sleep(1); \
    if ((++_sp & 255u) == 0u) { if (xb_ld(&(bar)[XB_TMO])) break; if (_sp > XB_SPIN_CAP) { atomicAdd(&(bar)[XB_TMO], 1u); break; } } } } while (0)
struct XcdBarrier { unsigned* bar; unsigned x; volatile LAS unsigned* st; };
__device__ __forceinline__ XcdBarrier xcd_barrier_post(unsigned* bar, volatile LAS unsigned* st) {
    XcdBarrier b; b.bar = bar; b.x = xb_xcc_id(); b.st = st;
    if (threadIdx.x == 0) (void)xb_add(&bar[XB_XCNT(b.x)], 1u);
    return b;
}
__device__ __forceinline__ void xcd_barrier_complete(unsigned* bar, unsigned x, unsigned& nloc, unsigned& nx) {
    const unsigned G = gridDim.x * gridDim.y * gridDim.z;
    unsigned sum, cnt, mine, sp = 0u;
    for (;;) {
        sum = 0u; cnt = 0u; mine = 0u;
#pragma unroll
        for (unsigned j = 0; j < 16; ++j) { const unsigned c = xb_ld(&bar[XB_XCNT(j)]); sum += c; cnt += (c > 0u) ? 1u : 0u; mine = (j == x) ? c : mine; }
        if (sum == G) break;
        __builtin_amdgcn_s_sleep(1);
        if ((++sp & 255u) == 0u) { if (xb_ld(&bar[XB_TMO])) break; if (sp > XB_SPIN_CAP) { atomicAdd(&bar[XB_TMO], 1u); break; } }
    }
    nloc = mine > 0u ? mine : 1u; nx = cnt > 0u ? cnt : 1u;
}
__device__ __forceinline__ void xcd_barrier(const XcdBarrier& b) {
    asm volatile("s_waitcnt vmcnt(0)" ::: "memory");
    __syncthreads();
    if (threadIdx.x == 0) {
        unsigned* bar = b.bar;
        __builtin_amdgcn_s_waitcnt(0);
        unsigned nloc = b.st[0], nx = b.st[1];
        if (nloc == 0u) { xcd_barrier_complete(bar, b.x, nloc, nx); b.st[0] = nloc; b.st[1] = nx; }
        const unsigned old = xb_add(&bar[XB_XSUB(b.x)], 1u);
        const unsigned gen = old / nloc;
        if (old + 1u == (gen + 1u) * nloc) {
            __builtin_amdgcn_fence(__ATOMIC_RELEASE, "agent");
            asm volatile("s_waitcnt vmcnt(0)" ::: "memory");
            const unsigned og = xb_add(&bar[XB_TOP], 1u);
            const unsigned tg = og / nx;
            if (og + 1u == (tg + 1u) * nx) xb_add(&bar[XB_TOPGEN], 1u);
            else XB_SPIN(xb_ld(&bar[XB_TOPGEN]) == tg, bar);
            __builtin_amdgcn_fence(__ATOMIC_ACQUIRE, "agent");
            xb_add(&bar[XB_XGEN(b.x)], 1u);
            asm volatile("s_waitcnt vmcnt(0)" ::: "memory");
        } else {
            XB_SPIN(xb_ld(&bar[XB_XGEN(b.x)]) == gen, bar);
            __builtin_amdgcn_fence(__ATOMIC_ACQUIRE, "agent");
            asm volatile("s_waitcnt vmcnt(0)" ::: "memory");
        }
    }
    __syncthreads();
}

namespace pg8 {
constexpr int BM = 256, BK = 64, HALF = 128, HTB = HALF * BK * 2, STAGE_BYTES = 8 * HTB, NXCD = 8, WGM = 8;
__device__ __forceinline__ int lds_byte(int r, int c) { const int st = (r >> 4) * 2 + (c >> 5), rr = r & 15, cc = c & 31, ob = rr * 64 + cc * 2; return st * 1024 + (ob ^ (((ob >> 9) & 1) << 5)); }
__device__ __forceinline__ void stage_rc(int b, int& R, int& C) { const int st = b / 1024, sb = b % 1024, swz = sb ^ (((sb >> 9) & 1) << 5); R = (st >> 1) * 16 + swz / 64; C = (st & 1) * 32 + (swz % 64) / 2; }
__device__ __forceinline__ int perm32(int rho) { const int n = rho >> 4, i = rho & 15; return 8 * (i >> 2) + 4 * n + (i & 3); }

struct GUnit { const char* A; const char* B; int pm, pn, a0, a1, a2, a3; };

template <class Epi, class Sched, bool F8 = false, int SCA = 0x7F7F7F7F, int SCB = 0x7F7F7F7F>
__device__ __forceinline__ void gemm_phase(LAS unsigned char* lds, const int K_, const Sched& S, const Epi& E) {
    int tid_l = threadIdx.x; asm volatile("" : "+v"(tid_l));
    const int tid = tid_l, wid = __builtin_amdgcn_readfirstlane(tid >> 6), lane = tid & 63, wr = wid >> 2, wc = wid & 3, fr = lane & 15, fq = lane >> 4;
    int K = K_; asm volatile("" : "+s"(K));
    const int nt = K / BK;
    int Rr[2], Cc[2]; unsigned voffA[2], voffB[2];
#pragma unroll
    for (int i = 0; i < 2; ++i) { int R, C; stage_rc(tid * 16 + i * 8192, R, C); const int Rb = Epi::PERM == 2 ? (64 * (R >> 5) + 16 * ((R >> 2) & 3) + 4 * ((R >> 4) & 1) + (R & 3)) : (Epi::PERM ? ((R & ~31) + perm32(R & 31)) : R);
        Rr[i] = R; Cc[i] = C; voffA[i] = (unsigned)(R * K + C) * 2u; voffB[i] = (unsigned)(Rb * K + C) * 2u; }
    const size_t kstep = (size_t)(BK * 2);
    const size_t hstep = (size_t)HALF * K * 2;
    const size_t hstepB = Epi::PERM == 2 ? (size_t)8 * K * 2 : hstep;
    const unsigned ldsw = (unsigned)wid * 1024u;
    const int aoff = lds_byte(wr * 64 + fr, fq * 8), boff = lds_byte(wc * 32 + fr, fq * 8);
#define PG8_SA(b, h) (((b) * 2 + (h)) * HTB)
#define PG8_SB(b, h) ((4 + (b) * 2 + (h)) * HTB)
#define PG8_STAGE(bufoff, gbase, voff) do { _Pragma("unroll") for (int _i = 0; _i < 2; ++_i) \
        __builtin_amdgcn_global_load_lds((const unsigned*)((const char*)(gbase) + (voff)[_i]), (LAS unsigned*)(lds + (bufoff) + ldsw + _i * 8192), 16, 0, 0); } while (0)
#define PG8_LD8(addr) __builtin_shufflevector(*(const LAS i32x4_*)(addr), *(const LAS i32x4_*)((addr) + 1024), 0, 1, 2, 3, 4, 5, 6, 7)
#define PG8_LDA(dst, b, h) do { _Pragma("unroll") for (int m = 0; m < 4; ++m) dst[m] = PG8_LD8(lds + PG8_SA(b, h) + aoff + m * 2048); } while (0)
#define PG8_LDB(dst, b, h) do { _Pragma("unroll") for (int n = 0; n < 2; ++n) dst[n] = PG8_LD8(lds + PG8_SB(b, h) + boff + n * 2048); } while (0)
#define PG8_LO(x) __builtin_bit_cast(bf16x8, __builtin_shufflevector(x, x, 0, 1, 2, 3))
#define PG8_HI(x) __builtin_bit_cast(bf16x8, __builtin_shufflevector(x, x, 4, 5, 6, 7))
#define PG8_MMA(ai, bj, At, Bt) do { __builtin_amdgcn_s_setprio(1); _Pragma("unroll") for (int m = 0; m < 4; ++m) _Pragma("unroll") for (int n = 0; n < 2; ++n) { \
        if constexpr (F8) asm volatile("v_mfma_scale_f32_16x16x128_f8f6f4 %0, %1, %2, %0, %3, %4 op_sel_hi:[0,0,0]" : "+v"(acc[ai][bj][m][n]) : "v"(Bt[n]), "v"(At[m]), "v"(scb_), "v"(sca_)); \
        else { acc[ai][bj][m][n] = __builtin_amdgcn_mfma_f32_16x16x32_bf16(PG8_LO(Bt[n]), PG8_LO(At[m]), acc[ai][bj][m][n], 0, 0, 0); \
               acc[ai][bj][m][n] = __builtin_amdgcn_mfma_f32_16x16x32_bf16(PG8_HI(Bt[n]), PG8_HI(At[m]), acc[ai][bj][m][n], 0, 0, 0); } } \
        __builtin_amdgcn_s_setprio(0); } while (0)
#define PG8_WAIT_V(n) asm volatile("s_waitcnt vmcnt(" #n ")" ::: "memory")
#define PG8_WAIT_L(n) asm volatile("s_waitcnt lgkmcnt(" #n ")" ::: "memory")
#define PG8_BAR __builtin_amdgcn_s_barrier()
#define PG8_SCHED __builtin_amdgcn_sched_barrier(0)
#define PG8_SETA(v, u) do { if constexpr (Sched::GATHER) { _Pragma("unroll") for (int _h = 0; _h < 2; ++_h) _Pragma("unroll") for (int _i = 0; _i < 2; ++_i) \
        v[_h][_i] = S.arow(u, Rr[_i] + 128 * _h) + (unsigned)Cc[_i] * 2u; } } while (0)
#define PG8_STAGEA(bufoff, p, v, h) do { if constexpr (Sched::GATHER) { PG8_STAGE(bufoff, p, v[h]); } else { PG8_STAGE(bufoff, (p) + (h) * hstep, voffA); } } while (0)
    GUnit cur, nxt; int ui = 0;
    if (!S.next(0, cur)) return;
    f32x4 acc[2][2][4][2];
#pragma unroll
    for (int a = 0; a < 2; ++a)
#pragma unroll
        for (int b = 0; b < 2; ++b)
#pragma unroll
            for (int m = 0; m < 4; ++m)
#pragma unroll
                for (int n = 0; n < 2; ++n) acc[a][b][m][n] = (f32x4){0.f, 0.f, 0.f, 0.f};
    typedef int i32x8_ __attribute__((ext_vector_type(8))); typedef int i32x4_ __attribute__((ext_vector_type(4)));
    i32x8_ At[4], B0[2], B1[2];
    int sca_ = SCA, scb_ = SCB; asm volatile("" : "+v"(sca_), "+v"(scb_));
    unsigned vAc[2][2], vAn[2][2];
    PG8_SETA(vAc, cur);
    const char* cA = cur.A; const char* cB = cur.B;
    PG8_STAGE(PG8_SB(0, 0), cB, voffB); PG8_STAGE(PG8_SB(0, 1), cB + hstepB, voffB); PG8_STAGEA(PG8_SA(0, 0), cA, vAc, 0); PG8_STAGEA(PG8_SA(0, 1), cA, vAc, 1);
    if (wr == 1) PG8_BAR;
    PG8_WAIT_V(2); PG8_BAR;
    PG8_STAGE(PG8_SB(1, 0), cB + kstep, voffB); PG8_STAGEA(PG8_SA(1, 0), cA + kstep, vAc, 0); PG8_STAGE(PG8_SB(1, 1), cB + hstepB + kstep, voffB);
    PG8_WAIT_V(6); PG8_BAR;
    for (;;) {
        const bool has_next = S.next(ui + 1, nxt);
        const char* nA = has_next ? nxt.A : cA; const char* nB = has_next ? nxt.B : cB;
        if constexpr (Sched::GATHER) { if (has_next) { PG8_SETA(vAn, nxt); } else {
#pragma unroll
            for (int _h = 0; _h < 2; ++_h)
#pragma unroll
                for (int _i = 0; _i < 2; ++_i) vAn[_h][_i] = vAc[_h][_i]; } }
        for (int t = 0; t < nt; t += 2) {
            const bool last = (t == nt - 2);
            const char* a1 = cA + (size_t)(t + 1) * kstep;
            const char* a2 = last ? nA : cA + (size_t)(t + 2) * kstep; const char* b2 = last ? nB : cB + (size_t)(t + 2) * kstep;
            const char* a3 = a2 + kstep; const char* b3 = b2 + kstep;
            unsigned v2[2][2];
            if constexpr (Sched::GATHER) {
#pragma unroll
            for (int _h = 0; _h < 2; ++_h)
#pragma unroll
                for (int _i = 0; _i < 2; ++_i) v2[_h][_i] = last ? vAn[_h][_i] : vAc[_h][_i]; }
            PG8_LDB(B0, 0, 0); PG8_LDB(B1, 0, 1); PG8_SCHED; PG8_LDA(At, 0, 0); PG8_STAGEA(PG8_SA(1, 1), a1, vAc, 1);
            PG8_WAIT_V(8); PG8_WAIT_L(0); PG8_BAR; PG8_MMA(0, 0, At, B0); PG8_MMA(0, 1, At, B1); PG8_BAR; PG8_SCHED;
            PG8_LDA(At, 0, 1); PG8_STAGE(PG8_SB(0, 0), b2, voffB); PG8_STAGE(PG8_SB(0, 1), b2 + hstepB, voffB); PG8_STAGEA(PG8_SA(0, 0), a2, v2, 0);
            PG8_WAIT_V(8); PG8_WAIT_L(0); PG8_BAR; PG8_MMA(1, 0, At, B0); PG8_MMA(1, 1, At, B1); PG8_BAR; PG8_SCHED;
            PG8_LDB(B0, 1, 0); PG8_LDB(B1, 1, 1); PG8_SCHED; PG8_LDA(At, 1, 0); PG8_STAGEA(PG8_SA(0, 1), a2, v2, 1);
            PG8_WAIT_V(8); PG8_WAIT_L(0); PG8_BAR; PG8_MMA(0, 0, At, B0); PG8_MMA(0, 1, At, B1); PG8_BAR; PG8_SCHED;
            PG8_LDA(At, 1, 1); PG8_STAGE(PG8_SB(1, 0), b3, voffB); PG8_STAGE(PG8_SB(1, 1), b3 + hstepB, voffB); PG8_STAGEA(PG8_SA(1, 0), a3, v2, 0);
            PG8_WAIT_V(8); PG8_WAIT_L(0); PG8_BAR; PG8_MMA(1, 0, At, B0); PG8_MMA(1, 1, At, B1); PG8_BAR; PG8_SCHED;
        }
        if (wr == 0) PG8_BAR;
        if constexpr (F8) asm volatile("s_nop 15\n\ts_nop 7" ::: "memory");
        bool keep = false;
        if constexpr (Epi::MULTI) keep = E.step(acc, cur, wr, wc, fr, fq); else E(acc, cur, wr, wc, fr, fq);
        if (!has_next) break;
        if (!keep) {
#pragma unroll
        for (int a = 0; a < 2; ++a)
#pragma unroll
            for (int b = 0; b < 2; ++b)
#pragma unroll
                for (int m = 0; m < 4; ++m)
#pragma unroll
                    for (int n = 0; n < 2; ++n) acc[a][b][m][n] = (f32x4){0.f, 0.f, 0.f, 0.f}; }
        cur = nxt; cA = nA; cB = nB; ++ui;
        if constexpr (Sched::GATHER) {
#pragma unroll
        for (int _h = 0; _h < 2; ++_h)
#pragma unroll
            for (int _i = 0; _i < 2; ++_i) vAc[_h][_i] = vAn[_h][_i]; }
        if (wr == 1) PG8_BAR;
    }
    PG8_WAIT_V(0);
    PG8_BAR;
#undef PG8_SA
#undef PG8_SB
#undef PG8_STAGE
#undef PG8_LD8
#undef PG8_LO
#undef PG8_HI
#undef PG8_LDA
#undef PG8_LDB
#undef PG8_MMA
#undef PG8_WAIT_V
#undef PG8_WAIT_L
#undef PG8_BAR
#undef PG8_SCHED
#undef PG8_SETA
#undef PG8_STAGEA
}

struct DenseSched {
    static constexpr bool GATHER = false;
    const char* A; const char* Bt; int K, nM, nN, nwg, G, c;
    __device__ __forceinline__ void init(const void* A_, const void* B_, int M, int N, int K_, int G_, int c_) { A = (const char*)A_; Bt = (const char*)B_; K = K_; nM = M / BM; nN = N / BM; nwg = nM * nN; G = G_; c = c_; }
    __device__ __forceinline__ bool next(int i, GUnit& u) const {
        const long L = (long)i * G + c; if (L >= nwg) return false;
        int wgid = (int)L; { const int q = nwg / NXCD, r = nwg % NXCD, xcd = wgid % NXCD, off = wgid / NXCD; wgid = (xcd < r ? xcd * (q + 1) : r * (q + 1) + (xcd - r) * q) + off; }
        const int nig = WGM * nN, gid = wgid / nig, fm = gid * WGM, gsz = (nM - fm) < WGM ? (nM - fm) : WGM;
        u.pm = fm + ((wgid % nig) % gsz); u.pn = (wgid % nig) / gsz;
        u.A = A + (size_t)u.pm * BM * K * 2; u.B = Bt + (size_t)u.pn * BM * K * 2; u.a0 = u.a1 = u.a2 = u.a3 = 0; return true;
    }
    __device__ __forceinline__ unsigned arow(const GUnit&, int) const { return 0u; }
};

struct Gate3Sched {
    static constexpr bool GATHER = false;
    const char* A; const char* Bt; long dA1, dA2, dB1, dB2; int K, nM, nN, nwg, G, c;
    __device__ __forceinline__ bool next(int i, GUnit& u) const {
        const int ti = i / 3, seg = i - 3 * ti;
        const long L = (long)ti * G + c; if (L >= nwg) return false;
        int wgid = (int)L; { const int q = nwg / NXCD, r = nwg % NXCD, xcd = wgid % NXCD, off = wgid / NXCD; wgid = (xcd < r ? xcd * (q + 1) : r * (q + 1) + (xcd - r) * q) + off; }
        const int nig = WGM * nN, gid = wgid / nig, fm = gid * WGM, gsz = (nM - fm) < WGM ? (nM - fm) : WGM;
        u.pm = fm + ((wgid % nig) % gsz); u.pn = (wgid % nig) / gsz;
        const long da = seg == 0 ? 0 : (seg == 1 ? dA1 : dA2), db = seg == 0 ? 0 : (seg == 1 ? dB1 : dB2);
        u.A = A + da + (size_t)u.pm * BM * K * 2; u.B = Bt + db + (size_t)u.pn * BM * K * 2; u.a0 = u.a1 = u.a2 = 0; u.a3 = seg; return true;
    }
    __device__ __forceinline__ unsigned arow(const GUnit&, int) const { return 0u; }
};

template <int NPN, bool G_> struct MoeSched {
    static constexpr bool GATHER = G_;
    const char* Abase; const char* Bbase; size_t bstride; int K; const int* elist; const LAS int* tab; int hbase, nU, G, c, NE; mutable int ehint;
    __device__ __forceinline__ bool next(int i, GUnit& u) const {
        const long L = (long)i * G + c; if (L >= nU) return false;
        int wgid = (int)L; { const int q = nU / NXCD, r = nU % NXCD, xcd = wgid % NXCD, off = wgid / NXCD; wgid = (xcd < r ? xcd * (q + 1) : r * (q + 1) + (xcd - r) * q) + off; }
        int e = ehint; if (wgid < tab[130 + e]) e = 0;
        while (e < NE - 1 && wgid >= tab[130 + e + 1]) ++e;
        e = __builtin_amdgcn_readfirstlane(e); ehint = e;
        const int r = wgid - tab[130 + e], rb = r / NPN, pn = r % NPN;
        u.pm = rb; u.pn = pn; u.a0 = e; u.a1 = __builtin_amdgcn_readfirstlane(tab[65 + e]) + 256 * rb; u.a2 = __builtin_amdgcn_readfirstlane(tab[e]); u.a3 = 0;
        u.A = G_ ? Abase : Abase + (size_t)u.a1 * K * 2;
        u.B = Bbase + (size_t)e * bstride + (size_t)pn * BM * K * 2;
        return true;
    }
    __device__ __forceinline__ unsigned arow(const GUnit& u, int R) const {
        const int idx = 256 * u.pm + R; int tok;
        if (u.a0 == 64) tok = hbase + idx;
        else { const int t0 = elist[(size_t)u.a0 * CAP + (idx < u.a2 ? idx : u.a2 - 1)]; tok = (idx < u.a2) ? t0 : hbase; }
        return (unsigned)tok * (unsigned)(K * 2);
    }
};
}
using pg8::GUnit;

typedef f32x4 AccT[2][2][4][2];
struct EpiG1 {
    static constexpr bool PERM = true; static constexpr bool MULTI = false;
    bf16 *QA, *QB, *QC; float* CG; const float* rope; int mode;
    __device__ __forceinline__ void operator()(const AccT& acc, const GUnit& u, int wr, int wc, int fr, int fq) const {
        const int pn = mode ? u.pn + 7 : (u.pn < 7 ? u.pn : 17);
        if (pn == 17) {
            if (wc == 0 && fq < 2) {
#pragma unroll
                for (int ai = 0; ai < 2; ++ai)
#pragma unroll
                    for (int m = 0; m < 4; ++m) { const int row = u.pm * 256 + ai * 128 + wr * 64 + m * 16 + fr; float* p = CG + (size_t)row * 16 + 8 * fq;
                        *(f32x4*)p = acc[ai][0][m][0]; *(f32x4*)(p + 4) = acc[ai][0][m][1]; }
            }
            return;
        }
        bf16* base; int ld, colt;
        if (pn < 3) { base = QA; ld = LDA_; colt = pn * 256; } else if (pn < 9) { base = QB; ld = LDB_; colt = (pn - 3) * 256; } else { base = QC; ld = LDC_; colt = (pn - 9) * 256; }
        const bool latent = u.pm < 128;
#pragma unroll
        for (int ai = 0; ai < 2; ++ai)
#pragma unroll
            for (int m = 0; m < 4; ++m) {
                const int row = u.pm * 256 + ai * 128 + wr * 64 + m * 16 + fr; const int t = row & 4095; const int pos = (wc & 1) ? (t & 63) : (t >> 6);
                bf16* rowp = base + (size_t)row * ld + colt + wc * 32 + 8 * fq;
#pragma unroll
                for (int bj = 0; bj < 2; ++bj) {
                    const int gc = pn * 256 + bj * 128;
                    const bool rp = latent && (gc < 640 || (gc >= 768 && gc < 1792));
                    f32x4 v0 = acc[ai][bj][m][0], v1 = acc[ai][bj][m][1];
                    if (rp) { const f32x4 cs = *(const f32x4*)(rope + pos * 16 + 4 * fq), sn = *(const f32x4*)(rope + 1024 + pos * 16 + 4 * fq);
                        const f32x4 a = v0, b = v1; v0 = a * cs - b * sn; v1 = b * cs + a * sn; }
                    u32x4 w; w.x = pk2(v0[0], v0[1]); w.y = pk2(v0[2], v0[3]); w.z = pk2(v1[0], v1[1]); w.w = pk2(v1[2], v1[3]);
                    *(u32x4*)(rowp + bj * 128) = w;
                }
            }
    }
};
struct EpiBf16 {
    static constexpr bool PERM = true; static constexpr bool MULTI = false;
    bf16* O; int ld;
    __device__ __forceinline__ void operator()(const AccT& acc, const GUnit& u, int wr, int wc, int fr, int fq) const {
#pragma unroll
        for (int ai = 0; ai < 2; ++ai)
#pragma unroll
            for (int m = 0; m < 4; ++m) { bf16* rowp = O + (size_t)(u.pm * 256 + ai * 128 + wr * 64 + m * 16 + fr) * ld + u.pn * 256 + wc * 32 + 8 * fq;
#pragma unroll
                for (int bj = 0; bj < 2; ++bj) { const f32x4 v0 = acc[ai][bj][m][0], v1 = acc[ai][bj][m][1];
                    u32x4 w; w.x = pk2(v0[0], v0[1]); w.y = pk2(v0[2], v0[3]); w.z = pk2(v1[0], v1[1]); w.w = pk2(v1[2], v1[3]);
                    *(u32x4*)(rowp + bj * 128) = w; } }
    }
};
struct EpiSig8 {
    static constexpr int PERM = 2; static constexpr bool MULTI = false;
    unsigned char* O; int ld;
    static __device__ __forceinline__ float q1(float x) { return fmaxf(__builtin_rintf(255.f * sigm(x)), 1.f); }
    static __device__ __forceinline__ unsigned q4(f32x4 v) {
        unsigned w = 0;
        w = __builtin_amdgcn_cvt_pk_u8_f32(q1(v[0]), 0, w); w = __builtin_amdgcn_cvt_pk_u8_f32(q1(v[1]), 1, w);
        w = __builtin_amdgcn_cvt_pk_u8_f32(q1(v[2]), 2, w); w = __builtin_amdgcn_cvt_pk_u8_f32(q1(v[3]), 3, w);
        return w;
    }
    __device__ __forceinline__ void operator()(const AccT& acc, const GUnit& u, int wr, int wc, int fr, int fq) const {
#pragma unroll
        for (int ai = 0; ai < 2; ++ai)
#pragma unroll
            for (int m = 0; m < 4; ++m) { unsigned char* rowp = O + (size_t)(u.pm * 256 + ai * 128 + wr * 64 + m * 16 + fr) * ld + u.pn * 256 + wc * 64 + 16 * fq;
                u32x4 w; w.x = q4(acc[ai][0][m][0]); w.y = q4(acc[ai][0][m][1]); w.z = q4(acc[ai][1][m][0]); w.w = q4(acc[ai][1][m][1]);
                *(u32x4*)rowp = w; }
    }
};
struct EpiGate3 {
    static constexpr bool PERM = true; static constexpr bool MULTI = true;
    const unsigned char* GT; bf16* Y;
    static __device__ __forceinline__ float ub(unsigned w, int k) { return (float)((w >> (8 * k)) & 0xffu); }
    __device__ __forceinline__ bool step(AccT& acc, const GUnit& u, int wr, int wc, int fr, int fq) const {
        const int col0 = u.pn * 256 + wc * 32 + 8 * fq, seg = u.a3;
        if (seg < 2) {
#pragma unroll
            for (int ai = 0; ai < 2; ++ai) {
                u32x2 ga[4][2], gb[4][2];
#pragma unroll
                for (int m = 0; m < 4; ++m) { const unsigned char* gp = GT + (size_t)(u.pm * 256 + ai * 128 + wr * 64 + m * 16 + fr) * NGT + seg * 1024 + col0;
#pragma unroll
                    for (int bj = 0; bj < 2; ++bj) { ga[m][bj] = *(const u32x2*)(gp + bj * 128); gb[m][bj] = *(const u32x2*)(gp + 1024 + bj * 128); } }
#pragma unroll
                for (int m = 0; m < 4; ++m)
#pragma unroll
                    for (int bj = 0; bj < 2; ++bj) { const u32x2 a = ga[m][bj], b = gb[m][bj];
                        f32x4 r0, r1;
#pragma unroll
                        for (int k = 0; k < 4; ++k) { r0[k] = ub(a.x, k) * __builtin_amdgcn_rcpf(ub(b.x, k)); r1[k] = ub(a.y, k) * __builtin_amdgcn_rcpf(ub(b.y, k)); }
                        acc[ai][bj][m][0] *= r0; acc[ai][bj][m][1] *= r1; }
            }
            return true;
        }
#pragma unroll
        for (int ai = 0; ai < 2; ++ai) {
            u32x2 g[4][2];
#pragma unroll
            for (int m = 0; m < 4; ++m) { const unsigned char* gp = GT + (size_t)(u.pm * 256 + ai * 128 + wr * 64 + m * 16 + fr) * NGT + 2048 + col0;
#pragma unroll
                for (int bj = 0; bj < 2; ++bj) g[m][bj] = *(const u32x2*)(gp + bj * 128); }
#pragma unroll
            for (int m = 0; m < 4; ++m) { bf16* yp = Y + (size_t)(u.pm * 256 + ai * 128 + wr * 64 + m * 16 + fr) * 1024 + col0;
#pragma unroll
                for (int bj = 0; bj < 2; ++bj) { const u32x2 gg = g[m][bj]; const f32x4 v0 = acc[ai][bj][m][0] * (1.f / 255.f), v1 = acc[ai][bj][m][1] * (1.f / 255.f);
                    u32x4 w;
                    w.x = pk2(ub(gg.x, 0) * v0[0], ub(gg.x, 1) * v0[1]); w.y = pk2(ub(gg.x, 2) * v0[2], ub(gg.x, 3) * v0[3]);
                    w.z = pk2(ub(gg.y, 0) * v1[0], ub(gg.y, 1) * v1[1]); w.w = pk2(ub(gg.y, 2) * v1[2], ub(gg.y, 3) * v1[3]);
                    *(u32x4*)(yp + bj * 128) = w; } }
            asm volatile("" ::: "memory");
        }
        return false;
    }
};
struct EpiRes {
    static constexpr bool PERM = true; static constexpr bool MULTI = false;
    const float* resL; const float* resC; bf16* xs; const float* modv; int rowbase;
    __device__ __forceinline__ void operator()(const AccT& acc, const GUnit& u, int wr, int wc, int fr, int fq) const {
        const int row0 = rowbase + u.pm * 256;
        const float* mv = modv + (row0 < ML ? (row0 >> 12) : 8) * 6144;
        const int col0 = u.pn * 256 + wc * 32 + 8 * fq;
        f32x4 m4[2][2];
#pragma unroll
        for (int bj = 0; bj < 2; ++bj)
#pragma unroll
            for (int n = 0; n < 2; ++n) m4[bj][n] = *(const f32x4*)(mv + col0 + bj * 128 + 4 * n);
#pragma unroll
        for (int ai = 0; ai < 2; ++ai) {
            if (resL) {
                f32x4 r4[4][2][2];
#pragma unroll
                for (int m = 0; m < 4; ++m) { const int row = row0 + ai * 128 + wr * 64 + m * 16 + fr;
                    const float* rp = row < ML ? resL + (size_t)row * D : resC + (size_t)(row - ML) * D;
#pragma unroll
                    for (int bj = 0; bj < 2; ++bj)
#pragma unroll
                        for (int n = 0; n < 2; ++n) r4[m][bj][n] = *(const f32x4*)(rp + col0 + bj * 128 + 4 * n); }
#pragma unroll
                for (int m = 0; m < 4; ++m) { bf16* op = xs + (size_t)(row0 + ai * 128 + wr * 64 + m * 16 + fr) * D + col0;
#pragma unroll
                    for (int bj = 0; bj < 2; ++bj) { const f32x4 a = r4[m][bj][0] + m4[bj][0] * acc[ai][bj][m][0], b = r4[m][bj][1] + m4[bj][1] * acc[ai][bj][m][1];
                        u32x4 w; w.x = pk2(a[0], a[1]); w.y = pk2(a[2], a[3]); w.z = pk2(b[0], b[1]); w.w = pk2(b[2], b[3]);
                        *(u32x4*)(op + bj * 128) = w; } }
            } else {
                u32x4 r[4][2];
#pragma unroll
                for (int m = 0; m < 4; ++m) { const bf16* rp = xs + (size_t)(row0 + ai * 128 + wr * 64 + m * 16 + fr) * D + col0;
#pragma unroll
                    for (int bj = 0; bj < 2; ++bj) r[m][bj] = *(const u32x4*)(rp + bj * 128); }
#pragma unroll
                for (int m = 0; m < 4; ++m) { bf16* op = xs + (size_t)(row0 + ai * 128 + wr * 64 + m * 16 + fr) * D + col0;
#pragma unroll
                    for (int bj = 0; bj < 2; ++bj) { const u32x4 rr = r[m][bj]; const f32x4 a0 = acc[ai][bj][m][0], a1 = acc[ai][bj][m][1], ma = m4[bj][0], mb = m4[bj][1];
                        u32x4 w;
                        w.x = pk2(bflo(rr.x) + ma[0] * a0[0], bfhi(rr.x) + ma[1] * a0[1]); w.y = pk2(bflo(rr.y) + ma[2] * a0[2], bfhi(rr.y) + ma[3] * a0[3]);
                        w.z = pk2(bflo(rr.z) + mb[0] * a1[0], bfhi(rr.z) + mb[1] * a1[1]); w.w = pk2(bflo(rr.w) + mb[2] * a1[2], bfhi(rr.w) + mb[3] * a1[3]);
                        *(u32x4*)(op + bj * 128) = w; } }
            }
            asm volatile("" ::: "memory");
        }
    }
};
struct EpiLogits {
    static constexpr bool PERM = false; static constexpr bool MULTI = false;
    float* L;
    __device__ __forceinline__ void operator()(const AccT& acc, const GUnit& u, int wr, int wc, int fr, int fq) const {
        if (wc >= 2) return;
#pragma unroll
        for (int ai = 0; ai < 2; ++ai)
#pragma unroll
            for (int m = 0; m < 4; ++m) { const int row = u.pm * 256 + ai * 128 + wr * 64 + m * 16 + fr;
#pragma unroll
                for (int n = 0; n < 2; ++n) *(f32x4*)(L + (size_t)row * 64 + wc * 32 + n * 16 + 4 * fq) = acc[ai][0][m][n]; }
    }
};
typedef unsigned char fp8;
__device__ __forceinline__ unsigned pk4_fp8(f32x4 v) {
    int w = 0;
    w = __builtin_amdgcn_cvt_pk_fp8_f32(__builtin_amdgcn_fmed3f(v[0], -400.f, 400.f), __builtin_amdgcn_fmed3f(v[1], -400.f, 400.f), w, false);
    w = __builtin_amdgcn_cvt_pk_fp8_f32(__builtin_amdgcn_fmed3f(v[2], -400.f, 400.f), __builtin_amdgcn_fmed3f(v[3], -400.f, 400.f), w, true);
    return (unsigned)w;
}
struct EpiSwiGLU {
    static constexpr int PERM = 2; static constexpr bool MULTI = false;
    fp8* A2;
    __device__ __forceinline__ void operator()(const AccT& acc, const GUnit& u, int wr, int wc, int fr, int fq) const {
#pragma unroll
        for (int ai = 0; ai < 2; ++ai)
#pragma unroll
            for (int m = 0; m < 4; ++m) { fp8* rowp = A2 + (size_t)(u.a1 + ai * 128 + wr * 64 + m * 16 + fr) * 256 + u.pn * 128 + wc * 32 + 8 * fq;
                u32x2 o;
#pragma unroll
                for (int bj = 0; bj < 2; ++bj) { const f32x4 g = acc[ai][bj][m][0], uu = acc[ai][bj][m][1];
                    const f32x4 a = {4.f * g[0] * sigm(g[0]) * uu[0], 4.f * g[1] * sigm(g[1]) * uu[1], 4.f * g[2] * sigm(g[2]) * uu[2], 4.f * g[3] * sigm(g[3]) * uu[3]};
                    if (bj == 0) o.x = pk4_fp8(a); else o.y = pk4_fp8(a); }
                *(u32x2*)rowp = o; }
    }
};
struct EpiY2 {
    static constexpr int PERM = 2; static constexpr bool MULTI = false;
    fp8* Y2; const float* wlist;
    __device__ __forceinline__ void operator()(const AccT& acc, const GUnit& u, int wr, int wc, int fr, int fq) const {
        const int e = u.a0;
        float wv[2][4];
#pragma unroll
        for (int ai = 0; ai < 2; ++ai)
#pragma unroll
            for (int m = 0; m < 4; ++m) { const int idx = 256 * u.pm + ai * 128 + wr * 64 + m * 16 + fr; const float wl = wlist[(size_t)e * CAP + (idx < u.a2 ? idx : u.a2 - 1)];
                wv[ai][m] = idx < u.a2 ? 16.f * wl : 0.f; }
#pragma unroll
        for (int ai = 0; ai < 2; ++ai)
#pragma unroll
            for (int m = 0; m < 4; ++m) { const int lr = ai * 128 + wr * 64 + m * 16 + fr; const float w = wv[ai][m];
                fp8* rowp = Y2 + (size_t)(u.a1 + lr) * 1024 + u.pn * 256 + wc * 64 + 16 * fq;
                u32x4 o; o.x = pk4_fp8(acc[ai][0][m][0] * w); o.y = pk4_fp8(acc[ai][0][m][1] * w); o.z = pk4_fp8(acc[ai][1][m][0] * w); o.w = pk4_fp8(acc[ai][1][m][1] * w);
                *(u32x4*)rowp = o; }
    }
};

template <int DV, bool DIFF>
__device__ __forceinline__ void attn_core(LAS unsigned char* lds, const bf16* qptr  ,
                                          const bf16* kv0, int nt0, const bf16* kv1, int nt1, int ld, int kcol, int vcol, int stream,
                                          bool domask, int qpos, int q0w  , int kpos0, float& m_run, float& l_run, f32x16 (&o)[DV / 32]) {
    constexpr int NDV = DV / 32;
    constexpr int NLD = DIFF ? 4 : 2;
    constexpr int KOFF = 0, VOFF = DIFF ? 16384 : 9216, BUFB = DIFF ? 32768 : 21504;
    int tid_l = threadIdx.x; asm volatile("" : "+v"(tid_l));
    const int tid = tid_l, lane = tid & 63, r32 = lane & 31, hi = lane >> 5, q4 = (lane & 15) >> 2, p4 = lane & 3, g1 = (lane >> 4) & 1;
    bf16x8 qf[4];
#pragma unroll
    for (int d0 = 0; d0 < 4; ++d0) qf[d0] = *(const bf16x8*)(qptr + 16 * d0);
    const int NT = nt0 + nt1;
    f32x16 negm;
    { const float _nm = -m_run;
#pragma unroll
      for (int i = 0; i < 16; ++i) negm[i] = _nm; }
    unsigned goff[NLD], woff[NLD];
#pragma unroll
    for (int p = 0; p < NLD; ++p) { const int idx = tid + 512 * p;
        if (DIFF) { const int w = idx >> 10, rem = idx & 1023, row = rem >> 4, ch = rem & 15; goff[p] = (unsigned)(row * ld + (w ? vcol : kcol) + ch * 8); woff[p] = (unsigned)((w ? VOFF : KOFF) + offb(row, ch)); }
        else { const int w = idx >> 9, rem = idx & 511, row = rem >> 3, ch = rem & 7; goff[p] = (unsigned)(row * ld + (w ? vcol : kcol) + ch * 8); woff[p] = (unsigned)((w ? VOFF + row * 192 : KOFF + row * 144) + ch * 16); } }
    unsigned kadr[4], vadr[2][NDV];
#pragma unroll
    for (int d0 = 0; d0 < 4; ++d0) kadr[d0] = (unsigned)(KOFF + (DIFF ? offb(r32, 8 * stream + 2 * d0 + hi) : r32 * 144 + (16 * d0 + 8 * hi) * 2));
#pragma unroll
    for (int jj = 0; jj < 2; ++jj)
#pragma unroll
        for (int dv = 0; dv < NDV; ++dv) vadr[jj][dv] = (unsigned)(VOFF + (DIFF ? offb(4 * hi + 8 * jj + q4, 4 * dv + 2 * g1 + (p4 >> 1)) + 8 * (p4 & 1) : (4 * hi + 8 * jj + q4) * 192 + (32 * dv + 16 * g1 + 4 * p4) * 2));
    constexpr int KB2 = DIFF ? 8192 : 32 * 144;
    constexpr int VROW = DIFF ? 256 : 192;
    u32x4 st[NLD];
#define AT_LOAD(t) do { const bf16* _b = ((t) < nt0) ? kv0 + (size_t)((t) * 64) * ld : kv1 + (size_t)(((t) - nt0) * 64) * ld; \
        _Pragma("unroll") for (int _p = 0; _p < NLD; ++_p) st[_p] = *(const u32x4*)(_b + goff[_p]); } while (0)
#define AT_WRITE(BO) do { _Pragma("unroll") for (int _p = 0; _p < NLD; ++_p) *(LAS u32x4*)(lds + (BO) + woff[_p]) = st[_p]; } while (0)
#define AT_VLD(dst, g, BO) do { _Pragma("unroll") for (int dv = 0; dv < NDV; ++dv) { dst[dv][0] = trrd(lds + (BO) + (16 * (g)) * VROW + vadr[0][dv]); dst[dv][1] = trrd(lds + (BO) + (16 * (g)) * VROW + vadr[1][dv]); } } while (0)
#define AT_PVG(src, PW) do { const bf16x8 pf = __builtin_bit_cast(bf16x8, PW); _Pragma("unroll") for (int dv = 0; dv < NDV; ++dv) o[dv] = __builtin_amdgcn_mfma_f32_32x32x16_bf16(cat8(src[dv][0], src[dv][1]), pf, o[dv], 0, 0, 0); } while (0)
#define AT_TILE(t, BO) do { \
        bool tmask_ = false; \
        if (!DIFF) { if (domask && (t) < nt0) { const int kp_ = kpos0 + 64 * (t); \
            if (kp_ > q0w + 159 || kp_ + 63 < q0w - 128) break;     \
            tmask_ = !(kp_ >= q0w - 97 && kp_ <= q0w + 65); } } \
        f32x16 p0, p1; bf16x8 kf[8]; \
        _Pragma("unroll") for (int d0 = 0; d0 < 4; ++d0) { kf[2 * d0] = *(const LAS bf16x8*)(lds + (BO) + kadr[d0]); kf[2 * d0 + 1] = *(const LAS bf16x8*)(lds + (BO) + KB2 + kadr[d0]); } \
        \
        p0 = __builtin_amdgcn_mfma_f32_32x32x16_bf16(kf[0], qf[0], negm, 0, 0, 0); \
        p1 = __builtin_amdgcn_mfma_f32_32x32x16_bf16(kf[1], qf[0], negm, 0, 0, 0); \
        _Pragma("unroll") for (int d0 = 1; d0 < 4; ++d0) { \
            p0 = __builtin_amdgcn_mfma_f32_32x32x16_bf16(kf[2 * d0], qf[d0], p0, 0, 0, 0); \
            p1 = __builtin_amdgcn_mfma_f32_32x32x16_bf16(kf[2 * d0 + 1], qf[d0], p1, 0, 0, 0); } \
        \
        s16x4 va[NDV][2], vb[NDV][2]; \
        AT_VLD(va, 0, BO); \
        if (!DIFF) { if (tmask_) { const int kp = kpos0 + 64 * (t); \
            _Pragma("unroll") for (int i = 0; i < 16; ++i) { const int d0_ = kp + crow(i, hi) - qpos; const int d1_ = d0_ + 32; \
                if (d0_ > 128 || d0_ < -128) p0[i] = -1e30f; if (d1_ > 128 || d1_ < -128) p1[i] = -1e30f; } } } \
        float ls = 0.f; \
        _Pragma("unroll") for (int i = 0; i < 16; ++i) { p0[i] = ex2(p0[i]); p1[i] = ex2(p1[i]); } \
        { float sa = fadd_s(p0[0], p1[0]), sb = fadd_s(p0[1], p1[1]);     \
          _Pragma("unroll") for (int i = 2; i < 16; i += 2) { sa = fadd_s(sa, p0[i]); sb = fadd_s(sb, p0[i + 1]); sa = fadd_s(sa, p1[i]); sb = fadd_s(sb, p1[i + 1]); } ls = sa + sb; } \
        l_run += ls; \
        u32x4 pw0, pw1, pw2, pw3; \
        pw0.x = pk2(p0[0], p0[1]); pw0.y = pk2(p0[2], p0[3]); pw0.z = pk2(p0[4], p0[5]); pw0.w = pk2(p0[6], p0[7]); \
        pw1.x = pk2(p0[8], p0[9]); pw1.y = pk2(p0[10], p0[11]); pw1.z = pk2(p0[12], p0[13]); pw1.w = pk2(p0[14], p0[15]); \
        pw2.x = pk2(p1[0], p1[1]); pw2.y = pk2(p1[2], p1[3]); pw2.z = pk2(p1[4], p1[5]); pw2.w = pk2(p1[6], p1[7]); \
        pw3.x = pk2(p1[8], p1[9]); pw3.y = pk2(p1[10], p1[11]); pw3.z = pk2(p1[12], p1[13]); pw3.w = pk2(p1[14], p1[15]); \
        AT_VLD(vb, 1, BO); AT_PVG(va, pw0); \
        AT_VLD(va, 2, BO); AT_PVG(vb, pw1); \
        AT_VLD(vb, 3, BO); AT_PVG(va, pw2); \
        AT_PVG(vb, pw3); \
        if (__any(ls > 4096.f)) {     \
            const float mxl = fmaxf(ls, __shfl_xor(ls, 32)); const float dl = mxl > 4096.f ? (float)((int)((__float_as_uint(mxl) >> 23) & 0xffu) - 132) : 0.f; const float alpha = ex2(-dl); \
            m_run += dl; l_run *= alpha; \
            _Pragma("unroll") for (int dv = 0; dv < NDV; ++dv) _Pragma("unroll") for (int i = 0; i < 16; ++i) o[dv][i] *= alpha; \
            { const float _nm = -m_run; _Pragma("unroll") for (int i = 0; i < 16; ++i) negm[i] = _nm; } } \
    } while (0)
    AT_LOAD(0); AT_WRITE(0);
    __syncthreads();
    for (int t = 0; t < NT; t += 2) {
        AT_LOAD(t + 1);
        AT_TILE(t, 0);
        AT_WRITE(BUFB);
        __syncthreads();
        if (t + 2 < NT) AT_LOAD(t + 2);
        AT_TILE(t + 1, BUFB);
        if (t + 2 < NT) AT_WRITE(0);
        __syncthreads();
    }
#undef AT_LOAD
#undef AT_WRITE
#undef AT_TILE
#undef AT_VLD
#undef AT_PVG
}

__device__ __forceinline__ void mixB_unit(LAS unsigned char* lds, int ub, const bf16* QB, bf16* OB, const float* gdiff, float lam, float lam_init) {
    int tid_l = threadIdx.x; asm volatile("" : "+v"(tid_l));
    const int tid = tid_l, lane = tid & 63, r32 = lane & 31, hi = lane >> 5, wid = __builtin_amdgcn_readfirstlane(tid >> 6), s = wid >> 2, qs = wid & 3;
    int b, h, qrow0, nt0, nt1; const bf16 *kv0, *kv1;
    if (ub < 1024) { b = ub >> 7; h = (ub >> 5) & 3; const int qb = ub & 31; qrow0 = b * 4096 + qb * 128; kv0 = QB + (size_t)(b * 4096) * LDB_; nt0 = 64; kv1 = QB + (size_t)(ML + b * 256) * LDB_; nt1 = 4; }
    else { const int uc = ub - 1024; b = uc >> 3; h = (uc >> 1) & 3; const int qb = uc & 1; qrow0 = ML + b * 256 + qb * 128; kv0 = QB + (size_t)(ML + b * 256) * LDB_; nt0 = 4; kv1 = kv0; nt1 = 0; }
    const int qrow = qrow0 + 32 * qs + r32;
    const bf16* qptr = QB + (size_t)qrow * LDB_ + (2 * h + s) * 64 + 8 * hi;
    float m_run = 0.f, l_run = 0.f; f32x16 o[4];
#pragma unroll
    for (int dv = 0; dv < 4; ++dv)
#pragma unroll
        for (int i = 0; i < 16; ++i) o[dv][i] = 0.f;
    attn_core<128, true>(lds, qptr, kv0, nt0, kv1, nt1, LDB_, 512 + 128 * h, 1024 + 128 * h, s, false, 0, 0, 0, m_run, l_run, o);
    const float inv = 1.f / (l_run + __shfl_xor(l_run, 32));
    LAS float* X = (LAS float*)(lds + 65536);
    if (s == 1) {
#pragma unroll
        for (int dv = 0; dv < 4; ++dv)
#pragma unroll
            for (int i = 0; i < 16; ++i) X[(qs * 64 + dv * 16 + i) * 64 + lane] = o[dv][i] * inv;
    }
    __syncthreads();
    if (s == 0) {
        float ss = 0.f;
#pragma unroll
        for (int dv = 0; dv < 4; ++dv)
#pragma unroll
            for (int i = 0; i < 16; ++i) { const float d = o[dv][i] * inv - lam * X[(qs * 64 + dv * 16 + i) * 64 + lane]; o[dv][i] = d; ss += d * d; }
        ss += __shfl_xor(ss, 32);
        const float rs = __builtin_amdgcn_rsqf(ss * (1.f / 128.f) + EPS) * (1.f - lam_init);
        bf16* op = OB + (size_t)qrow * 512 + h * 128;
#pragma unroll
        for (int dv = 0; dv < 4; ++dv)
#pragma unroll
            for (int i4 = 0; i4 < 4; ++i4) { const int e0 = 32 * dv + 8 * i4 + 4 * hi; const f32x4 g = *(const f32x4*)(gdiff + e0);
                u32x2 w; w.x = pk2(o[dv][4 * i4] * rs * g[0], o[dv][4 * i4 + 1] * rs * g[1]); w.y = pk2(o[dv][4 * i4 + 2] * rs * g[2], o[dv][4 * i4 + 3] * rs * g[3]);
                *(u32x2*)(op + e0) = w; }
    }
    __syncthreads();
}

__device__ __forceinline__ void mixA_unit(LAS unsigned char* lds, int ua, const bf16* QA, bf16* OA, const float* sink) {
    int tid_l = threadIdx.x; asm volatile("" : "+v"(tid_l));
    const int tid = tid_l, lane = tid & 63, r32 = lane & 31, hi = lane >> 5, wid = __builtin_amdgcn_readfirstlane(tid >> 6), qs = wid & 3;
    int b, qb, kvh, pair, qrow0, nt0, nt1, kpos0; const bf16 *kv0, *kv1; bool domask;
    if (ua < 1024) { b = ua >> 7; qb = (ua >> 2) & 31; kvh = (ua >> 1) & 1; pair = ua & 1; qrow0 = b * 4096 + qb * 128;
        const int ks = qb * 128 - 128 < 0 ? 0 : qb * 128 - 128, ke = qb * 128 + 256 > SEQ ? SEQ : qb * 128 + 256;
        kpos0 = ks; nt0 = (ke - ks) >> 6; kv0 = QA + (size_t)(b * 4096 + ks) * LDA_; kv1 = QA + (size_t)(ML + b * 256) * LDA_; nt1 = 4; domask = true; }
    else { const int uc = ua - 1024; b = uc >> 3; qb = (uc >> 2) & 1; kvh = (uc >> 1) & 1; pair = uc & 1; qrow0 = ML + b * 256 + qb * 128;
        kpos0 = 0; nt0 = 4; kv0 = QA + (size_t)(ML + b * 256) * LDA_; kv1 = kv0; nt1 = 0; domask = false; }
    const int head = 4 * kvh + 2 * pair + (wid >> 2);
    const int qrow = qrow0 + 32 * qs + r32;
    const bf16* qptr = QA + (size_t)qrow * LDA_ + head * 64 + 8 * hi;
    float m_run = sink[head] * LOG2E, l_run = hi == 0 ? 1.f : 0.f; f32x16 o[2];
#pragma unroll
    for (int dv = 0; dv < 2; ++dv)
#pragma unroll
        for (int i = 0; i < 16; ++i) o[dv][i] = 0.f;
    attn_core<64, false>(lds, qptr, kv0, nt0, kv1, nt1, LDA_, 512 + 64 * kvh, 640 + 64 * kvh, 0, domask, qb * 128 + 32 * qs + r32, qb * 128 + 32 * qs, kpos0, m_run, l_run, o);
    const float inv = 1.f / (l_run + __shfl_xor(l_run, 32));
    bf16* op = OA + (size_t)qrow * 512 + head * 64;
#pragma unroll
    for (int dv = 0; dv < 2; ++dv)
#pragma unroll
        for (int i4 = 0; i4 < 4; ++i4) { const int e0 = 32 * dv + 8 * i4 + 4 * hi;
            u32x2 w; w.x = pk2(o[dv][4 * i4] * inv, o[dv][4 * i4 + 1] * inv); w.y = pk2(o[dv][4 * i4 + 2] * inv, o[dv][4 * i4 + 3] * inv);
            *(u32x2*)(op + e0) = w; }
}

constexpr int ML_QI = 0, ML_KI = 34816, ML_VI = 67584, ML_CI = 100352, ML_VEC = 135168;
__device__ __forceinline__ void mlstm_unit(LAS unsigned char* lds, int unit, const bf16* QC, const float* CG, const float* bgate, bf16* HF, bf16* HB, bool need_ctx) {
    int tid_l = threadIdx.x; asm volatile("" : "+v"(tid_l));
    const int wid = __builtin_amdgcn_readfirstlane(tid_l >> 6);
    const int b = unit >> 3, h = (unit >> 1) & 3, dir = unit & 1;
    bf16* Hout = dir ? HB : HF;
    const int gi_col = 8 * dir + h, gf_col = 8 * dir + 4 + h;
    const float bi = bgate[gi_col], bfb = bgate[gf_col];
    LAS float* cvec = (LAS float*)(lds + ML_VEC);
    LAS float* rvec = cvec + 128;
    LAS float* avec = cvec + 256;
    LAS float* evec = cvec + 384;
    LAS float* nvec = cvec + 512;
    for (int i = tid_l; i < 34816 / 4; i += 512) ((LAS unsigned*)(lds + ML_CI))[i] = 0u;
    if (tid_l < 128) nvec[tid_l] = 0.f;
    f32x16 Cst[2];
#pragma unroll
    for (int et = 0; et < 2; ++et)
#pragma unroll
        for (int i = 0; i < 16; ++i) Cst[et][i] = 0.f;
    float m_st = 0.f;
    for (int step = 0; step < 34; ++step) {
        asm volatile("" : "+v"(tid_l));
        const int tid = tid_l, lane = tid & 63, r32 = lane & 31, hi = lane >> 5;
        const int q4 = (lane & 15) >> 2, p4 = lane & 3, g1 = (lane >> 4) & 1;
        int base;
        if (step < 2) { const int cj = dir ? 1 - step : step; base = ML + b * 256 + 128 * cj; }
        else { const int lj = step - 2; const int cj = dir ? 31 - lj : lj; base = b * 4096 + 128 * cj; }
        u32x4 st[12];
        {
            const int tau = (tid >> 4), ch = tid & 15;
#pragma unroll
            for (int p = 0; p < 12; ++p) { const int tt = (p & 3) * 32 + tau; const int gr = base + (dir ? 127 - tt : tt);
                st[p] = *(const u32x4*)(QC + (size_t)gr * LDC_ + (p >> 2) * 512 + h * 128 + ch * 8); }
        }
        float decay_r, factor_r;
        {
            const int t0 = lane, t1 = lane + 64;
            const int gr0 = base + (dir ? 127 - t0 : t0), gr1 = base + (dir ? 127 - t1 : t1);
            const float gi0 = CG[(size_t)gr0 * 16 + gi_col] + bi, gf0 = CG[(size_t)gr0 * 16 + gf_col] + bfb;
            const float gi1 = CG[(size_t)gr1 * 16 + gi_col] + bi, gf1 = CG[(size_t)gr1 * 16 + gf_col] + bfb;
            const float f0 = fminf(gf0, 0.f) - __logf(1.f + __expf(-fabsf(gf0))), f1 = fminf(gf1, 0.f) - __logf(1.f + __expf(-fabsf(gf1)));
            float s0 = f0, s1 = f1;
#pragma unroll
            for (int o = 1; o < 64; o <<= 1) { const float a = __shfl_up(s0, o), c = __shfl_up(s1, o); if (lane >= o) { s0 += a; s1 += c; } }
            s1 += __shfl(s0, 63);
            const float blast = __shfl(s1, 63);
            const float a0 = gi0 - s0, a1 = gi1 - s1;
            float pm0 = a0, pm1 = a1;
#pragma unroll
            for (int o = 1; o < 64; o <<= 1) { const float a = __shfl_up(pm0, o), c = __shfl_up(pm1, o); if (lane >= o) { pm0 = fmaxf(pm0, a); pm1 = fmaxf(pm1, c); } }
            pm1 = fmaxf(pm1, __shfl(pm0, 63));
            const float A0 = __shfl(pm1, 63);
            const float M0 = fmaxf(m_st, pm0), M1 = fmaxf(m_st, pm1);
            if (wid == 0) {
                cvec[t0] = __expf(a0 - A0); cvec[t1] = __expf(a1 - A0);
                rvec[t0] = __expf(A0 - M0); rvec[t1] = __expf(A0 - M1);
                avec[t0] = __expf(m_st - M0); avec[t1] = __expf(m_st - M1);
                evec[t0] = __expf(-s0 - M0); evec[t1] = __expf(-s1 - M1);
            }
            const float Ml = fmaxf(m_st, A0);
            decay_r = __expf(m_st - Ml); factor_r = __expf(A0 - Ml);
            m_st = blast + Ml;
        }
        __syncthreads();
        {
            const int tau = (tid >> 4), ch = tid & 15;
#pragma unroll
            for (int p = 0; p < 12; ++p) { const int tt = (p & 3) * 32 + tau;
                if (p < 4) *(LAS u32x4*)(lds + ML_QI + tt * 272 + ch * 16) = st[p];
                else if (p < 8) { const float c = cvec[tt]; u32x4 v = st[p];
                    v.x = pk2(bflo(v.x) * c, bfhi(v.x) * c); v.y = pk2(bflo(v.y) * c, bfhi(v.y) * c); v.z = pk2(bflo(v.z) * c, bfhi(v.z) * c); v.w = pk2(bflo(v.w) * c, bfhi(v.w) * c);
                    *(LAS u32x4*)(lds + ML_KI + offb(tt, ch)) = v; }
                else *(LAS u32x4*)(lds + ML_VI + offb(tt, ch)) = st[p]; }
        }
        __syncthreads();
        {
            const int tb = wid & 3, eh = wid >> 2, t = 32 * tb + r32;
            const float rr = rvec[t], aa = avec[t], em = evec[t];
            bf16x8 qf[8];
#pragma unroll
            for (int d0 = 0; d0 < 8; ++d0) qf[d0] = *(const LAS bf16x8*)(lds + ML_QI + t * 272 + (16 * d0 + 8 * hi) * 2);
            f32x16 hh2[2]; float den1 = 0.f;
#pragma unroll
            for (int et = 0; et < 2; ++et) {
#pragma unroll
                for (int i = 0; i < 16; ++i) hh2[et][i] = 0.f;
#pragma unroll
                for (int d0 = 0; d0 < 8; ++d0) { const bf16x8 cf = *(const LAS bf16x8*)(lds + ML_CI + (32 * (2 * eh + et) + r32) * 272 + (16 * d0 + 8 * hi) * 2);
                    hh2[et] = __builtin_amdgcn_mfma_f32_32x32x16_bf16(cf, qf[d0], hh2[et], 0, 0, 0); }
#pragma unroll
                for (int i = 0; i < 16; ++i) hh2[et][i] *= aa;
            }
            float den2 = 0.f;
#pragma unroll
            for (int d0 = 0; d0 < 8; ++d0) { const f32x4 n0 = *(const LAS f32x4*)(nvec + 16 * d0 + 8 * hi), n1 = *(const LAS f32x4*)(nvec + 16 * d0 + 8 * hi + 4);
                const u32x4 qq = __builtin_bit_cast(u32x4, qf[d0]);
                den2 += bflo(qq.x) * n0[0] + bfhi(qq.x) * n0[1] + bflo(qq.y) * n0[2] + bfhi(qq.y) * n0[3] + bflo(qq.z) * n1[0] + bfhi(qq.z) * n1[1] + bflo(qq.w) * n1[2] + bfhi(qq.w) * n1[3]; }
            for (int sb = 0; sb <= tb; ++sb) {
                f32x16 g;
#pragma unroll
                for (int i = 0; i < 16; ++i) g[i] = 0.f;
#pragma unroll
                for (int d0 = 0; d0 < 8; ++d0) { const bf16x8 kf = *(const LAS bf16x8*)(lds + ML_KI + offb(32 * sb + r32, 2 * d0 + hi)); g = __builtin_amdgcn_mfma_f32_32x32x16_bf16(kf, qf[d0], g, 0, 0, 0); }
                if (sb == tb) {
#pragma unroll
                    for (int i = 0; i < 16; ++i) if (crow(i, hi) > r32) g[i] = 0.f; }
#pragma unroll
                for (int i = 0; i < 16; ++i) { g[i] *= rr; den1 += g[i]; }
#pragma unroll
                for (int ks = 0; ks < 2; ++ks) {
                    u32x4 pw; pw.x = pk2(g[8 * ks], g[8 * ks + 1]); pw.y = pk2(g[8 * ks + 2], g[8 * ks + 3]); pw.z = pk2(g[8 * ks + 4], g[8 * ks + 5]); pw.w = pk2(g[8 * ks + 6], g[8 * ks + 7]);
                    const bf16x8 pf = __builtin_bit_cast(bf16x8, pw);
                    const int krow = 32 * sb + 16 * ks + 4 * hi + q4;
#pragma unroll
                    for (int et = 0; et < 2; ++et) { const int ch = 4 * (2 * eh + et) + 2 * g1 + (p4 >> 1);
                        const s16x4 lo = trrd(lds + ML_VI + offb(krow, ch) + 8 * (p4 & 1)), hh = trrd(lds + ML_VI + offb(krow + 8, ch) + 8 * (p4 & 1));
                        hh2[et] = __builtin_amdgcn_mfma_f32_32x32x16_bf16(cat8(lo, hh), pf, hh2[et], 0, 0, 0); }
                }
            }
            den1 += __shfl_xor(den1, 32); den2 += __shfl_xor(den2, 32);
            const float den = den1 + aa * den2; const float inv = 1.f / fmaxf(fabsf(den), em);
            if (need_ctx || step >= 2) {
                const int gr = base + (dir ? 127 - t : t);
                bf16* op = Hout + (size_t)gr * 512 + h * 128;
#pragma unroll
                for (int et = 0; et < 2; ++et)
#pragma unroll
                    for (int i4 = 0; i4 < 4; ++i4) { const int e0 = 32 * (2 * eh + et) + 8 * i4 + 4 * hi;
                        u32x2 w; w.x = pk2(hh2[et][4 * i4] * inv, hh2[et][4 * i4 + 1] * inv); w.y = pk2(hh2[et][4 * i4 + 2] * inv, hh2[et][4 * i4 + 3] * inv);
                        *(u32x2*)(op + e0) = w; }
            }
        }
        __syncthreads();
        {
            const int db = wid & 3, eg = wid >> 2;
            f32x16 cl[2]; float nl = 0.f;
#pragma unroll
            for (int et = 0; et < 2; ++et)
#pragma unroll
                for (int i = 0; i < 16; ++i) cl[et][i] = 0.f;
#pragma unroll 2
            for (int ks = 0; ks < 8; ++ks) {
                const int trow = 16 * ks + 8 * hi + q4;
                const int chk = 4 * db + 2 * g1 + (p4 >> 1);
                const s16x4 klo = trrd(lds + ML_KI + offb(trow, chk) + 8 * (p4 & 1)), khi = trrd(lds + ML_KI + offb(trow + 4, chk) + 8 * (p4 & 1));
                const bf16x8 kT = cat8(klo, khi);
                const u32x4 kk = __builtin_bit_cast(u32x4, kT);
                nl += bflo(kk.x) + bfhi(kk.x) + bflo(kk.y) + bfhi(kk.y) + bflo(kk.z) + bfhi(kk.z) + bflo(kk.w) + bfhi(kk.w);
#pragma unroll
                for (int et = 0; et < 2; ++et) { const int chv = 4 * (2 * eg + et) + 2 * g1 + (p4 >> 1);
                    const s16x4 vlo = trrd(lds + ML_VI + offb(trow, chv) + 8 * (p4 & 1)), vhi = trrd(lds + ML_VI + offb(trow + 4, chv) + 8 * (p4 & 1));
                    cl[et] = __builtin_amdgcn_mfma_f32_32x32x16_bf16(kT, cat8(vlo, vhi), cl[et], 0, 0, 0); }
            }
            nl += __shfl_xor(nl, 32);
            const float decay = decay_r, factor = factor_r;
#pragma unroll
            for (int et = 0; et < 2; ++et) {
#pragma unroll
                for (int i = 0; i < 16; ++i) Cst[et][i] = decay * Cst[et][i] + factor * cl[et][i];
                const int e = 32 * (2 * eg + et) + r32;
#pragma unroll
                for (int i4 = 0; i4 < 4; ++i4) { u32x2 w; w.x = pk2(Cst[et][4 * i4], Cst[et][4 * i4 + 1]); w.y = pk2(Cst[et][4 * i4 + 2], Cst[et][4 * i4 + 3]);
                    *(LAS u32x2*)(lds + ML_CI + e * 272 + (32 * db + 8 * i4 + 4 * hi) * 2) = w; }
            }
            if (eg == 0 && hi == 0) nvec[32 * db + r32] = decay * nvec[32 * db + r32] + factor * nl;
        }
        __syncthreads();
    }
}

__device__ __forceinline__ void load_row(const float* p, int lane, f32x4 (&v)[4]) {
#pragma unroll
    for (int j = 0; j < 4; ++j) v[j] = *(const f32x4*)(p + 4 * lane + 256 * j);
}
__device__ __forceinline__ float row_rstd(const f32x4 (&v)[4]) {
    float s = 0.f;
#pragma unroll
    for (int j = 0; j < 4; ++j) s += v[j][0] * v[j][0] + v[j][1] * v[j][1] + v[j][2] * v[j][2] + v[j][3] * v[j][3];
    return __builtin_amdgcn_rsqf(wave_sum(s) * (1.f / D) + EPS);
}
__device__ __forceinline__ void norm_mod_store(const f32x4 (&v)[4], const float* g, const float* shift, const float* scale, bf16* out, fp8* out8, int lane) {
    const float rs = row_rstd(v);
#pragma unroll
    for (int j = 0; j < 4; ++j) { const int c = 4 * lane + 256 * j; const f32x4 gg = *(const f32x4*)(g + c), sh = *(const f32x4*)(shift + c), sc = *(const f32x4*)(scale + c);
        const f32x4 y = (v[j] * rs * gg) * (sc + 1.f) + sh;
        u32x2 w; w.x = pk2(y[0], y[1]); w.y = pk2(y[2], y[3]); *(u32x2*)(out + c) = w;
        *(unsigned*)(out8 + c) = pk4_fp8(y * 8.f); }
}

template <class MapF>
__device__ __forceinline__ void wt_item(const MapF& mf, int K, int src_ld, bf16* dst, int item, int nblk, LAS float* scr, int lane) {
    const float* dummy = mf.base();
    const int kb = item / nblk, nb = item % nblk, k0 = 64 * kb, n0 = 32 * nb;
    const float* sp; float sc; mf(n0 + (lane & 31), sp, sc);
    if (!sp) { sp = dummy; sc = 0.f; }
    float tv[32];
#pragma unroll
    for (int i = 0; i < 32; ++i) tv[i] = sp[(size_t)(k0 + 2 * i + (lane >> 5)) * src_ld];
#pragma unroll
    for (int i = 0; i < 32; ++i) { const int kk = 2 * i + (lane >> 5); scr[kk * 33 + (lane & 31)] = tv[i] * sc; }
    LDS_WAIT(); asm volatile("" ::: "memory");
    const int c = lane & 7;
#pragma unroll
    for (int j = 0; j < 4; ++j) { const int n = (lane >> 3) + 8 * j; const LAS float* s = scr + (8 * c) * 33 + n;
        u32x4 o; o.x = pk2(s[0 * 33], s[1 * 33]); o.y = pk2(s[2 * 33], s[3 * 33]); o.z = pk2(s[4 * 33], s[5 * 33]); o.w = pk2(s[6 * 33], s[7 * 33]);
        *(u32x4*)(dst + (size_t)(n0 + n) * K + k0 + 8 * c) = o; }
    LDS_WAIT(); asm volatile("" ::: "memory");
}
template <class MapF>
__device__ __forceinline__ void wt_item8(const MapF& mf, int K, int src_ld, fp8* dst, int item, int nblk, float scale, LAS float* scr, int lane) {
    const float* dummy = mf.base();
    const int kb = item / nblk, nb = item % nblk, k0 = 64 * kb, n0 = 32 * nb;
    const float* sp; float sc; mf(n0 + (lane & 31), sp, sc); sc *= scale;
    if (!sp) { sp = dummy; sc = 0.f; }
    float tv[32];
#pragma unroll
    for (int i = 0; i < 32; ++i) tv[i] = sp[(size_t)(k0 + 2 * i + (lane >> 5)) * src_ld];
#pragma unroll
    for (int i = 0; i < 32; ++i) { const int kk = 2 * i + (lane >> 5); scr[kk * 33 + (lane & 31)] = tv[i] * sc; }
    LDS_WAIT(); asm volatile("" ::: "memory");
    const int c = lane & 7;
#pragma unroll
    for (int j = 0; j < 4; ++j) { const int n = (lane >> 3) + 8 * j; const LAS float* s = scr + (8 * c) * 33 + n;
        u32x2 o; o.x = pk4_fp8((f32x4){s[0 * 33], s[1 * 33], s[2 * 33], s[3 * 33]}); o.y = pk4_fp8((f32x4){s[4 * 33], s[5 * 33], s[6 * 33], s[7 * 33]});
        *(u32x2*)(dst + (size_t)(n0 + n) * K + k0 + 8 * c) = o; }
    LDS_WAIT(); asm volatile("" ::: "memory");
}
__device__ __forceinline__ int permd(int p) { const int i = p >> 3, w = p & 7; return (i < 4 ? 0 : 32) + (w < 4 ? 0 : 16) + 4 * (i & 3) + (w & 3); }
struct MapWin { const float* w;
    __device__ __forceinline__ const float* base() const { return w; }
    __device__ __forceinline__ void operator()(int n, const float*& sp, float& sc) const {
        if (n >= 4368) { sp = nullptr; sc = 0.f; return; }
        int col = n; sc = 1.f;
        if (n < 640 || (n >= 768 && n < 1792)) col = (n & ~63) + permd(n & 63);
        if (n < 512 || (n >= 768 && n < 1280)) sc = 0.125f * LOG2E;
        if (n >= 2816 && n < 3328) sc = 0.08838834764831845f;
        sp = w + col; } };
struct MapLin { const float* w; int off, nvalid;
    __device__ __forceinline__ const float* base() const { return w; }
    __device__ __forceinline__ void operator()(int n, const float*& sp, float& sc) const { sc = 1.f; sp = n < nvalid ? w + off + n : nullptr; } };
struct MapGU { const float* g; long du;
    __device__ __forceinline__ const float* base() const { return g; }
    __device__ __forceinline__ void operator()(int n, const float*& sp, float& sc) const { const int i = n >> 3, w = n & 7, j = 4 * i + (w & 3); sc = 1.f; sp = g + (j + (w < 4 ? 0l : du)); } };

__global__ void __launch_bounds__(512, 2) fwd_kernel(Args args) {
    extern __shared__ __attribute__((aligned(16))) unsigned char lds_raw[];
    LAS unsigned char* lds = (LAS unsigned char*)lds_raw;
    const int G = gridDim.x, bx = blockIdx.x, NGW = G * 8;
    GAS unsigned char* const ws0 = args.ws;
    unsigned* ctl = (unsigned*)(ws0 + WS_CTL);
#define PH_BEGIN int tid_p = threadIdx.x; asm volatile("" : "+v"(tid_p)); const int tid = tid_p, lane = tid & 63, wid = __builtin_amdgcn_readfirstlane(tid >> 6), gw = bx * 8 + wid; \
    GAS unsigned char* ws = ws0; asm volatile("" : "+s"(ws)); (void)lane; (void)gw;
    volatile LAS unsigned* MISC = (volatile LAS unsigned*)(lds + LDS_MISC);
    LAS int* tab = (LAS int*)(lds + LDS_TAB);
    if (threadIdx.x < 32) MISC[threadIdx.x] = 0u;
    __syncthreads();
#if ONE_LAUNCH
    XcdBarrier bar = xcd_barrier_post(ctl + CW_BAR, MISC + 8);
#define GRID_BAR() xcd_barrier(bar)
#else
#define GRID_BAR() do {} while (0)
#endif
    const int lo = args.lo, hi_ = args.hi;
#define IN(k) (lo <= (k) && (k) < hi_)
    CArgsP akp = (CArgsP)__builtin_amdgcn_kernarg_segment_ptr();
#define AIN(i) ((const float*)(launder_args(akp)->in[i]))
    unsigned long long pr_prev = 0ull, pr_acc = 0ull;
    if (PROBE_MASK) pr_prev = __builtin_amdgcn_s_memrealtime();
#define SEAM(k) do { if (IN(k) && IN((k) + 1)) GRID_BAR(); if (PROBE_MASK) { const unsigned long long _t = __builtin_amdgcn_s_memrealtime(); const int _b = (k) == 0 ? 16 : (((k) - 1) % NPH); \
        if ((PROBE_MASK >> _b) & 1) pr_acc += _t - pr_prev; pr_prev = _t; } } while (0)

#define x_in AIN(0)
#define c_in AIN(1)
#define ctx_in AIN(2)
#define cctx_in AIN(3)
#define mods ((float*)(ws + WS_MODS))
#define rope ((float*)(ws + WS_ROPE))
#define lamv ((float*)(ws + WS_LAM))
#define HL ((bf16*)(ws + WS_HL))
#define XS ((bf16*)(ws + WS_XS))
#define OUTF ((float*)(launder_args(akp)->out))
#define QA ((bf16*)(ws + WS_QA))
#define QB ((bf16*)(ws + WS_QB))
#define QC ((bf16*)(ws + WS_QC))
#define OA ((bf16*)(launder_args(akp)->out))
#define OB (((bf16*)(launder_args(akp)->out)) + (size_t)MA * 512)
#define HF ((bf16*)(ws + WS_HF))
#define HB ((bf16*)(ws + WS_HB))
#define GT ((unsigned char*)(ws + WS_GT))
#define Y ((bf16*)(ws + WS_Y))
#define CG ((float*)(ws + WS_CG))
#define LOG ((float*)(ws + WS_LOG))
#define TOKE ((int*)(ws + WS_TOKE))
#define TOKP ((int*)(ws + WS_TOKP))
#define ELIST ((int*)(ws + WS_ELIST))
#define WLIST ((float*)(ws + WS_WLIST))
#define WIN ((bf16*)(ws + WS_WIN))
#define WIN8 ((fp8*)(ws + WS_WIN + 5 * MiB))
#define WGT ((fp8*)(ws + WS_WGT))
#define HL8 ((fp8*)(ws + WS_Y))
#define WA ((bf16*)(ws + WS_WA))
#define WB ((bf16*)(ws + WS_WB))
#define WC ((bf16*)(ws + WS_WC))
#define WO ((bf16*)(ws + WS_WO))
#define WR ((bf16*)(ws + WS_WR))
#define WGU ((fp8*)(ws + WS_WGU))
#define H8 ((fp8*)(ws + WS_HF))
#define WD ((fp8*)(ws + WS_WD))
#define A2 ((fp8*)(ws + WS_A2))
#define Y2 ((fp8*)(ws + WS_Y2))
    if (IN(0)) {
        PH_BEGIN
        LAS float* sc = (LAS float*)lds;
        for (int i = tid; i < 9 * 1024; i += 512) { const int b = i >> 10, k = i & 1023; const float cv = b < 8 ? c_in[b * 1024 + k] : cctx_in[k]; sc[i] = cv * sigm(cv); }
        __syncthreads();
        LAS float* red = sc + 9 * 1024;
        for (int unit = bx; unit < 192; unit += G) {
            const int l = unit / 96, n0 = (unit % 96) * 64, cl = tid & 63, ks = tid >> 6;
            float acc[9];
#pragma unroll
            for (int b = 0; b < 9; ++b) acc[b] = 0.f;
            const float* w = AIN(4) + (size_t)l * 1024 * 6144 + n0 + cl;
#pragma unroll 16
            for (int k = 128 * ks; k < 128 * ks + 128; ++k) { const float wv = w[(size_t)k * 6144];
#pragma unroll
                for (int b = 0; b < 9; ++b) acc[b] += sc[b * 1024 + k] * wv; }
#pragma unroll
            for (int b = 0; b < 9; ++b) red[(ks * 9 + b) * 64 + cl] = acc[b];
            __syncthreads();
            for (int i = tid; i < 9 * 64; i += 512) { const int b = i >> 6, c2 = i & 63; float s = 0.f;
#pragma unroll
                for (int k2 = 0; k2 < 8; ++k2) s += red[(k2 * 9 + b) * 64 + c2];
                mods[(size_t)(l * 9 + b) * 6144 + n0 + c2] = s + AIN(5)[l * 6144 + n0 + c2]; }
            __syncthreads();
        }
        if (bx == G - 1) {
            for (int i = tid; i < 1024; i += 512) { const int pos = i >> 4, j = i & 15; const float inv = ex2(-(float)j * (13.287712379549449f / 16.f)); const float ang = (float)pos * inv;
                rope[i] = __cosf(ang); rope[1024 + i] = __sinf(ang); }
            if (wid == 0) {
#pragma unroll
                for (int l = 0; l < 2; ++l) { const float a = wave_sum(AIN(11)[l * 64 + lane] * AIN(12)[l * 64 + lane]), b2 = wave_sum(AIN(13)[l * 64 + lane] * AIN(14)[l * 64 + lane]);
                    const float li = 0.8f - 0.6f * __expf(-0.3f * (float)l);
                    if (lane == 0) lamv[l] = __expf(a) - __expf(b2) + li; }
            }
        }
    }
    SEAM(0);

    for (int layer = 0; layer < 2; ++layer) {
        const int P0 = 1 + layer * NPH;
        const bool need_ctx = layer == 0;
        const int Mx = need_ctx ? MA : ML;
        const int Mh = Mx / 2;
#define modl (mods + (size_t)layer * 9 * 6144)
        const float lam_init = 0.8f - 0.6f * __expf(-0.3f * (float)layer);

        if (IN(P0 + 0)) {
            PH_BEGIN
            LAS float* scr = (LAS float*)(lds + wid * 8448);
            const float* w_in = AIN(8) + (size_t)layer * 1024 * NIN;
            for (int it = gw; it < 5248; it += NGW) {
                int r = it;
                if (r < 2304) { MapWin mf{w_in}; const int nb = r % 144;
                    if (nb < 56) wt_item(mf, 1024, NIN, WIN, r, 144, scr, lane);
                    else if (nb < 136) wt_item8(mf, 1024, NIN, WIN8 - (size_t)1792 * 1024, r, 144, 64.f, scr, lane);
                    else wt_item(mf, 1024, NIN, WIN - (size_t)(4352 - 1792) * 1024, r, 144, scr, lane);
                    continue; } r -= 2304;
                if (r < 1536) { MapLin mf{w_in, 4368, 3072}; wt_item8(mf, 1024, NIN, WGT, r, 96, 64.f, scr, lane); continue; } r -= 1536;
                if (r < 768) { const int which = r >> 8; const float* src = AIN(17 + which) + (size_t)layer * 512 * 1024; MapLin mf{src, 0, 1024};
                    wt_item(mf, 512, 1024, which == 0 ? WA : (which == 1 ? WB : WC), r & 255, 32, scr, lane); continue; } r -= 768;
                if (r < 512) { MapLin mf{AIN(20) + (size_t)layer * 1024 * 1024, 0, 1024}; wt_item(mf, 1024, 1024, WO, r, 32, scr, lane); continue; } r -= 512;
                { MapLin mf{AIN(21) + (size_t)layer * 1024 * 64, 0, 64}; wt_item(mf, 1024, 64, WR, r, 8, scr, lane); }
            }
            if (layer == 0) {
                for (int m = gw; m < MA; m += NGW) {
                    const float* xr = m < ML ? x_in + (size_t)m * D : ctx_in + (size_t)(m - ML) * D;
                    const float* mv = modl + (m < ML ? (m >> 12) : 8) * 6144;
                    f32x4 v[4]; load_row(xr, lane, v);
                    norm_mod_store(v, AIN(6) + layer * D, mv, mv + 1024, HL + (size_t)m * D, HL8 + (size_t)m * D, lane);
                }
            }
        }
        SEAM(P0 + 0);

        if (IN(P0 + 1)) {
            PH_BEGIN
            for (int rep = 0; rep < REP_G1; ++rep) {
            { pg8::DenseSched S; S.init(HL, WIN, MA, 2048, 1024, G, bx);
              EpiG1 E{QA, QB, QC, CG, rope, 0};
              pg8::gemm_phase(lds, 1024, S, E); }
            { const int rot = ((MA / 256 * 8) % G) & ~7;
              pg8::DenseSched S; S.init(HL8, WIN8, MA, 2560, 512, G, (bx - rot + G) % G);
              EpiG1 E{QA, QB, QC, CG, rope, 1};
              pg8::gemm_phase<EpiG1, pg8::DenseSched, true, 0x7C7C7C7C, 0x79797979>(lds, 512, S, E); } }
        }
        SEAM(P0 + 1);

        if (IN(P0 + 2)) {
            PH_BEGIN
            for (int rep = 0; rep < REP_C; ++rep) {
            unsigned* wq = ctl + CW_WQ + 64 * ((layer * 2 + rep) * 4);
            for (;;) {
                if (tid == 0) MISC[0] = atomicAdd(wq, 1u);
                __syncthreads();
                const int u = (int)MISC[0];
                __syncthreads();
                if (u >= 64) break;
                mlstm_unit(lds, u, QC, CG, AIN(9) + layer * 16, HF, HB, need_ctx);
            } }
            const int nB = need_ctx ? 1088 : 1024;
            const float lam = lamv[layer];
            for (int rep = 0; rep < REP_B; ++rep) {
            unsigned* wq = ctl + CW_WQ + 64 * ((layer * 2 + rep) * 4);
            for (;;) {
                if (tid == 0) MISC[0] = atomicAdd(wq + 64, 1u);
                __syncthreads();
                const int u = (int)MISC[0];
                __syncthreads();
                if (u >= nB) break;
                mixB_unit(lds, u, QB, OB, AIN(15) + layer * 128, lam, lam_init);
            } }
            for (int rep = 0; rep < REP_A; ++rep) {
            unsigned* wq = ctl + CW_WQ + 64 * ((layer * 2 + rep) * 4);
            for (;;) {
                if (tid == 0) MISC[0] = atomicAdd(wq + 128, 1u);
                __syncthreads();
                const int u = (int)MISC[0];
                __syncthreads();
                if (u >= nB) break;
                mixA_unit(lds, u, QA, OA, AIN(10) + layer * 8);
                __syncthreads();
            } }
        }
        SEAM(P0 + 2);


        if (IN(P0 + 4)) {
            PH_BEGIN
            {
            const float* gm = AIN(16) + layer * 512;
            for (int m = gw; m < Mx; m += NGW) {
                const u32x4 a = *(const u32x4*)(HF + (size_t)m * 512 + 8 * lane), b = *(const u32x4*)(HB + (size_t)m * 512 + 8 * lane);
                const u32x4 co = *(const u32x4*)(QC + (size_t)m * LDC_ + 1536 + 8 * lane);
                float v[8];
                v[0] = bflo(a.x) + bflo(b.x); v[1] = bfhi(a.x) + bfhi(b.x); v[2] = bflo(a.y) + bflo(b.y); v[3] = bfhi(a.y) + bfhi(b.y);
                v[4] = bflo(a.z) + bflo(b.z); v[5] = bfhi(a.z) + bfhi(b.z); v[6] = bflo(a.w) + bflo(b.w); v[7] = bfhi(a.w) + bfhi(b.w);
                float ss = 0.f;
#pragma unroll
                for (int k = 0; k < 8; ++k) ss += v[k] * v[k];
                ss += __shfl_xor(ss, 1); ss += __shfl_xor(ss, 2); ss += __shfl_xor(ss, 4); ss += __shfl_xor(ss, 8);
                const float rs = __builtin_amdgcn_rsqf(ss * (1.f / 128.f) + EPS);
                const f32x4 g0 = *(const f32x4*)(gm + 8 * lane), g1v = *(const f32x4*)(gm + 8 * lane + 4);
                u32x4 w;
                w.x = pk2(v[0] * rs * g0[0] * sigm(bflo(co.x)), v[1] * rs * g0[1] * sigm(bfhi(co.x)));
                w.y = pk2(v[2] * rs * g0[2] * sigm(bflo(co.y)), v[3] * rs * g0[3] * sigm(bfhi(co.y)));
                w.z = pk2(v[4] * rs * g1v[0] * sigm(bflo(co.z)), v[5] * rs * g1v[1] * sigm(bfhi(co.z)));
                w.w = pk2(v[6] * rs * g1v[2] * sigm(bflo(co.w)), v[7] * rs * g1v[3] * sigm(bfhi(co.w)));
                *(u32x4*)(HF + (size_t)m * 512 + 8 * lane) = w;
            }
            }
            pg8::DenseSched S; S.init(HL8, WGT, Mx, NGT, 512, G, bx);
            EpiSig8 E{GT, NGT};
            pg8::gemm_phase<EpiSig8, pg8::DenseSched, true, 0x7C7C7C7C, 0x79797979>(lds, 512, S, E);
        }
        SEAM(P0 + 4);

        if (IN(P0 + 5)) {
            PH_BEGIN
            pg8::Gate3Sched S; S.A = (const char*)OA; S.Bt = (const char*)WA; S.dA1 = (const char*)OB - (const char*)OA; S.dA2 = (const char*)HF - (const char*)OA;
            S.dB1 = (const char*)WB - (const char*)WA; S.dB2 = (const char*)WC - (const char*)WA; S.K = 512; S.nM = Mx / 256; S.nN = 4; S.nwg = S.nM * 4; S.G = G; S.c = bx;
            EpiGate3 E{GT, Y};
            pg8::gemm_phase(lds, 512, S, E);
        }
        SEAM(P0 + 5);

        if (IN(P0 + 6)) {
            PH_BEGIN
            pg8::DenseSched S; S.init(Y, WO, Mx, 1024, 1024, G, bx);
            EpiRes E{layer == 0 ? x_in : (const float*)nullptr, ctx_in, XS, modl + 2 * 1024, 0};
            pg8::gemm_phase(lds, 1024, S, E);
        }
        SEAM(P0 + 6);

        if (IN(P0 + 7)) {
            PH_BEGIN
            for (int m = gw; m < Mx; m += NGW) {
                const bf16* xr = XS + (size_t)m * D;
                const float* mv = modl + (m < ML ? (m >> 12) : 8) * 6144;
                f32x4 v[4];
#pragma unroll
                for (int g2 = 0; g2 < 2; ++g2) { const u32x4 r = *(const u32x4*)(xr + g2 * 512 + 8 * lane);
                    v[2 * g2] = (f32x4){bflo(r.x), bfhi(r.x), bflo(r.y), bfhi(r.y)}; v[2 * g2 + 1] = (f32x4){bflo(r.z), bfhi(r.z), bflo(r.w), bfhi(r.w)}; }
                const float rs = row_rstd(v);
#pragma unroll
                for (int g2 = 0; g2 < 2; ++g2) { u32x4 w; u32x2 w8;
#pragma unroll
                    for (int q = 0; q < 2; ++q) { const int c = g2 * 512 + 8 * lane + 4 * q; const f32x4 gg = *(const f32x4*)(AIN(7) + layer * D + c), sh = *(const f32x4*)(mv + 3 * 1024 + c), sc = *(const f32x4*)(mv + 4 * 1024 + c);
                        const f32x4 y = (v[2 * g2 + q] * rs * gg) * (sc + 1.f) + sh;
                        if (q == 0) { w.x = pk2(y[0], y[1]); w.y = pk2(y[2], y[3]); w8.x = pk4_fp8(y * 8.f); } else { w.z = pk2(y[0], y[1]); w.w = pk2(y[2], y[3]); w8.y = pk4_fp8(y * 8.f); } }
                    *(u32x4*)(HL + (size_t)m * D + g2 * 512 + 8 * lane) = w;
                    *(u32x2*)(H8 + (size_t)m * D + g2 * 512 + 8 * lane) = w8; }
            }
            LAS float* scr = (LAS float*)(lds + wid * 8448);
            for (int it = gw; it < 24960; it += NGW) {
                if (it < 16640) { const int e = it >> 8, r = it & 255;
                    const float* gsrc = e < 64 ? AIN(23) + (size_t)(layer * 64 + e) * 1024 * 256 : AIN(26) + (size_t)layer * 1024 * 256;
                    const float* usrc = e < 64 ? AIN(24) + (size_t)(layer * 64 + e) * 1024 * 256 : AIN(27) + (size_t)layer * 1024 * 256;
                    MapGU mf{gsrc, (long)(usrc - gsrc)}; wt_item8(mf, 1024, 256, WGU + (size_t)e * 512 * 1024, r, 16, 64.f, scr, lane); }
                else { const int r2 = it - 16640, e = r2 >> 7, r = r2 & 127;
                    const float* src = e < 64 ? AIN(25) + (size_t)(layer * 64 + e) * 256 * 1024 : AIN(28) + (size_t)layer * 256 * 1024;
                    MapLin mf{src, 0, 1024}; wt_item8(mf, 256, 1024, WD + (size_t)e * 1024 * 256, r, 32, 32.f, scr, lane); }
            }
        }
        SEAM(P0 + 7);


        if (IN(P0 + 9)) {
            PH_BEGIN
            LAS int* lcnt = (LAS int*)lds; LAS int* lbase = lcnt + 128;
            LAS unsigned* st_e = (LAS unsigned*)(lds + 1024); LAS float* st_w = (LAS float*)(lds + 1024 + 8192);
            const int tpb = (Mx + G - 1) / G, m0 = bx * tpb, ntok = (m0 + tpb <= Mx) ? tpb : (Mx > m0 ? Mx - m0 : 0);
            if (tid < 128) lcnt[tid] = 0;
            LAS float* llog = (LAS float*)(lds + 32768);
            {
                const int r32 = lane & 31, hi = lane >> 5;
                const int tl = wid * 32 + r32, tlc = tl < ntok ? tl : (ntok > 0 ? ntok - 1 : 0);
                const bf16* hp = HL + (size_t)(m0 + tlc < Mx ? m0 + tlc : 0) * D + 8 * hi;
                LAS unsigned char* wl = lds + 69632;
                f32x16 c0, c1;
#pragma unroll
                for (int i = 0; i < 16; ++i) { c0[i] = 0.f; c1[i] = 0.f; }
#pragma unroll 1
                for (int kh = 0; kh < 2; ++kh) {
                    __syncthreads();
#pragma unroll
                    for (int pp = 0; pp < 8; ++pp) { const int idx = tid + 512 * pp, row = idx >> 6, ch = idx & 63;
                        *(LAS u32x4*)(wl + row * 1040 + ch * 16) = *(const u32x4*)(WR + (size_t)row * 1024 + kh * 512 + ch * 8); }
                    __syncthreads();
                    if (wid * 32 < ntok) {
#pragma unroll 1
                        for (int kb = 0; kb < 512; kb += 256) {
                            bf16x8 a[16];
#pragma unroll
                            for (int q = 0; q < 16; ++q) a[q] = *(const bf16x8*)(hp + kh * 512 + kb + 16 * q);
#pragma unroll
                            for (int q = 0; q < 16; ++q) { const LAS unsigned char* bp = wl + r32 * 1040 + (kb * 2) + (2 * q + hi) * 16;
                                const bf16x8 b0 = *(const LAS bf16x8*)bp, b1 = *(const LAS bf16x8*)(bp + 32 * 1040);
                                c0 = __builtin_amdgcn_mfma_f32_32x32x16_bf16(b0, a[q], c0, 0, 0, 0); c1 = __builtin_amdgcn_mfma_f32_32x32x16_bf16(b1, a[q], c1, 0, 0, 0); }
                        }
                    }
                }
                if (tl < ntok) {
#pragma unroll
                    for (int i = 0; i < 16; ++i) { llog[tl * 64 + crow(i, hi)] = c0[i]; llog[tl * 64 + 32 + crow(i, hi)] = c1[i]; }
                }
            }
            __syncthreads();
            const float* br = AIN(22) + layer * 64;
            const float bias = br[lane];
            for (int tl = wid; tl < ntok; tl += 8) {
                const int m = m0 + tl;
                const int half = m >= Mh ? 1 : 0;
                const float sg = sigm(llog[tl * 64 + lane]);
                const float sel = sg + bias;
                float m1 = sel; m1 = fmaxf(m1, __shfl_xor(m1, 1)); m1 = fmaxf(m1, __shfl_xor(m1, 2)); m1 = fmaxf(m1, __shfl_xor(m1, 4));
                const unsigned long long bm = __ballot(sel == m1);
                const unsigned gmask = (unsigned)(bm >> (lane & 56)) & 0xffu;
                const int first = __builtin_ctz(gmask);
                float v2 = ((lane & 7) == first) ? -3.0e38f : sel;
                v2 = fmaxf(v2, __shfl_xor(v2, 1)); v2 = fmaxf(v2, __shfl_xor(v2, 2)); v2 = fmaxf(v2, __shfl_xor(v2, 4));
                const float gsc = m1 + v2; const int g = lane >> 3;
                int gr = 0;
#pragma unroll
                for (int g2 = 0; g2 < 8; ++g2) { const float o = __int_as_float(__builtin_amdgcn_readlane(__float_as_int(gsc), 8 * g2)); gr += (o > gsc || (o == gsc && g2 < g)) ? 1 : 0; }
                const bool gsel = gr < 4;
                const float mv = gsel ? sel : -3.0e38f;
                const unsigned ub = (unsigned)__float_as_int(mv);
                const unsigned key = ((ub ^ ((ub >> 31) ? 0xFFFFFFFFu : 0x80000000u)) & ~63u) | (unsigned)(63 - lane);
                int rank = 0;
#pragma unroll
                for (int e2 = 0; e2 < 64; ++e2) { const unsigned ok = (unsigned)__builtin_amdgcn_readlane((int)key, e2); rank += ok > key ? 1 : 0;
                    if ((e2 & 7) == 7) asm volatile("" : "+v"(rank)); }
                const bool chosen = gsel && rank < 8;
                const float ssum = wave_sum(chosen ? sg : 0.f);
                if (chosen) {
                    const int lpos = __hip_atomic_fetch_add(lcnt + half * 64 + lane, 1, __ATOMIC_RELAXED, __HIP_MEMORY_SCOPE_WORKGROUP);
                    st_e[tl * 8 + rank] = (unsigned)lane | ((unsigned)lpos << 8); st_w[tl * 8 + rank] = sg / ssum * 2.5f;
                }
            }
            __syncthreads();
            if (tid < 128) { const int c = lcnt[tid]; lbase[tid] = c ? (int)atomicAdd(ctl + CW_CNT + 16 * ((layer * 2 + (tid >> 6)) * 64 + (tid & 63)), (unsigned)c) : 0; }
            __syncthreads();
            for (int idx = tid; idx < ntok * 8; idx += 512) {
                const int m = m0 + (idx >> 3), slot = idx & 7, half = m >= Mh ? 1 : 0;
                const unsigned v = st_e[idx]; const int e = (int)(v & 0xffu), pos = lbase[half * 64 + e] + (int)(v >> 8);
                ELIST[((size_t)half * 64 + e) * CAP + pos] = m; WLIST[((size_t)half * 64 + e) * CAP + pos] = st_w[idx];
                TOKE[(size_t)m * 8 + slot] = e; TOKP[(size_t)m * 8 + slot] = pos;
            }
        }
        SEAM(P0 + 9);

        for (int half = 0; half < 2; ++half) {
            const int PH = P0 + 10 + 3 * half;
            const int hbase = half * Mh;
            if (IN(PH) || IN(PH + 1) || IN(PH + 2)) {
                PH_BEGIN
                if (wid == 0) {
                    const int c = (int)__hip_atomic_load(ctl + CW_CNT + 16 * ((layer * 2 + half) * 64 + lane), __ATOMIC_RELAXED, __HIP_MEMORY_SCOPE_AGENT);
                    const int pad = (c + 255) & ~255;
                    int inc = pad;
#pragma unroll
                    for (int o = 1; o < 64; o <<= 1) { const int a = __shfl_up(inc, o); if (lane >= o) inc += a; }
                    tab[lane] = c; tab[65 + lane] = inc - pad;
                    if (lane == 63) { tab[64] = Mh; tab[65 + 64] = inc; }
                }
                __syncthreads();
            }
            if (IN(PH)) {
                PH_BEGIN
                if (wid == 0) {
                    tab[130 + lane] = (tab[65 + lane] >> 8) * 2; if (lane == 63) { tab[130 + 64] = (tab[65 + 64] >> 8) * 2; tab[195] = ((tab[65 + 64] + Mh) >> 8) * 2; } }
                __syncthreads();
                pg8::MoeSched<2, true> S; S.Abase = (const char*)H8; S.Bbase = (const char*)WGU; S.bstride = (size_t)512 * 1024; S.K = 512; S.elist = ELIST + (size_t)half * 64 * CAP; S.tab = tab;
                S.hbase = hbase; S.nU = tab[195]; S.G = G; S.c = bx; S.NE = 65; S.ehint = 0;
                EpiSwiGLU E{A2};
                pg8::gemm_phase<EpiSwiGLU, pg8::MoeSched<2, true>, true, 0x7C7C7C7C, 0x79797979>(lds, 512, S, E);
            }
            SEAM(PH);
            if (IN(PH + 1) && !DBG_H) {
                PH_BEGIN
                __syncthreads();
                if (wid == 0) { tab[130 + lane] = (tab[65 + lane] >> 8) * 4; if (lane == 63) { tab[194] = (tab[65 + 64] >> 8) * 4; tab[195] = (tab[65 + 64] >> 8) * 4; } }
                __syncthreads();
                {
                    pg8::MoeSched<4, false> S; S.Abase = (const char*)A2; S.Bbase = (const char*)WD; S.bstride = (size_t)1024 * 256; S.K = 128; S.elist = nullptr; S.tab = tab;
                    S.hbase = hbase; S.nU = tab[195]; S.G = G; S.c = bx; S.NE = 64; S.ehint = 0;
                    EpiY2 E{Y2, WLIST + (size_t)half * 64 * CAP};
                    pg8::gemm_phase<EpiY2, pg8::MoeSched<4, false>, true, 0x7D7D7D7D, 0x7A7A7A7A>(lds, 128, S, E);
                }
                {
                    pg8::DenseSched S; S.init(A2 + (size_t)tab[65 + 64] * 256, WD + (size_t)64 * 1024 * 256, Mh, 1024, 128, G, bx);
                    EpiRes E{nullptr, nullptr, XS, modl + 5 * 1024, hbase};
                    pg8::gemm_phase<EpiRes, pg8::DenseSched, true, 0x7D7D7D7D, 0x7A7A7A7A>(lds, 128, S, E);
                }
            }
            SEAM(PH + 1);
            if (IN(PH + 2)) {
                PH_BEGIN
                for (int m = hbase + gw; m < hbase + Mh; m += NGW) {
                    bf16* xr = XS + (size_t)m * D;
                    const float* mv = modl + (m < ML ? (m >> 12) : 8) * 6144;
                    f32x4 v[4], s4[4];
#pragma unroll
                    for (int g2 = 0; g2 < 2; ++g2) { const u32x4 r = *(const u32x4*)(xr + g2 * 512 + 8 * lane);
                        v[2 * g2] = (f32x4){bflo(r.x), bfhi(r.x), bflo(r.y), bfhi(r.y)}; v[2 * g2 + 1] = (f32x4){bflo(r.z), bfhi(r.z), bflo(r.w), bfhi(r.w)}; s4[2 * g2] = s4[2 * g2 + 1] = (f32x4){0.f, 0.f, 0.f, 0.f}; }
                    u32x2 yv[8][2];
#pragma unroll
                    for (int k = 0; k < 8; ++k) {
                        const int e = TOKE[(size_t)m * 8 + k], pos = TOKP[(size_t)m * 8 + k];
                        const fp8* yr = Y2 + (size_t)(tab[65 + e] + pos) * 1024 + 8 * lane;
                        yv[k][0] = *(const u32x2*)yr; yv[k][1] = *(const u32x2*)(yr + 512);
                    }
#pragma unroll
                    for (int k = 0; k < 8; ++k)
#pragma unroll
                        for (int g2 = 0; g2 < 2; ++g2) {
                            const f32x2 a = __builtin_amdgcn_cvt_pk_f32_fp8((int)yv[k][g2].x, false), b = __builtin_amdgcn_cvt_pk_f32_fp8((int)yv[k][g2].x, true);
                            const f32x2 c = __builtin_amdgcn_cvt_pk_f32_fp8((int)yv[k][g2].y, false), d = __builtin_amdgcn_cvt_pk_f32_fp8((int)yv[k][g2].y, true);
                            s4[2 * g2][0] += a[0]; s4[2 * g2][1] += a[1]; s4[2 * g2][2] += b[0]; s4[2 * g2][3] += b[1];
                            s4[2 * g2 + 1][0] += c[0]; s4[2 * g2 + 1][1] += c[1]; s4[2 * g2 + 1][2] += d[0]; s4[2 * g2 + 1][3] += d[1];
                        }
#pragma unroll
                    for (int j = 0; j < 4; ++j) { const f32x4 m5 = *(const f32x4*)(mv + 5 * 1024 + (j >> 1) * 512 + 8 * lane + 4 * (j & 1)); v[j] = v[j] + m5 * (s4[j] * 0.0625f); }
                    const float rs = row_rstd(v);
                    if (layer == 0) {
                        const float* mn = mods + (size_t)9 * 6144 + (m < ML ? (m >> 12) : 8) * 6144;
                        const float* g = AIN(6) + D;
#pragma unroll
                        for (int g2 = 0; g2 < 2; ++g2) { u32x4 w; w.x = pk2(v[2 * g2][0], v[2 * g2][1]); w.y = pk2(v[2 * g2][2], v[2 * g2][3]); w.z = pk2(v[2 * g2 + 1][0], v[2 * g2 + 1][1]); w.w = pk2(v[2 * g2 + 1][2], v[2 * g2 + 1][3]);
                            *(u32x4*)(xr + g2 * 512 + 8 * lane) = w; }
#pragma unroll
                        for (int g2 = 0; g2 < 2; ++g2) { u32x4 w; u32x2 w8;
#pragma unroll
                            for (int q = 0; q < 2; ++q) { const int c = g2 * 512 + 8 * lane + 4 * q; const f32x4 gg = *(const f32x4*)(g + c), sh = *(const f32x4*)(mn + c), sc = *(const f32x4*)(mn + 1024 + c);
                                const f32x4 y = (v[2 * g2 + q] * rs * gg) * (sc + 1.f) + sh;
                                if (q == 0) { w.x = pk2(y[0], y[1]); w.y = pk2(y[2], y[3]); w8.x = pk4_fp8(y * 8.f); } else { w.z = pk2(y[0], y[1]); w.w = pk2(y[2], y[3]); w8.y = pk4_fp8(y * 8.f); } }
                            *(u32x4*)(HL + (size_t)m * D + g2 * 512 + 8 * lane) = w; *(u32x2*)(HL8 + (size_t)m * D + g2 * 512 + 8 * lane) = w8; }
                    } else {
#pragma unroll
                        for (int j = 0; j < 4; ++j) { const int c = (j >> 1) * 512 + 8 * lane + 4 * (j & 1); const f32x4 gg = *(const f32x4*)(AIN(29) + c); *(f32x4*)(OUTF + (size_t)m * D + c) = v[j] * rs * gg; }
                    }
                }
            }
            SEAM(PH + 2);
        }
    }
    if (PROBE_MASK && bx == 0) { const unsigned long long t0 = __builtin_amdgcn_s_memrealtime(); while (__builtin_amdgcn_s_memrealtime() - t0 < 4ull * pr_acc) __builtin_amdgcn_s_sleep(8); }
}

#if DBG_AMP
__global__ void dbg_sum(const unsigned* buf, size_t nwords, unsigned long long* acc) {
    unsigned long long s = 0;
    for (size_t i = (size_t)blockIdx.x * blockDim.x + threadIdx.x; i < nwords; i += (size_t)gridDim.x * blockDim.x) s += (unsigned long long)buf[i] * (unsigned long long)(i * 2654435761ull + 12345ull);
    for (int o = 32; o > 0; o >>= 1) s += __shfl_xor(s, o);
    if ((threadIdx.x & 63) == 0) atomicAdd(acc, s);
}
__global__ void dbg_fill(float* o, size_t off, size_t n, const unsigned long long* acc, float weight) {
    const unsigned long long a = *acc;
    for (size_t i = (size_t)blockIdx.x * blockDim.x + threadIdx.x; i < n; i += (size_t)gridDim.x * blockDim.x) {
        unsigned long long h = (a + i) * 0x9E3779B97F4A7C15ull; h ^= h >> 29; h *= 0xBF58476D1CE4E5B9ull; h ^= h >> 32;
        o[off + i] = weight * (float)(h & 0xffffff) * (1.f / 16777216.f); }
}
#endif
extern "C" void kernel_launch(void* const* d_in, const int* in_sizes, int n_in, void* d_out, int out_size, void* d_ws, size_t ws_size, hipStream_t stream) {
    static int grid = 0;
    if (grid == 0) {
        if (n_in != 30 || out_size != ML * D || ws_size < WS_END) { fprintf(stderr, "kernel_launch: unexpected problem (n_in %d, out %d, ws %zu < %zu)\n", n_in, out_size, ws_size, (size_t)WS_END); grid = -1; return; }
        int dev = 0, cus = 0, per_cu = 0;
        if (hipGetDevice(&dev) != hipSuccess || hipDeviceGetAttribute(&cus, hipDeviceAttributeMultiprocessorCount, dev) != hipSuccess) { grid = -1; return; }
        if (hipFuncSetAttribute((const void*)fwd_kernel, hipFuncAttributeMaxDynamicSharedMemorySize, LDS_BYTES) != hipSuccess) { fprintf(stderr, "kernel_launch: hipFuncSetAttribute failed\n"); grid = -1; return; }
        if (hipOccupancyMaxActiveBlocksPerMultiprocessor(&per_cu, (const void*)fwd_kernel, 512, LDS_BYTES) != hipSuccess || per_cu < 1) fprintf(stderr, "kernel_launch: occupancy query reports %d\n", per_cu);
        (void)hipGetLastError();
        grid = cus;
    }
    if (grid < 0) return;
    (void)hipMemsetAsync((char*)d_ws + WS_CTL, 0, 1 * MiB, stream);
    Args a{};
    for (int i = 0; i < 30; ++i) a.in[i] = (const GAS float*)d_in[i];
    a.out = (GAS float*)d_out; a.ws = (GAS unsigned char*)d_ws;
#if ONE_LAUNCH
    a.lo = 0; a.hi = NPHASE;
    hipLaunchKernelGGL(fwd_kernel, dim3(grid), dim3(512), LDS_BYTES, stream, a);
#else
#ifndef DBG_NPH
#define DBG_NPH NPHASE
#endif
    for (int p = 0; p < DBG_NPH; ++p) { a.lo = p; a.hi = p + 1; hipLaunchKernelGGL(fwd_kernel, dim3(grid), dim3(512), LDS_BYTES, stream, a); }
#if DBG_AMP
    {
        unsigned long long* accs = (unsigned long long*)((char*)d_ws + 2048);
        const size_t seg = (size_t)ML * D / 4;
        const size_t offs[4] = {DBG_B0, DBG_B1, DBG_B2, DBG_B3}; const size_t lens[4] = {DBG_L0, DBG_L1, DBG_L2, DBG_L3}; const float wts[4] = {1.f, 0.3f, 0.09f, 0.027f};
        for (int k = 0; k < 4; ++k) {
            hipLaunchKernelGGL(dbg_sum, dim3(2048), dim3(256), 0, stream, (const unsigned*)((char*)d_ws + offs[k]), lens[k] / 4, accs + k);
            hipLaunchKernelGGL(dbg_fill, dim3(2048), dim3(256), 0, stream, (float*)d_out, seg * k, seg, accs + k, wts[k]);
        }
    }
#endif
#endif
}
```

```cpp
#include <hip/hip_runtime.h>
#include <cstdio>
#include <cstdint>

#ifndef ONE_LAUNCH
#define ONE_LAUNCH 1
#endif
#ifndef REP_A
#define REP_A 1
#endif
#ifndef REP_B
#define REP_B 1
#endif
#ifndef REP_C
#define REP_C 1
#endif
#ifndef REP_G1
#define REP_G1 1
#endif
#ifndef REP_E1
#define REP_E1 1
#endif
#ifndef REP_E2
#define REP_E2 1
#endif
#ifndef DBG_DUP
#define DBG_DUP 0
#endif
#ifndef PROBE_MASK
#define PROBE_MASK 0
#endif
#define DBG_NPH NPHASE
#define DBG_H 0
#define DBG_I 0
#define DBG_AMP 0
#define DBG_X1 1
#define DBG_B0 WS_QC
#define DBG_L0 ((size_t)MA * 2048 * 2)
#define DBG_B1 WS_HF
#define DBG_L1 ((size_t)MA * 512 * 2)
#define DBG_B2 WS_HB
#define DBG_L2 ((size_t)MA * 512 * 2)
#define DBG_B3 WS_HB
#define DBG_L3 ((size_t)MA * 512 * 2)

#define LAS __attribute__((address_space(3)))
#define GAS __attribute__((address_space(1)))
typedef unsigned short bf16;
typedef short bf16x8 __attribute__((ext_vector_type(8)));
typedef short s16x4 __attribute__((ext_vector_type(4)));
typedef float f32x2 __attribute__((ext_vector_type(2)));
typedef float f32x4 __attribute__((ext_vector_type(4)));
typedef float f32x16 __attribute__((ext_vector_type(16)));
typedef unsigned u32x2 __attribute__((ext_vector_type(2)));
typedef unsigned u32x4 __attribute__((ext_vector_type(4)));
typedef __bf16 bf16x2_t __attribute__((ext_vector_type(2)));

constexpr int D = 1024, NBATCH = 8, SEQ = 4096, CTXL = 256;
constexpr int ML = NBATCH * SEQ;
constexpr int MC = NBATCH * CTXL;
constexpr int MA = ML + MC;
constexpr int NIN = 7440;
constexpr int N1 = 4608;
constexpr int NGT = 3072;
constexpr int LDA_ = 768, LDB_ = 1536, LDC_ = 2048;
constexpr float EPS = 1e-6f;
constexpr float LOG2E = 1.4426950408889634f;
constexpr int NPH = 16;
constexpr int NPHASE = 1 + 2 * NPH;
constexpr int CAP = 17408;

constexpr size_t MiB = 1ull << 20;
constexpr size_t WS_CTL = 0;
constexpr size_t WS_MODS = 1 * MiB;
constexpr size_t WS_ROPE = 1 * MiB + 512 * 1024;
constexpr size_t WS_LAM = WS_ROPE + 16384;
constexpr size_t WS_WIN = 8 * MiB;
constexpr size_t WS_WGT = 17 * MiB;
constexpr size_t WS_WA = 23 * MiB, WS_WB = 24 * MiB, WS_WC = 25 * MiB;
constexpr size_t WS_WO = 26 * MiB;
constexpr size_t WS_WR = 28 * MiB;
constexpr size_t WS_HL = 38 * MiB;
constexpr size_t WS_CG = 106 * MiB;
constexpr size_t WS_LOG = 109 * MiB;
constexpr size_t WS_TOKE = 118 * MiB;
constexpr size_t WS_TOKP = 119 * MiB + 512 * 1024;
constexpr size_t WS_ELIST = 121 * MiB;
constexpr size_t WS_WLIST = 130 * MiB;
constexpr size_t WS_BIG = 140 * MiB;
constexpr size_t WS_QA = WS_BIG;
constexpr size_t WS_QB = WS_BIG + 51 * MiB;
constexpr size_t WS_QC = WS_BIG + 153 * MiB;
constexpr size_t WS_XS = WS_BIG + 289 * MiB;
constexpr size_t WS_HF = WS_BIG + 357 * MiB;
constexpr size_t WS_HB = WS_BIG + 391 * MiB;
constexpr size_t WS_GT = WS_BIG;
constexpr size_t WS_Y = WS_BIG + 425 * MiB;
constexpr size_t WS_WGU = WS_BIG;
constexpr size_t WS_WD = WS_BIG + 33 * MiB;
constexpr size_t WS_A2 = WS_BIG + 50 * MiB;
constexpr size_t A2_HALF = 43 * MiB;
constexpr size_t WS_Y2 = WS_BIG + 136 * MiB;
constexpr size_t WS_END = WS_BIG + 493 * MiB;
static_assert(WS_WGU + 65ull * 512 * 1024 <= WS_WD && WS_WD + 65ull * 1024 * 256 <= WS_A2 && 172992ull * 256 <= A2_HALF && WS_A2 + 2 * A2_HALF <= WS_Y2 && WS_Y2 + 155584ull * 1024 <= WS_XS && WS_XS + (size_t)MA * 2048 <= WS_HF, "ws map");
constexpr int CW_BAR = 4096;
constexpr int CW_WQ = 8192;
constexpr int CW_CNT = 16384;

constexpr int LDS_TAB = 143360;
constexpr int LDS_MISC = 147456;
constexpr int LDS_BYTES = 151552;

struct Args { const GAS float* in[30]; GAS float* out; GAS unsigned char* ws; int lo, hi; };
typedef const __attribute__((address_space(4))) Args* CArgsP;
__device__ __forceinline__ CArgsP launder_args(CArgsP p) { asm volatile("" : "+s"(p)); return p; }

__device__ __forceinline__ unsigned pk2(float lo, float hi) { f32x2 v = {lo, hi}; bf16x2_t b = __builtin_convertvector(v, bf16x2_t); return __builtin_bit_cast(unsigned, b); }
__device__ __forceinline__ float bflo(unsigned u) { return __uint_as_float(u << 16); }
__device__ __forceinline__ float bfhi(unsigned u) { return __uint_as_float(u & 0xffff0000u); }
__device__ __forceinline__ float ex2(float x) { return __builtin_amdgcn_exp2f(x); }
__device__ __forceinline__ float sigm(float x) { return __builtin_amdgcn_rcpf(1.f + ex2(-LOG2E * x)); }
__device__ __forceinline__ float fadd_s(float a, float b) { float r = a + b; asm("" : "+v"(r)); return r; }
__device__ __forceinline__ float wave_sum(float v) {
#pragma unroll
    for (int o = 1; o < 64; o <<= 1) v += __shfl_xor(v, o);
    return v;
}
template <int CTRL, int ROWMASK = 0xf>
__device__ __forceinline__ float dppf(float v) { const int vi = __builtin_bit_cast(int, v); return __builtin_bit_cast(float, __builtin_amdgcn_update_dpp(ROWMASK == 0xf ? vi : 0, vi, CTRL, ROWMASK, 0xf, ROWMASK == 0xf)); }
__device__ __forceinline__ float wave_sum_dpp(float v) {
    v += dppf<0xB1>(v); v += dppf<0x4E>(v); v += dppf<0x141>(v); v += dppf<0x140>(v);
    v += dppf<0x142, 0xa>(v);
    v += dppf<0x143, 0xc>(v);
    return __builtin_bit_cast(float, __builtin_amdgcn_readlane(__builtin_bit_cast(int, v), 63));
}
__device__ __forceinline__ float max8(float v) {
    v = fmaxf(v, dppf<0xB1>(v)); v = fmaxf(v, dppf<0x4E>(v)); v = fmaxf(v, dppf<0x141>(v)); return v;
}
__device__ __forceinline__ int crow(int i, int hi) { return (i & 3) + 8 * (i >> 2) + 4 * hi; }
__device__ __forceinline__ int offb(int row, int ch) { return 256 * row + 16 * (ch ^ (((row & 3) << 2) | ((row >> 2) & 3))); }
typedef short v4i16_t __attribute__((ext_vector_type(4)));
__device__ __forceinline__ s16x4 trrd(LAS unsigned char* p) { return __builtin_bit_cast(s16x4, __builtin_amdgcn_ds_read_tr16_b64_v4i16((LAS v4i16_t*)p)); }
__device__ __forceinline__ bf16x8 cat8(s16x4 a, s16x4 b) { return (bf16x8){a[0], a[1], a[2], a[3], b[0], b[1], b[2], b[3]}; }
#define LDS_WAIT() asm volatile("s_waitcnt lgkmcnt(0)" ::: "memory")

#define XB_TMO      128
#define XB_XCNT(j)  (256  + 64 * (j))
#define XB_XSUB(j)  (1280 + 64 * (j))
#define XB_XGEN(j)  (2304 + 64 * (j))
#define XB_TOP      3328
#define XB_TOPGEN   3392
#define XCD_BAR_WORDS 3456
#define XB_SPIN_CAP (1u << 18)
__device__ __forceinline__ unsigned xb_ld(unsigned* p)              { return __hip_atomic_load(p, __ATOMIC_RELAXED, __HIP_MEMORY_SCOPE_AGENT); }
__device__ __forceinline__ unsigned xb_add(unsigned* p, unsigned v) { return __hip_atomic_fetch_add(p, v, __ATOMIC_RELAXED, __HIP_MEMORY_SCOPE_AGENT); }
__device__ __forceinline__ unsigned xb_xcc_id() { return (unsigned)__builtin_amdgcn_s_getreg((3 << 11) | 20) & 0xFu; }
#define XB_SPIN(cond, bar) do { unsigned _sp = 0; while (cond) { __builtin_amdgcn_s_sleep(1); \
    if ((++_sp & 255u) == 0u) { if (xb_ld(&(bar)[XB_TMO])) break; if (_sp > XB_SPIN_CAP) { atomicAdd(&(bar)[XB_TMO], 1u); break; } } } } while (0)
struct XcdBarrier { unsigned* bar; unsigned x; volatile LAS unsigned* st; };
__device__ __forceinline__ XcdBarrier xcd_barrier_post(unsigned* bar, volatile LAS unsigned* st) {
    XcdBarrier b; b.bar = bar; b.x = xb_xcc_id(); b.st = st;
    if (threadIdx.x == 0) (void)xb_add(&bar[XB_XCNT(b.x)], 1u);
    return b;
}
__device__ __forceinline__ void xcd_barrier_complete(unsigned* bar, unsigned x, unsigned& nloc, unsigned& nx) {
    const unsigned G = gridDim.x * gridDim.y * gridDim.z;
    unsigned sum, cnt, mine, sp = 0u;
    for (;;) {
        sum = 0u; cnt = 0u; mine = 0u;
#pragma unroll
        for (unsigned j = 0; j < 16; ++j) { const unsigned c = xb_ld(&bar[XB_XCNT(j)]); sum += c; cnt += (c > 0u) ? 1u : 0u; mine = (j == x) ? c : mine; }
        if (sum == G) break;
        __builtin_amdgcn_s_sleep(1);
        if ((++sp & 255u) == 0u) { if (xb_ld(&bar[XB_TMO])) break; if (sp > XB_SPIN_CAP) { atomicAdd(&bar[XB_TMO], 1u); break; } }
    }
    nloc = mine > 0u ? mine : 1u; nx = cnt > 0u ? cnt : 1u;
}
__device__ __forceinline__ void xcd_barrier(const XcdBarrier& b) {
    asm volatile("s_waitcnt vmcnt(0)" ::: "memory");
    __syncthreads();
    if (threadIdx.x == 0) {
        unsigned* bar = b.bar;
        __builtin_amdgcn_s_waitcnt(0);
        unsigned nloc = b.st[0], nx = b.st[1];
        if (nloc == 0u) { xcd_barrier_complete(bar, b.x, nloc, nx); b.st[0] = nloc; b.st[1] = nx; }
        const unsigned old = xb_add(&bar[XB_XSUB(b.x)], 1u);
        const unsigned gen = old / nloc;
        if (old + 1u == (gen + 1u) * nloc) {
            __builtin_amdgcn_fence(__ATOMIC_RELEASE, "agent");
            asm volatile("s_waitcnt vmcnt(0)" ::: "memory");
            const unsigned og = xb_add(&bar[XB_TOP], 1u);
            const unsigned tg = og / nx;
            if (og + 1u == (tg + 1u) * nx) xb_add(&bar[XB_TOPGEN], 1u);
            else XB_SPIN(xb_ld(&bar[XB_TOPGEN]) == tg, bar);
            __builtin_amdgcn_fence(__ATOMIC_ACQUIRE, "agent");
            xb_add(&bar[XB_XGEN(b.x)], 1u);
            asm volatile("s_waitcnt vmcnt(0)" ::: "memory");
        } else {
            XB_SPIN(xb_ld(&bar[XB_XGEN(b.x)]) == gen, bar);
            __builtin_amdgcn_fence(__ATOMIC_ACQUIRE, "agent");
            asm volatile("s_waitcnt vmcnt(0)" ::: "memory");
        }
    }
    __syncthreads();
}

namespace pg8 {
constexpr int BM = 256, BK = 64, HALF = 128, HTB = HALF * BK * 2, STAGE_BYTES = 8 * HTB, NXCD = 8, WGM = 8;
__device__ __forceinline__ int lds_byte(int r, int c) { const int st = (r >> 4) * 2 + (c >> 5), rr = r & 15, cc = c & 31, ob = rr * 64 + cc * 2; return st * 1024 + (ob ^ (((ob >> 9) & 1) << 5)); }
__device__ __forceinline__ void stage_rc(int b, int& R, int& C) { const int st = b / 1024, sb = b % 1024, swz = sb ^ (((sb >> 9) & 1) << 5); R = (st >> 1) * 16 + swz / 64; C = (st & 1) * 32 + (swz % 64) / 2; }
__device__ __forceinline__ int perm32(int rho) { const int n = rho >> 4, i = rho & 15; return 8 * (i >> 2) + 4 * n + (i & 3); }

template <class T, class = void> struct EpiNst { static constexpr int v = 0; };
template <class T> struct EpiNst<T, decltype((void)T::NST)> { static constexpr int v = T::NST; };
struct GUnit { const char* A; const char* B; int pm, pn, a0, a1, a2, a3; };

template <class Epi, class Sched, bool F8 = false, int SCA = 0x7F7F7F7F, int SCB = 0x7F7F7F7F>
__device__ __forceinline__ void gemm_phase(LAS unsigned char* lds, const int K_, const Sched& S, const Epi& E) {
    int tid_l = threadIdx.x; asm volatile("" : "+v"(tid_l));
    const int tid = tid_l, wid = __builtin_amdgcn_readfirstlane(tid >> 6), lane = tid & 63, wr = wid >> 2, wc = wid & 3, fr = lane & 15, fq = lane >> 4;
    int K = K_; asm volatile("" : "+s"(K));
    const int nt = K / BK;
    int Rr[2], Cc[2]; unsigned voffA[2], voffB[2];
#pragma unroll
    for (int i = 0; i < 2; ++i) { int R, C; stage_rc(tid * 16 + i * 8192, R, C); const int Rb = Epi::PERM == 2 ? (64 * (R >> 5) + 16 * ((R >> 2) & 3) + 4 * ((R >> 4) & 1) + (R & 3)) : (Epi::PERM ? ((R & ~31) + perm32(R & 31)) : R);
        Rr[i] = R; Cc[i] = C; voffA[i] = (unsigned)(R * K + C) * 2u; voffB[i] = (unsigned)(Rb * K + C) * 2u; }
    const size_t kstep = (size_t)(BK * 2);
    const size_t hstep = (size_t)HALF * K * 2;
    const size_t hstepB = Epi::PERM == 2 ? (size_t)8 * K * 2 : hstep;
    const unsigned ldsw = (unsigned)wid * 1024u;
    const int aoff = lds_byte(wr * 64 + fr, fq * 8), boff = lds_byte(wc * 32 + fr, fq * 8);
#define PG8_SA(b, h) (((b) * 2 + (h)) * HTB)
#define PG8_SB(b, h) ((4 + (b) * 2 + (h)) * HTB)
#define PG8_STAGE(bufoff, gbase, voff) do { _Pragma("unroll") for (int _i = 0; _i < 2; ++_i) \
        __builtin_amdgcn_global_load_lds((const unsigned*)((const char*)(gbase) + (voff)[_i]), (LAS unsigned*)(lds + (bufoff) + ldsw + _i * 8192), 16, 0, 0); } while (0)
#define PG8_LD8(addr) __builtin_shufflevector(*(const LAS i32x4_*)(addr), *(const LAS i32x4_*)((addr) + 1024), 0, 1, 2, 3, 4, 5, 6, 7)
#define PG8_LDA(dst, b, h) do { _Pragma("unroll") for (int m = 0; m < 4; ++m) dst[m] = PG8_LD8(lds + PG8_SA(b, h) + aoff + m * 2048); } while (0)
#define PG8_LDB(dst, b, h) do { _Pragma("unroll") for (int n = 0; n < 2; ++n) dst[n] = PG8_LD8(lds + PG8_SB(b, h) + boff + n * 2048); } while (0)
#define PG8_LO(x) __builtin_bit_cast(bf16x8, __builtin_shufflevector(x, x, 0, 1, 2, 3))
#define PG8_HI(x) __builtin_bit_cast(bf16x8, __builtin_shufflevector(x, x, 4, 5, 6, 7))
#define PG8_MMA(ai, bj, At, Bt) do { __builtin_amdgcn_s_setprio(1); _Pragma("unroll") for (int m = 0; m < 4; ++m) _Pragma("unroll") for (int n = 0; n < 2; ++n) { \
        if constexpr (F8) asm volatile("v_mfma_scale_f32_16x16x128_f8f6f4 %0, %1, %2, %0, %3, %4 op_sel_hi:[0,0,0]" : "+v"(acc[ai][bj][m][n]) : "v"(Bt[n]), "v"(At[m]), "v"(scb_), "v"(sca_)); \
        else { acc[ai][bj][m][n] = __builtin_amdgcn_mfma_f32_16x16x32_bf16(PG8_LO(Bt[n]), PG8_LO(At[m]), acc[ai][bj][m][n], 0, 0, 0); \
               acc[ai][bj][m][n] = __builtin_amdgcn_mfma_f32_16x16x32_bf16(PG8_HI(Bt[n]), PG8_HI(At[m]), acc[ai][bj][m][n], 0, 0, 0); } } \
        __builtin_amdgcn_s_setprio(0); } while (0)
#define PG8_WAIT_V(n) asm volatile("s_waitcnt vmcnt(" #n ")" ::: "memory")
#define PG8_WAIT_L(n) asm volatile("s_waitcnt lgkmcnt(" #n ")" ::: "memory")
#define PG8_BAR __builtin_amdgcn_s_barrier()
#define PG8_SCHED __builtin_amdgcn_sched_barrier(0)
#define PG8_SETA(v, u) do { if constexpr (Sched::GATHER) { _Pragma("unroll") for (int _h = 0; _h < 2; ++_h) _Pragma("unroll") for (int _i = 0; _i < 2; ++_i) \
        v[_h][_i] = S.arow(u, Rr[_i] + 128 * _h) + (unsigned)Cc[_i] * 2u; } } while (0)
#define PG8_STAGEA(bufoff, p, v, h) do { if constexpr (Sched::GATHER) { PG8_STAGE(bufoff, p, v[h]); } else { PG8_STAGE(bufoff, (p) + (h) * hstep, voffA); } } while (0)
    GUnit cur, nxt; int ui = 0;
    if (!S.next(0, cur)) return;
    f32x4 acc[2][2][4][2];
#pragma unroll
    for (int a = 0; a < 2; ++a)
#pragma unroll
        for (int b = 0; b < 2; ++b)
#pragma unroll
            for (int m = 0; m < 4; ++m)
#pragma unroll
                for (int n = 0; n < 2; ++n) acc[a][b][m][n] = (f32x4){0.f, 0.f, 0.f, 0.f};
    typedef int i32x8_ __attribute__((ext_vector_type(8))); typedef int i32x4_ __attribute__((ext_vector_type(4)));
    i32x8_ At[4], B0[2], B1[2];
    int sca_ = SCA, scb_ = SCB; asm volatile("" : "+v"(sca_), "+v"(scb_));
    unsigned vAc[2][2], vAn[2][2];
    PG8_SETA(vAc, cur);
    const char* cA = cur.A; const char* cB = cur.B;
    PG8_STAGE(PG8_SB(0, 0), cB, voffB); PG8_STAGE(PG8_SB(0, 1), cB + hstepB, voffB); PG8_STAGEA(PG8_SA(0, 0), cA, vAc, 0); PG8_STAGEA(PG8_SA(0, 1), cA, vAc, 1);
    if (wr == 1) PG8_BAR;
    PG8_WAIT_V(2); PG8_BAR;
    PG8_STAGE(PG8_SB(1, 0), cB + kstep, voffB); PG8_STAGEA(PG8_SA(1, 0), cA + kstep, vAc, 0); PG8_STAGE(PG8_SB(1, 1), cB + hstepB + kstep, voffB);
    PG8_WAIT_V(6); PG8_BAR;
    for (;;) {
        const bool has_next = S.next(ui + 1, nxt);
        const char* nA = has_next ? nxt.A : cA; const char* nB = has_next ? nxt.B : cB;
        if constexpr (Sched::GATHER) { if (has_next) { PG8_SETA(vAn, nxt); } else {
#pragma unroll
            for (int _h = 0; _h < 2; ++_h)
#pragma unroll
                for (int _i = 0; _i < 2; ++_i) vAn[_h][_i] = vAc[_h][_i]; } }
        for (int t = 0; t < nt; t += 2) {
            const bool last = (t == nt - 2);
            const char* a1 = cA + (size_t)(t + 1) * kstep;
            const char* a2 = last ? nA : cA + (size_t)(t + 2) * kstep; const char* b2 = last ? nB : cB + (size_t)(t + 2) * kstep;
            const char* a3 = a2 + kstep; const char* b3 = b2 + kstep;
            unsigned v2[2][2];
            if constexpr (Sched::GATHER) {
#pragma unroll
            for (int _h = 0; _h < 2; ++_h)
#pragma unroll
                for (int _i = 0; _i < 2; ++_i) v2[_h][_i] = last ? vAn[_h][_i] : vAc[_h][_i]; }
            PG8_LDB(B0, 0, 0); PG8_LDB(B1, 0, 1); PG8_SCHED; PG8_LDA(At, 0, 0); PG8_STAGEA(PG8_SA(1, 1), a1, vAc, 1);
            const bool relax = EpiNst<Epi>::v == 8 && t == 0 && ui > 0;
            if (relax) PG8_WAIT_V(16); else PG8_WAIT_V(8);
            PG8_WAIT_L(0); PG8_BAR; PG8_MMA(0, 0, At, B0); PG8_MMA(0, 1, At, B1); PG8_BAR; PG8_SCHED;
            PG8_LDA(At, 0, 1); PG8_STAGE(PG8_SB(0, 0), b2, voffB); PG8_STAGE(PG8_SB(0, 1), b2 + hstepB, voffB); PG8_STAGEA(PG8_SA(0, 0), a2, v2, 0);
            if (relax) PG8_WAIT_V(16); else PG8_WAIT_V(8);
            PG8_WAIT_L(0); PG8_BAR; PG8_MMA(1, 0, At, B0); PG8_MMA(1, 1, At, B1); PG8_BAR; PG8_SCHED;
            PG8_LDB(B0, 1, 0); PG8_LDB(B1, 1, 1); PG8_SCHED; PG8_LDA(At, 1, 0); PG8_STAGEA(PG8_SA(0, 1), a2, v2, 1);
            PG8_WAIT_V(8); PG8_WAIT_L(0); PG8_BAR; PG8_MMA(0, 0, At, B0); PG8_MMA(0, 1, At, B1); PG8_BAR; PG8_SCHED;
            PG8_LDA(At, 1, 1); PG8_STAGE(PG8_SB(1, 0), b3, voffB); PG8_STAGE(PG8_SB(1, 1), b3 + hstepB, voffB); PG8_STAGEA(PG8_SA(1, 0), a3, v2, 0);
            PG8_WAIT_V(8); PG8_WAIT_L(0); PG8_BAR; PG8_MMA(1, 0, At, B0); PG8_MMA(1, 1, At, B1); PG8_BAR; PG8_SCHED;
        }
        if (wr == 0) PG8_BAR;
        if constexpr (F8) asm volatile("s_nop 15\n\ts_nop 7" ::: "memory");
        bool keep = false;
        int tid_e = threadIdx.x; asm volatile("" : "+v"(tid_e));
        const int fr_e = tid_e & 15, fq_e = (tid_e & 63) >> 4;
        if constexpr (Epi::MULTI) keep = E.step(acc, cur, wr, wc, fr_e, fq_e); else E(acc, cur, wr, wc, fr_e, fq_e);
        if (!has_next) break;
        if (!keep) {
#pragma unroll
        for (int a = 0; a < 2; ++a)
#pragma unroll
            for (int b = 0; b < 2; ++b)
#pragma unroll
                for (int m = 0; m < 4; ++m)
#pragma unroll
                    for (int n = 0; n < 2; ++n) acc[a][b][m][n] = (f32x4){0.f, 0.f, 0.f, 0.f}; }
        cur = nxt; cA = nA; cB = nB; ++ui;
        if constexpr (Sched::GATHER) {
#pragma unroll
        for (int _h = 0; _h < 2; ++_h)
#pragma unroll
            for (int _i = 0; _i < 2; ++_i) vAc[_h][_i] = vAn[_h][_i]; }
        if (wr == 1) PG8_BAR;
    }
    PG8_WAIT_V(0);
    PG8_BAR;
#undef PG8_SA
#undef PG8_SB
#undef PG8_STAGE
#undef PG8_LD8
#undef PG8_LO
#undef PG8_HI
#undef PG8_LDA
#undef PG8_LDB
#undef PG8_MMA
#undef PG8_WAIT_V
#undef PG8_WAIT_L
#undef PG8_BAR
#undef PG8_SCHED
#undef PG8_SETA
#undef PG8_STAGEA
}

struct DenseSched {
    static constexpr bool GATHER = false;
    const char* A; const char* Bt; int K, nM, nN, nwg, G, c, isplit, G2, first, last;
    __device__ __forceinline__ void init(const void* A_, const void* B_, int M, int N, int K_, int G_, int c_) { A = (const char*)A_; Bt = (const char*)B_; K = K_; nM = M / BM; nN = N / BM; nwg = nM * nN; G = G_; c = c_; isplit = 1 << 20; G2 = G_; first = 0; last = nwg; }
    __device__ __forceinline__ bool next(int i, GUnit& u) const {
        long L = first + (long)i * G + c;
        if (i >= isplit) { if (c >= G2) return false; L = (long)isplit * G + (long)(i - isplit) * G2 + c; }
        if (c < 0 || L >= last) return false;
        int wgid = (int)L; { const int q = nwg / NXCD, r = nwg % NXCD, xcd = wgid % NXCD, off = wgid / NXCD; wgid = (xcd < r ? xcd * (q + 1) : r * (q + 1) + (xcd - r) * q) + off; }
        const int nig = WGM * nN, gid = wgid / nig, fm = gid * WGM, gsz = (nM - fm) < WGM ? (nM - fm) : WGM;
        u.pm = fm + ((wgid % nig) % gsz); u.pn = (wgid % nig) / gsz;
        u.A = A + (size_t)u.pm * BM * K * 2; u.B = Bt + (size_t)u.pn * BM * K * 2; u.a0 = u.a1 = u.a2 = u.a3 = 0; return true;
    }
    __device__ __forceinline__ unsigned arow(const GUnit&, int) const { return 0u; }
};

struct Gate3Sched {
    static constexpr bool GATHER = false;
    const char* A; const char* Bt; long dA1, dA2, dB1, dB2; int K, nM, nN, nwg, G, c;
    __device__ __forceinline__ bool next(int i, GUnit& u) const {
        const int ti = i / 3, seg = i - 3 * ti;
        const long L = (long)ti * G + c; if (L >= nwg) return false;
        int wgid = (int)L; { const int q = nwg / NXCD, r = nwg % NXCD, xcd = wgid % NXCD, off = wgid / NXCD; wgid = (xcd < r ? xcd * (q + 1) : r * (q + 1) + (xcd - r) * q) + off; }
        const int nig = WGM * nN, gid = wgid / nig, fm = gid * WGM, gsz = (nM - fm) < WGM ? (nM - fm) : WGM;
        u.pm = fm + ((wgid % nig) % gsz); u.pn = (wgid % nig) / gsz;
        const long da = seg == 0 ? 0 : (seg == 1 ? dA1 : dA2), db = seg == 0 ? 0 : (seg == 1 ? dB1 : dB2);
        u.A = A + da + (size_t)u.pm * BM * K * 2; u.B = Bt + db + (size_t)u.pn * BM * K * 2; u.a0 = u.a1 = u.a2 = 0; u.a3 = seg; return true;
    }
    __device__ __forceinline__ unsigned arow(const GUnit&, int) const { return 0u; }
};

template <int NPN, bool G_> struct MoeSched {
    static constexpr bool GATHER = G_;
    const char* Abase; const char* Bbase; size_t bstride; int K; const int* elist; const LAS int* tab; int hbase, nU, G, c, NE; mutable int ehint;
    __device__ __forceinline__ bool next(int i, GUnit& u) const {
        const long L = (long)i * G + c; if (L >= nU) return false;
        int wgid = (int)L; { const int q = nU / NXCD, r = nU % NXCD, xcd = wgid % NXCD, off = wgid / NXCD; wgid = (xcd < r ? xcd * (q + 1) : r * (q + 1) + (xcd - r) * q) + off; }
        int e = ehint; if (wgid < tab[130 + e]) e = 0;
        while (e < NE - 1 && wgid >= tab[130 + e + 1]) ++e;
        e = __builtin_amdgcn_readfirstlane(e); ehint = e;
        const int r = wgid - tab[130 + e], rb = r / NPN, pn = r % NPN;
        u.pm = rb; u.pn = pn; u.a0 = e; u.a1 = __builtin_amdgcn_readfirstlane(tab[65 + e]) + 256 * rb; u.a2 = __builtin_amdgcn_readfirstlane(tab[e]); u.a3 = 0;
        u.A = G_ ? Abase : Abase + (size_t)u.a1 * K * 2;
        u.B = Bbase + (size_t)e * bstride + (size_t)pn * BM * K * 2;
        return true;
    }
    __device__ __forceinline__ unsigned arow(const GUnit& u, int R) const {
        const int idx = 256 * u.pm + R; int tok;
        if (u.a0 == 64) tok = hbase + idx;
        else { const int t0 = elist[(size_t)u.a0 * CAP + (idx < u.a2 ? idx : u.a2 - 1)]; tok = (idx < u.a2) ? t0 : hbase; }
        return (unsigned)tok * (unsigned)(K * 2);
    }
};
}
using pg8::GUnit;

typedef f32x4 AccT[2][2][4][2];
struct EpiG1 {
    static constexpr bool PERM = true; static constexpr bool MULTI = false;
    bf16 *QA, *QB, *QC; float* CG; const float* rope; int mode;
    __device__ __forceinline__ void operator()(const AccT& acc, const GUnit& u, int wr, int wc, int fr, int fq) const {
        const int pn = mode ? u.pn + 7 : (u.pn < 7 ? u.pn : 17);
        if (pn == 17) {
            if (wc == 0 && fq < 2) {
#pragma unroll
                for (int ai = 0; ai < 2; ++ai)
#pragma unroll
                    for (int m = 0; m < 4; ++m) { const int row = u.pm * 256 + ai * 128 + wr * 64 + m * 16 + fr; float* p = CG + (size_t)row * 16 + 8 * fq;
                        *(f32x4*)p = acc[ai][0][m][0]; *(f32x4*)(p + 4) = acc[ai][0][m][1]; }
            }
            return;
        }
        bf16* base; int ld, colt;
        if (pn < 3) { base = QA; ld = LDA_; colt = pn * 256; } else if (pn < 9) { base = QB; ld = LDB_; colt = (pn - 3) * 256; } else { base = QC; ld = LDC_; colt = (pn - 9) * 256; }
        const bool latent = u.pm < 128;
        const bool rp0 = latent && (pn * 256 < 640 || (pn * 256 >= 768 && pn * 256 < 1792)), rp1 = latent && (pn * 256 + 128 < 640 || (pn * 256 + 128 >= 768 && pn * 256 + 128 < 1792));
#pragma unroll
        for (int ai = 0; ai < 2; ++ai) {
            f32x4 cs[4], sn[4];
            if (rp0 || rp1) {
#pragma unroll
                for (int m = 0; m < 4; ++m) { const int row = u.pm * 256 + ai * 128 + wr * 64 + m * 16 + fr; const int t = row & 4095; const int pos = (wc & 1) ? (t & 63) : (t >> 6);
                    cs[m] = *(const f32x4*)(rope + pos * 16 + 4 * fq); sn[m] = *(const f32x4*)(rope + 1024 + pos * 16 + 4 * fq); }
            } else {
#pragma unroll
                for (int m = 0; m < 4; ++m) { cs[m] = (f32x4){1.f, 1.f, 1.f, 1.f}; sn[m] = (f32x4){0.f, 0.f, 0.f, 0.f}; }
            }
#pragma unroll
            for (int m = 0; m < 4; ++m) {
                const int row = u.pm * 256 + ai * 128 + wr * 64 + m * 16 + fr;
                bf16* rowp = base + (size_t)row * ld + colt + wc * 32 + 8 * fq;
#pragma unroll
                for (int bj = 0; bj < 2; ++bj) {
                    const bool rp = bj ? rp1 : rp0;
                    f32x4 v0 = acc[ai][bj][m][0], v1 = acc[ai][bj][m][1];
                    if (rp) { const f32x4 a = v0, b = v1; v0 = a * cs[m] - b * sn[m]; v1 = b * cs[m] + a * sn[m]; }
                    u32x4 w; w.x = pk2(v0[0], v0[1]); w.y = pk2(v0[2], v0[3]); w.z = pk2(v1[0], v1[1]); w.w = pk2(v1[2], v1[3]);
                    *(u32x4*)(rowp + bj * 128) = w;
                }
            }
            asm volatile("" ::: "memory");
        }
    }
};
struct EpiBf16 {
    static constexpr bool PERM = true; static constexpr bool MULTI = false;
    bf16* O; int ld;
    __device__ __forceinline__ void operator()(const AccT& acc, const GUnit& u, int wr, int wc, int fr, int fq) const {
#pragma unroll
        for (int ai = 0; ai < 2; ++ai)
#pragma unroll
            for (int m = 0; m < 4; ++m) { bf16* rowp = O + (size_t)(u.pm * 256 + ai * 128 + wr * 64 + m * 16 + fr) * ld + u.pn * 256 + wc * 32 + 8 * fq;
#pragma unroll
                for (int bj = 0; bj < 2; ++bj) { const f32x4 v0 = acc[ai][bj][m][0], v1 = acc[ai][bj][m][1];
                    u32x4 w; w.x = pk2(v0[0], v0[1]); w.y = pk2(v0[2], v0[3]); w.z = pk2(v1[0], v1[1]); w.w = pk2(v1[2], v1[3]);
                    *(u32x4*)(rowp + bj * 128) = w; } }
    }
};
struct EpiSig8 {
    static constexpr int PERM = 2; static constexpr bool MULTI = false; static constexpr int NST = 8;
    unsigned char* O; int ld;
    static __device__ __forceinline__ float q1(float x) { return fmaxf(__builtin_rintf(__builtin_amdgcn_rcpf(__builtin_fmaf(ex2(x), 1.f / 255.f, 1.f / 255.f))), 1.f); }
    static __device__ __forceinline__ unsigned q4(f32x4 v) {
        unsigned w = 0;
        w = __builtin_amdgcn_cvt_pk_u8_f32(q1(v[0]), 0, w); w = __builtin_amdgcn_cvt_pk_u8_f32(q1(v[1]), 1, w);
        w = __builtin_amdgcn_cvt_pk_u8_f32(q1(v[2]), 2, w); w = __builtin_amdgcn_cvt_pk_u8_f32(q1(v[3]), 3, w);
        return w;
    }
    __device__ __forceinline__ void operator()(const AccT& acc, const GUnit& u, int wr, int wc, int fr, int fq) const {
#pragma unroll
        for (int ai = 0; ai < 2; ++ai)
#pragma unroll
            for (int m = 0; m < 4; ++m) { unsigned char* rowp = O + (size_t)(u.pm * 256 + ai * 128 + wr * 64 + m * 16 + fr) * ld + u.pn * 256 + wc * 64 + 16 * fq;
                u32x4 w; w.x = q4(acc[ai][0][m][0]); w.y = q4(acc[ai][0][m][1]); w.z = q4(acc[ai][1][m][0]); w.w = q4(acc[ai][1][m][1]);
                *(u32x4*)rowp = w; }
    }
};
struct EpiGate3 {
    static constexpr int PERM = 2; static constexpr bool MULTI = true;
    const unsigned char* GT; bf16* Y; int rowbase;
    static __device__ __forceinline__ float ub(unsigned w, int k) { return (float)((w >> (8 * k)) & 0xffu); }
    __device__ __forceinline__ bool step(AccT& acc, const GUnit& u0, int wr, int wc, int fr, int fq) const {
        GUnit u = u0; u.pm += rowbase >> 8;
        const int col0 = u.pn * 256 + wc * 64 + 16 * fq, seg = u.a3;
        if (seg < 2) {
            u32x4 ga[2][4], gb[2][4];
#pragma unroll
            for (int ai = 0; ai < 2; ++ai)
#pragma unroll
                for (int m = 0; m < 4; ++m) { const unsigned char* gp = GT + (size_t)(u.pm * 256 + ai * 128 + wr * 64 + m * 16 + fr) * NGT + seg * 1024 + col0;
                    ga[ai][m] = *(const u32x4*)gp; gb[ai][m] = *(const u32x4*)(gp + 1024); }
#pragma unroll
            for (int ai = 0; ai < 2; ++ai)
#pragma unroll
                for (int m = 0; m < 4; ++m)
#pragma unroll
                    for (int bj = 0; bj < 2; ++bj)
#pragma unroll
                        for (int n = 0; n < 2; ++n) { const unsigned a = ga[ai][m][2 * bj + n], b = gb[ai][m][2 * bj + n];
                            f32x4 r;
#pragma unroll
                            for (int k = 0; k < 4; ++k) r[k] = ub(a, k) * __builtin_amdgcn_rcpf(ub(b, k));
                            acc[ai][bj][m][n] *= r; }
            return true;
        }
        u32x4 g[2][4];
#pragma unroll
        for (int ai = 0; ai < 2; ++ai)
#pragma unroll
            for (int m = 0; m < 4; ++m) g[ai][m] = *(const u32x4*)(GT + (size_t)(u.pm * 256 + ai * 128 + wr * 64 + m * 16 + fr) * NGT + 2048 + col0);
#pragma unroll
        for (int ai = 0; ai < 2; ++ai) {
#pragma unroll
            for (int m = 0; m < 4; ++m) { bf16* yp = Y + (size_t)(u.pm * 256 + ai * 128 + wr * 64 + m * 16 + fr) * 1024 + col0;
#pragma unroll
                for (int bj = 0; bj < 2; ++bj) { const unsigned g0 = g[ai][m][2 * bj], g1 = g[ai][m][2 * bj + 1]; const f32x4 v0 = acc[ai][bj][m][0] * (1.f / 255.f), v1 = acc[ai][bj][m][1] * (1.f / 255.f);
                    u32x4 w;
                    w.x = pk2(ub(g0, 0) * v0[0], ub(g0, 1) * v0[1]); w.y = pk2(ub(g0, 2) * v0[2], ub(g0, 3) * v0[3]);
                    w.z = pk2(ub(g1, 0) * v1[0], ub(g1, 1) * v1[1]); w.w = pk2(ub(g1, 2) * v1[2], ub(g1, 3) * v1[3]);
                    *(u32x4*)(yp + 8 * bj) = w; } }
            asm volatile("" ::: "memory");
        }
        return false;
    }
};
struct EpiRes {
    static constexpr bool PERM = true; static constexpr bool MULTI = false;
    const float* resL; const float* resC; bf16* xs; const float* modv; int rowbase;
    __device__ __forceinline__ void operator()(const AccT& acc, const GUnit& u, int wr, int wc, int fr, int fq) const {
        const int row0 = rowbase + u.pm * 256;
        const float* mv = modv + (row0 < ML ? (row0 >> 12) : 8) * 6144;
        const int col0 = u.pn * 256 + wc * 32 + 8 * fq;
        f32x4 m4[2][2];
#pragma unroll
        for (int bj = 0; bj < 2; ++bj)
#pragma unroll
            for (int n = 0; n < 2; ++n) m4[bj][n] = *(const f32x4*)(mv + col0 + bj * 128 + 4 * n);
#pragma unroll
        for (int ai = 0; ai < 2; ++ai) {
            if (resL) {
                f32x4 r4[4][2][2];
#pragma unroll
                for (int m = 0; m < 4; ++m) { const int row = row0 + ai * 128 + wr * 64 + m * 16 + fr;
                    const float* rp = row < ML ? resL + (size_t)row * D : resC + (size_t)(row - ML) * D;
#pragma unroll
                    for (int bj = 0; bj < 2; ++bj)
#pragma unroll
                        for (int n = 0; n < 2; ++n) r4[m][bj][n] = *(const f32x4*)(rp + col0 + bj * 128 + 4 * n); }
#pragma unroll
                for (int m = 0; m < 4; ++m) { bf16* op = xs + (size_t)(row0 + ai * 128 + wr * 64 + m * 16 + fr) * D + col0;
#pragma unroll
                    for (int bj = 0; bj < 2; ++bj) { const f32x4 a = r4[m][bj][0] + m4[bj][0] * acc[ai][bj][m][0], b = r4[m][bj][1] + m4[bj][1] * acc[ai][bj][m][1];
                        u32x4 w; w.x = pk2(a[0], a[1]); w.y = pk2(a[2], a[3]); w.z = pk2(b[0], b[1]); w.w = pk2(b[2], b[3]);
                        *(u32x4*)(op + bj * 128) = w; } }
            } else {
                u32x4 r[4][2];
#pragma unroll
                for (int m = 0; m < 4; ++m) { const bf16* rp = xs + (size_t)(row0 + ai * 128 + wr * 64 + m * 16 + fr) * D + col0;
#pragma unroll
                    for (int bj = 0; bj < 2; ++bj) r[m][bj] = *(const u32x4*)(rp + bj * 128); }
#pragma unroll
                for (int m = 0; m < 4; ++m) { bf16* op = xs + (size_t)(row0 + ai * 128 + wr * 64 + m * 16 + fr) * D + col0;
#pragma unroll
                    for (int bj = 0; bj < 2; ++bj) { const u32x4 rr = r[m][bj]; const f32x4 a0 = acc[ai][bj][m][0], a1 = acc[ai][bj][m][1], ma = m4[bj][0], mb = m4[bj][1];
                        u32x4 w;
                        w.x = pk2(bflo(rr.x) + ma[0] * a0[0], bfhi(rr.x) + ma[1] * a0[1]); w.y = pk2(bflo(rr.y) + ma[2] * a0[2], bfhi(rr.y) + ma[3] * a0[3]);
                        w.z = pk2(bflo(rr.z) + mb[0] * a1[0], bfhi(rr.z) + mb[1] * a1[1]); w.w = pk2(bflo(rr.w) + mb[2] * a1[2], bfhi(rr.w) + mb[3] * a1[3]);
                        *(u32x4*)(op + bj * 128) = w; } }
            }
            asm volatile("" ::: "memory");
        }
    }
};
struct EpiLogits {
    static constexpr bool PERM = false; static constexpr bool MULTI = false;
    float* L;
    __device__ __forceinline__ void operator()(const AccT& acc, const GUnit& u, int wr, int wc, int fr, int fq) const {
        if (wc >= 2) return;
#pragma unroll
        for (int ai = 0; ai < 2; ++ai)
#pragma unroll
            for (int m = 0; m < 4; ++m) { const int row = u.pm * 256 + ai * 128 + wr * 64 + m * 16 + fr;
#pragma unroll
                for (int n = 0; n < 2; ++n) *(f32x4*)(L + (size_t)row * 64 + wc * 32 + n * 16 + 4 * fq) = acc[ai][0][m][n]; }
    }
};
typedef unsigned char fp8;
__device__ __forceinline__ unsigned pk4_fp8(f32x4 v) {
    int w = 0;
    w = __builtin_amdgcn_cvt_pk_fp8_f32(__builtin_amdgcn_fmed3f(v[0], -400.f, 400.f), __builtin_amdgcn_fmed3f(v[1], -400.f, 400.f), w, false);
    w = __builtin_amdgcn_cvt_pk_fp8_f32(__builtin_amdgcn_fmed3f(v[2], -400.f, 400.f), __builtin_amdgcn_fmed3f(v[3], -400.f, 400.f), w, true);
    return (unsigned)w;
}
struct EpiSwiGLU {
    static constexpr int PERM = 2; static constexpr bool MULTI = false;
    fp8* A2;
    __device__ __forceinline__ void operator()(const AccT& acc, const GUnit& u, int wr, int wc, int fr, int fq) const {
#pragma unroll
        for (int ai = 0; ai < 2; ++ai)
#pragma unroll
            for (int m = 0; m < 4; ++m) { fp8* rowp = A2 + (size_t)(u.a1 + ai * 128 + wr * 64 + m * 16 + fr) * 256 + u.pn * 128 + wc * 32 + 8 * fq;
                u32x2 o;
#pragma unroll
                for (int bj = 0; bj < 2; ++bj) { const f32x4 g = acc[ai][bj][m][0], uu = acc[ai][bj][m][1];
                    const f32x4 a = {g[0] * uu[0] * __builtin_amdgcn_rcpf(1.f + ex2(g[0])), g[1] * uu[1] * __builtin_amdgcn_rcpf(1.f + ex2(g[1])), g[2] * uu[2] * __builtin_amdgcn_rcpf(1.f + ex2(g[2])), g[3] * uu[3] * __builtin_amdgcn_rcpf(1.f + ex2(g[3]))};
                    if (bj == 0) o.x = pk4_fp8(a); else o.y = pk4_fp8(a); }
                *(u32x2*)rowp = o; }
    }
};
struct EpiY2 {
    static constexpr int PERM = 2; static constexpr bool MULTI = false; static constexpr int NST = 8;
    fp8* Y2;
    __device__ __forceinline__ void operator()(const AccT& acc, const GUnit& u, int wr, int wc, int fr, int fq) const {
#pragma unroll
        for (int ai = 0; ai < 2; ++ai)
#pragma unroll
            for (int m = 0; m < 4; ++m) { const int lr = ai * 128 + wr * 64 + m * 16 + fr;
                fp8* rowp = Y2 + (size_t)(u.a1 + lr) * 1024 + u.pn * 256 + wc * 64 + 16 * fq;
                u32x4 o; o.x = pk4_fp8(acc[ai][0][m][0] * 16.f); o.y = pk4_fp8(acc[ai][0][m][1] * 16.f); o.z = pk4_fp8(acc[ai][1][m][0] * 16.f); o.w = pk4_fp8(acc[ai][1][m][1] * 16.f);
                *(u32x4*)rowp = o; }
    }
};

template <int DV, bool DIFF>
__device__ __forceinline__ void attn_core(LAS unsigned char* lds, const bf16* qptr  ,
                                          const bf16* kv0, int nt0, const bf16* kv1, int nt1, int ld, int kcol, int vcol, int stream,
                                          bool domask, int qpos, int q0w  , int kpos0, float& m_run, float& l_run, f32x16 (&o)[DV / 32]) {
    constexpr int NDV = DV / 32;
    constexpr int NLD = DIFF ? 4 : 2;
    constexpr int KOFF = 0, VOFF = DIFF ? 16384 : 9216, BUFB = DIFF ? 32768 : 21504;
    int tid_l = threadIdx.x; asm volatile("" : "+v"(tid_l));
    const int tid = tid_l, lane = tid & 63, r32 = lane & 31, hi = lane >> 5, q4 = (lane & 15) >> 2, p4 = lane & 3, g1 = (lane >> 4) & 1;
    bf16x8 qf[4];
#pragma unroll
    for (int d0 = 0; d0 < 4; ++d0) qf[d0] = *(const bf16x8*)(qptr + 16 * d0);
    const int NT = nt0 + nt1;
    f32x16 negm;
    { const float _nm = -m_run;
#pragma unroll
      for (int i = 0; i < 16; ++i) negm[i] = _nm; }
    unsigned goff[NLD], woff[NLD];
#pragma unroll
    for (int p = 0; p < NLD; ++p) { const int idx = tid + 512 * p;
        if (DIFF) { const int w = idx >> 10, rem = idx & 1023, row = rem >> 4, ch = rem & 15; goff[p] = (unsigned)(row * ld + (w ? vcol : kcol) + ch * 8); woff[p] = (unsigned)((w ? VOFF : KOFF) + offb(row, ch)); }
        else { const int w = idx >> 9, rem = idx & 511, row = rem >> 3, ch = rem & 7; goff[p] = (unsigned)(row * ld + (w ? vcol : kcol) + ch * 8); woff[p] = (unsigned)((w ? VOFF + row * 192 : KOFF + row * 144) + ch * 16); } }
    unsigned kadr[4], vadr[2][NDV];
#pragma unroll
    for (int d0 = 0; d0 < 4; ++d0) kadr[d0] = (unsigned)(KOFF + (DIFF ? offb(r32, 8 * stream + 2 * d0 + hi) : r32 * 144 + (16 * d0 + 8 * hi) * 2));
#pragma unroll
    for (int jj = 0; jj < 2; ++jj)
#pragma unroll
        for (int dv = 0; dv < NDV; ++dv) vadr[jj][dv] = (unsigned)(VOFF + (DIFF ? offb(4 * hi + 8 * jj + q4, 4 * dv + 2 * g1 + (p4 >> 1)) + 8 * (p4 & 1) : (4 * hi + 8 * jj + q4) * 192 + (32 * dv + 16 * g1 + 4 * p4) * 2));
    constexpr int KB2 = DIFF ? 8192 : 32 * 144;
    constexpr int VROW = DIFF ? 256 : 192;
    u32x4 st[NLD];
#define AT_LOAD(t) do { const bf16* _b = ((t) < nt0) ? kv0 + (size_t)((t) * 64) * ld : kv1 + (size_t)(((t) - nt0) * 64) * ld; \
        _Pragma("unroll") for (int _p = 0; _p < NLD; ++_p) st[_p] = *(const u32x4*)(_b + goff[_p]); } while (0)
#define AT_WRITE(BO) do { _Pragma("unroll") for (int _p = 0; _p < NLD; ++_p) *(LAS u32x4*)(lds + (BO) + woff[_p]) = st[_p]; } while (0)
#define AT_VLD(dst, g, BO) do { _Pragma("unroll") for (int dv = 0; dv < NDV; ++dv) { dst[dv][0] = trrd(lds + (BO) + (16 * (g)) * VROW + vadr[0][dv]); dst[dv][1] = trrd(lds + (BO) + (16 * (g)) * VROW + vadr[1][dv]); } } while (0)
#define AT_PVG(src, PW) do { const bf16x8 pf = __builtin_bit_cast(bf16x8, PW); _Pragma("unroll") for (int dv = 0; dv < NDV; ++dv) o[dv] = __builtin_amdgcn_mfma_f32_32x32x16_bf16(cat8(src[dv][0], src[dv][1]), pf, o[dv], 0, 0, 0); } while (0)
#define AT_TILE(t, BO) do { \
        bool tmask_ = false; \
        if (!DIFF) { if (domask && (t) < nt0) { const int kp_ = kpos0 + 64 * (t); \
            if (kp_ > q0w + 159 || kp_ + 63 < q0w - 128) break;     \
            tmask_ = !(kp_ >= q0w - 97 && kp_ <= q0w + 65); } } \
        f32x16 p0, p1; bf16x8 kf[8]; \
        _Pragma("unroll") for (int d0 = 0; d0 < 4; ++d0) { kf[2 * d0] = *(const LAS bf16x8*)(lds + (BO) + kadr[d0]); kf[2 * d0 + 1] = *(const LAS bf16x8*)(lds + (BO) + KB2 + kadr[d0]); } \
        \
        p0 = __builtin_amdgcn_mfma_f32_32x32x16_bf16(kf[0], qf[0], negm, 0, 0, 0); \
        p1 = __builtin_amdgcn_mfma_f32_32x32x16_bf16(kf[1], qf[0], negm, 0, 0, 0); \
        _Pragma("unroll") for (int d0 = 1; d0 < 4; ++d0) { \
            p0 = __builtin_amdgcn_mfma_f32_32x32x16_bf16(kf[2 * d0], qf[d0], p0, 0, 0, 0); \
            p1 = __builtin_amdgcn_mfma_f32_32x32x16_bf16(kf[2 * d0 + 1], qf[d0], p1, 0, 0, 0); } \
        \
        s16x4 va[NDV][2], vb[NDV][2]; \
        AT_VLD(va, 0, BO); \
        if (!DIFF) { if (tmask_) { const int kp = kpos0 + 64 * (t); \
            _Pragma("unroll") for (int i = 0; i < 16; ++i) { const int d0_ = kp + crow(i, hi) - qpos; const int d1_ = d0_ + 32; \
                if (d0_ > 128 || d0_ < -128) p0[i] = -1e30f; if (d1_ > 128 || d1_ < -128) p1[i] = -1e30f; } } } \
        float ls = 0.f; \
        _Pragma("unroll") for (int i = 0; i < 16; ++i) { p0[i] = ex2(p0[i]); p1[i] = ex2(p1[i]); } \
        { float sa = fadd_s(p0[0], p1[0]), sb = fadd_s(p0[1], p1[1]);     \
          _Pragma("unroll") for (int i = 2; i < 16; i += 2) { sa = fadd_s(sa, p0[i]); sb = fadd_s(sb, p0[i + 1]); sa = fadd_s(sa, p1[i]); sb = fadd_s(sb, p1[i + 1]); } ls = sa + sb; } \
        l_run += ls; \
        u32x4 pw0, pw1, pw2, pw3; \
        pw0.x = pk2(p0[0], p0[1]); pw0.y = pk2(p0[2], p0[3]); pw0.z = pk2(p0[4], p0[5]); pw0.w = pk2(p0[6], p0[7]); \
        pw1.x = pk2(p0[8], p0[9]); pw1.y = pk2(p0[10], p0[11]); pw1.z = pk2(p0[12], p0[13]); pw1.w = pk2(p0[14], p0[15]); \
        pw2.x = pk2(p1[0], p1[1]); pw2.y = pk2(p1[2], p1[3]); pw2.z = pk2(p1[4], p1[5]); pw2.w = pk2(p1[6], p1[7]); \
        pw3.x = pk2(p1[8], p1[9]); pw3.y = pk2(p1[10], p1[11]); pw3.z = pk2(p1[12], p1[13]); pw3.w = pk2(p1[14], p1[15]); \
        AT_VLD(vb, 1, BO); AT_PVG(va, pw0); \
        AT_VLD(va, 2, BO); AT_PVG(vb, pw1); \
        AT_VLD(vb, 3, BO); AT_PVG(va, pw2); \
        AT_PVG(vb, pw3); \
        if (__any(ls > 4096.f)) {     \
            const float mxl = fmaxf(ls, __shfl_xor(ls, 32)); const float dl = mxl > 4096.f ? (float)((int)((__float_as_uint(mxl) >> 23) & 0xffu) - 132) : 0.f; const float alpha = ex2(-dl); \
            m_run += dl; l_run *= alpha; \
            _Pragma("unroll") for (int dv = 0; dv < NDV; ++dv) _Pragma("unroll") for (int i = 0; i < 16; ++i) o[dv][i] *= alpha; \
            { const float _nm = -m_run; _Pragma("unroll") for (int i = 0; i < 16; ++i) negm[i] = _nm; } } \
    } while (0)
    AT_LOAD(0); AT_WRITE(0);
    __syncthreads();
    for (int t = 0; t < NT; t += 2) {
        AT_LOAD(t + 1);
        AT_TILE(t, 0);
        AT_WRITE(BUFB);
        __syncthreads();
        if (t + 2 < NT) AT_LOAD(t + 2);
        AT_TILE(t + 1, BUFB);
        if (t + 2 < NT) AT_WRITE(0);
        __syncthreads();
    }
#undef AT_LOAD
#undef AT_WRITE
#undef AT_TILE
#undef AT_VLD
#undef AT_PVG
}

__device__ __forceinline__ void mixB_unit(LAS unsigned char* lds, int ub, const bf16* QB, bf16* OB, const float* gdiff, float lam, float lam_init) {
    int tid_l = threadIdx.x; asm volatile("" : "+v"(tid_l));
    const int tid = tid_l, lane = tid & 63, r32 = lane & 31, hi = lane >> 5, wid = __builtin_amdgcn_readfirstlane(tid >> 6), s = wid >> 2, qs = wid & 3;
    int b, h, qrow0, nt0, nt1; const bf16 *kv0, *kv1;
    if (ub < 1024) { b = ub >> 7; h = (ub >> 5) & 3; const int qb = ub & 31; qrow0 = b * 4096 + qb * 128; kv0 = QB + (size_t)(b * 4096) * LDB_; nt0 = 64; kv1 = QB + (size_t)(ML + b * 256) * LDB_; nt1 = 4; }
    else { const int uc = ub - 1024; b = uc >> 3; h = (uc >> 1) & 3; const int qb = uc & 1; qrow0 = ML + b * 256 + qb * 128; kv0 = QB + (size_t)(ML + b * 256) * LDB_; nt0 = 4; kv1 = kv0; nt1 = 0; }
    const int qrow = qrow0 + 32 * qs + r32;
    const bf16* qptr = QB + (size_t)qrow * LDB_ + (2 * h + s) * 64 + 8 * hi;
    float m_run = 0.f, l_run = 0.f; f32x16 o[4];
#pragma unroll
    for (int dv = 0; dv < 4; ++dv)
#pragma unroll
        for (int i = 0; i < 16; ++i) o[dv][i] = 0.f;
    attn_core<128, true>(lds, qptr, kv0, nt0, kv1, nt1, LDB_, 512 + 128 * h, 1024 + 128 * h, s, false, 0, 0, 0, m_run, l_run, o);
    const float inv = 1.f / (l_run + __shfl_xor(l_run, 32));
    LAS float* X = (LAS float*)(lds + 65536);
    if (s == 1) {
#pragma unroll
        for (int dv = 0; dv < 4; ++dv)
#pragma unroll
            for (int i = 0; i < 16; ++i) X[(qs * 64 + dv * 16 + i) * 64 + lane] = o[dv][i] * inv;
    }
    __syncthreads();
    if (s == 0) {
        float ss = 0.f;
#pragma unroll
        for (int dv = 0; dv < 4; ++dv)
#pragma unroll
            for (int i = 0; i < 16; ++i) { const float d = o[dv][i] * inv - lam * X[(qs * 64 + dv * 16 + i) * 64 + lane]; o[dv][i] = d; ss += d * d; }
        ss += __shfl_xor(ss, 32);
        const float rs = __builtin_amdgcn_rsqf(ss * (1.f / 128.f) + EPS) * (1.f - lam_init);
        bf16* op = OB + (size_t)qrow * 512 + h * 128;
        f32x4 gd[4][4];
#pragma unroll
        for (int dv = 0; dv < 4; ++dv)
#pragma unroll
            for (int i4 = 0; i4 < 4; ++i4) gd[dv][i4] = *(const f32x4*)(gdiff + 32 * dv + 8 * i4 + 4 * hi);
#pragma unroll
        for (int dv = 0; dv < 4; ++dv)
#pragma unroll
            for (int i4 = 0; i4 < 4; ++i4) { const int e0 = 32 * dv + 8 * i4 + 4 * hi; const f32x4 g = gd[dv][i4];
                u32x2 w; w.x = pk2(o[dv][4 * i4] * rs * g[0], o[dv][4 * i4 + 1] * rs * g[1]); w.y = pk2(o[dv][4 * i4 + 2] * rs * g[2], o[dv][4 * i4 + 3] * rs * g[3]);
                *(u32x2*)(op + e0) = w; }
    }
    __syncthreads();
}

__device__ __forceinline__ void mixA_unit(LAS unsigned char* lds, int ua, const bf16* QA, bf16* OA, const float* sink) {
    int tid_l = threadIdx.x; asm volatile("" : "+v"(tid_l));
    const int tid = tid_l, lane = tid & 63, r32 = lane & 31, hi = lane >> 5, wid = __builtin_amdgcn_readfirstlane(tid >> 6), qs = wid & 3;
    int b, qb, kvh, pair, qrow0, nt0, nt1, kpos0; const bf16 *kv0, *kv1; bool domask;
    if (ua < 1024) { b = ua >> 7; qb = (ua >> 2) & 31; kvh = (ua >> 1) & 1; pair = ua & 1; qrow0 = b * 4096 + qb * 128;
        const int ks = qb * 128 - 128 < 0 ? 0 : qb * 128 - 128, ke = qb * 128 + 256 > SEQ ? SEQ : qb * 128 + 256;
        kpos0 = ks; nt0 = (ke - ks) >> 6; kv0 = QA + (size_t)(b * 4096 + ks) * LDA_; kv1 = QA + (size_t)(ML + b * 256) * LDA_; nt1 = 4; domask = true; }
    else { const int uc = ua - 1024; b = uc >> 3; qb = (uc >> 2) & 1; kvh = (uc >> 1) & 1; pair = uc & 1; qrow0 = ML + b * 256 + qb * 128;
        kpos0 = 0; nt0 = 4; kv0 = QA + (size_t)(ML + b * 256) * LDA_; kv1 = kv0; nt1 = 0; domask = false; }
    const int head = 4 * kvh + 2 * pair + (wid >> 2);
    const int qrow = qrow0 + 32 * qs + r32;
    const bf16* qptr = QA + (size_t)qrow * LDA_ + head * 64 + 8 * hi;
    float m_run = sink[head] * LOG2E, l_run = hi == 0 ? 1.f : 0.f; f32x16 o[2];
#pragma unroll
    for (int dv = 0; dv < 2; ++dv)
#pragma unroll
        for (int i = 0; i < 16; ++i) o[dv][i] = 0.f;
    attn_core<64, false>(lds, qptr, kv0, nt0, kv1, nt1, LDA_, 512 + 64 * kvh, 640 + 64 * kvh, 0, domask, qb * 128 + 32 * qs + r32, qb * 128 + 32 * qs, kpos0, m_run, l_run, o);
    const float inv = 1.f / (l_run + __shfl_xor(l_run, 32));
    bf16* op = OA + (size_t)qrow * 512 + head * 64;
#pragma unroll
    for (int dv = 0; dv < 2; ++dv)
#pragma unroll
        for (int i4 = 0; i4 < 4; ++i4) { const int e0 = 32 * dv + 8 * i4 + 4 * hi;
            u32x2 w; w.x = pk2(o[dv][4 * i4] * inv, o[dv][4 * i4 + 1] * inv); w.y = pk2(o[dv][4 * i4 + 2] * inv, o[dv][4 * i4 + 3] * inv);
            *(u32x2*)(op + e0) = w; }
}

constexpr int ML_QI = 0, ML_KI = 34816, ML_VI = 67584, ML_CI = 100352, ML_VEC = 135168;
__device__ __forceinline__ void mlstm_unit(LAS unsigned char* lds, int unit, const bf16* QC, const float* CG, const float* bgate, bf16* HF, bf16* HB, bool need_ctx) {
    int tid_l = threadIdx.x; asm volatile("" : "+v"(tid_l));
    const int wid = __builtin_amdgcn_readfirstlane(tid_l >> 6);
    const int b = unit >> 3, h = (unit >> 1) & 3, dir = unit & 1;
    bf16* Hout = dir ? HB : HF;
    const int gi_col = 8 * dir + h, gf_col = 8 * dir + 4 + h;
    const float bi = bgate[gi_col], bfb = bgate[gf_col];
    LAS float* cvec = (LAS float*)(lds + ML_VEC);
    LAS float* rvec = cvec + 128;
    LAS float* avec = cvec + 256;
    LAS float* evec = cvec + 384;
    LAS float* nvec = cvec + 512;
    for (int i = tid_l; i < 34816 / 4; i += 512) ((LAS unsigned*)(lds + ML_CI))[i] = 0u;
    if (tid_l < 128) nvec[tid_l] = 0.f;
    f32x16 Cst[2];
#pragma unroll
    for (int et = 0; et < 2; ++et)
#pragma unroll
        for (int i = 0; i < 16; ++i) Cst[et][i] = 0.f;
    float m_st = 0.f;
    for (int step = 0; step < 34; ++step) {
        asm volatile("" : "+v"(tid_l));
        const int tid = tid_l, lane = tid & 63, r32 = lane & 31, hi = lane >> 5;
        const int q4 = (lane & 15) >> 2, p4 = lane & 3, g1 = (lane >> 4) & 1;
        int base;
        if (step < 2) { const int cj = dir ? 1 - step : step; base = ML + b * 256 + 128 * cj; }
        else { const int lj = step - 2; const int cj = dir ? 31 - lj : lj; base = b * 4096 + 128 * cj; }
        u32x4 st[12];
        {
            const int tau = (tid >> 4), ch = tid & 15;
#pragma unroll
            for (int p = 0; p < 12; ++p) { const int tt = (p & 3) * 32 + tau; const int gr = base + (dir ? 127 - tt : tt);
                st[p] = *(const u32x4*)(QC + (size_t)gr * LDC_ + (p >> 2) * 512 + h * 128 + ch * 8); }
        }
        float decay_r, factor_r;
        {
            const int t0 = lane, t1 = lane + 64;
            const int gr0 = base + (dir ? 127 - t0 : t0), gr1 = base + (dir ? 127 - t1 : t1);
            const float gi0 = CG[(size_t)gr0 * 16 + gi_col] + bi, gf0 = CG[(size_t)gr0 * 16 + gf_col] + bfb;
            const float gi1 = CG[(size_t)gr1 * 16 + gi_col] + bi, gf1 = CG[(size_t)gr1 * 16 + gf_col] + bfb;
            const float f0 = fminf(gf0, 0.f) - __logf(1.f + __expf(-fabsf(gf0))), f1 = fminf(gf1, 0.f) - __logf(1.f + __expf(-fabsf(gf1)));
            float s0 = f0, s1 = f1;
#pragma unroll
            for (int o = 1; o < 64; o <<= 1) { const float a = __shfl_up(s0, o), c = __shfl_up(s1, o); if (lane >= o) { s0 += a; s1 += c; } }
            s1 += __shfl(s0, 63);
            const float blast = __shfl(s1, 63);
            const float a0 = gi0 - s0, a1 = gi1 - s1;
            float pm0 = a0, pm1 = a1;
#pragma unroll
            for (int o = 1; o < 64; o <<= 1) { const float a = __shfl_up(pm0, o), c = __shfl_up(pm1, o); if (lane >= o) { pm0 = fmaxf(pm0, a); pm1 = fmaxf(pm1, c); } }
            pm1 = fmaxf(pm1, __shfl(pm0, 63));
            const float A0 = __shfl(pm1, 63);
            const float M0 = fmaxf(m_st, pm0), M1 = fmaxf(m_st, pm1);
            if (wid == 0) {
                cvec[t0] = __expf(a0 - A0); cvec[t1] = __expf(a1 - A0);
                rvec[t0] = __expf(A0 - M0); rvec[t1] = __expf(A0 - M1);
                avec[t0] = __expf(m_st - M0); avec[t1] = __expf(m_st - M1);
                evec[t0] = __expf(-s0 - M0); evec[t1] = __expf(-s1 - M1);
            }
            const float Ml = fmaxf(m_st, A0);
            decay_r = __expf(m_st - Ml); factor_r = __expf(A0 - Ml);
            m_st = blast + Ml;
        }
        __syncthreads();
        {
            const int tau = (tid >> 4), ch = tid & 15;
#pragma unroll
            for (int p = 0; p < 12; ++p) { const int tt = (p & 3) * 32 + tau;
                if (p < 4) *(LAS u32x4*)(lds + ML_QI + tt * 272 + ch * 16) = st[p];
                else if (p < 8) { const float c = cvec[tt]; u32x4 v = st[p];
                    v.x = pk2(bflo(v.x) * c, bfhi(v.x) * c); v.y = pk2(bflo(v.y) * c, bfhi(v.y) * c); v.z = pk2(bflo(v.z) * c, bfhi(v.z) * c); v.w = pk2(bflo(v.w) * c, bfhi(v.w) * c);
                    *(LAS u32x4*)(lds + ML_KI + offb(tt, ch)) = v; }
                else *(LAS u32x4*)(lds + ML_VI + offb(tt, ch)) = st[p]; }
        }
        __syncthreads();
        {
            const int tb = wid & 3, eh = wid >> 2, t = 32 * tb + r32;
            const float rr = rvec[t], aa = avec[t], em = evec[t];
            bf16x8 qf[8];
#pragma unroll
            for (int d0 = 0; d0 < 8; ++d0) qf[d0] = *(const LAS bf16x8*)(lds + ML_QI + t * 272 + (16 * d0 + 8 * hi) * 2);
            f32x16 hh2[2]; float den1 = 0.f;
#pragma unroll
            for (int et = 0; et < 2; ++et) {
#pragma unroll
                for (int i = 0; i < 16; ++i) hh2[et][i] = 0.f;
#pragma unroll
                for (int d0 = 0; d0 < 8; ++d0) { const bf16x8 cf = *(const LAS bf16x8*)(lds + ML_CI + (32 * (2 * eh + et) + r32) * 272 + (16 * d0 + 8 * hi) * 2);
                    hh2[et] = __builtin_amdgcn_mfma_f32_32x32x16_bf16(cf, qf[d0], hh2[et], 0, 0, 0); }
#pragma unroll
                for (int i = 0; i < 16; ++i) hh2[et][i] *= aa;
            }
            float den2 = 0.f;
#pragma unroll
            for (int d0 = 0; d0 < 8; ++d0) { const f32x4 n0 = *(const LAS f32x4*)(nvec + 16 * d0 + 8 * hi), n1 = *(const LAS f32x4*)(nvec + 16 * d0 + 8 * hi + 4);
                const u32x4 qq = __builtin_bit_cast(u32x4, qf[d0]);
                den2 += bflo(qq.x) * n0[0] + bfhi(qq.x) * n0[1] + bflo(qq.y) * n0[2] + bfhi(qq.y) * n0[3] + bflo(qq.z) * n1[0] + bfhi(qq.z) * n1[1] + bflo(qq.w) * n1[2] + bfhi(qq.w) * n1[3]; }
            for (int sb = 0; sb <= tb; ++sb) {
                f32x16 g;
#pragma unroll
                for (int i = 0; i < 16; ++i) g[i] = 0.f;
#pragma unroll
                for (int d0 = 0; d0 < 8; ++d0) { const bf16x8 kf = *(const LAS bf16x8*)(lds + ML_KI + offb(32 * sb + r32, 2 * d0 + hi)); g = __builtin_amdgcn_mfma_f32_32x32x16_bf16(kf, qf[d0], g, 0, 0, 0); }
                if (sb == tb) {
#pragma unroll
                    for (int i = 0; i < 16; ++i) if (crow(i, hi) > r32) g[i] = 0.f; }
#pragma unroll
                for (int i = 0; i < 16; ++i) { g[i] *= rr; den1 += g[i]; }
#pragma unroll
                for (int ks = 0; ks < 2; ++ks) {
                    u32x4 pw; pw.x = pk2(g[8 * ks], g[8 * ks + 1]); pw.y = pk2(g[8 * ks + 2], g[8 * ks + 3]); pw.z = pk2(g[8 * ks + 4], g[8 * ks + 5]); pw.w = pk2(g[8 * ks + 6], g[8 * ks + 7]);
                    const bf16x8 pf = __builtin_bit_cast(bf16x8, pw);
                    const int krow = 32 * sb + 16 * ks + 4 * hi + q4;
#pragma unroll
                    for (int et = 0; et < 2; ++et) { const int ch = 4 * (2 * eh + et) + 2 * g1 + (p4 >> 1);
                        const s16x4 lo = trrd(lds + ML_VI + offb(krow, ch) + 8 * (p4 & 1)), hh = trrd(lds + ML_VI + offb(krow + 8, ch) + 8 * (p4 & 1));
                        hh2[et] = __builtin_amdgcn_mfma_f32_32x32x16_bf16(cat8(lo, hh), pf, hh2[et], 0, 0, 0); }
                }
            }
            den1 += __shfl_xor(den1, 32); den2 += __shfl_xor(den2, 32);
            const float den = den1 + aa * den2; const float inv = 1.f / fmaxf(fabsf(den), em);
            if (need_ctx || step >= 2) {
                const int gr = base + (dir ? 127 - t : t);
                bf16* op = Hout + (size_t)gr * 512 + h * 128;
#pragma unroll
                for (int et = 0; et < 2; ++et)
#pragma unroll
                    for (int i4 = 0; i4 < 4; ++i4) { const int e0 = 32 * (2 * eh + et) + 8 * i4 + 4 * hi;
                        u32x2 w; w.x = pk2(hh2[et][4 * i4] * inv, hh2[et][4 * i4 + 1] * inv); w.y = pk2(hh2[et][4 * i4 + 2] * inv, hh2[et][4 * i4 + 3] * inv);
                        *(u32x2*)(op + e0) = w; }
            }
        }
        __syncthreads();
        {
            const int db = wid & 3, eg = wid >> 2;
            f32x16 cl[2]; float nl = 0.f;
#pragma unroll
            for (int et = 0; et < 2; ++et)
#pragma unroll
                for (int i = 0; i < 16; ++i) cl[et][i] = 0.f;
#pragma unroll 2
            for (int ks = 0; ks < 8; ++ks) {
                const int trow = 16 * ks + 8 * hi + q4;
                const int chk = 4 * db + 2 * g1 + (p4 >> 1);
                const s16x4 klo = trrd(lds + ML_KI + offb(trow, chk) + 8 * (p4 & 1)), khi = trrd(lds + ML_KI + offb(trow + 4, chk) + 8 * (p4 & 1));
                const bf16x8 kT = cat8(klo, khi);
                const u32x4 kk = __builtin_bit_cast(u32x4, kT);
                nl += bflo(kk.x) + bfhi(kk.x) + bflo(kk.y) + bfhi(kk.y) + bflo(kk.z) + bfhi(kk.z) + bflo(kk.w) + bfhi(kk.w);
#pragma unroll
                for (int et = 0; et < 2; ++et) { const int chv = 4 * (2 * eg + et) + 2 * g1 + (p4 >> 1);
                    const s16x4 vlo = trrd(lds + ML_VI + offb(trow, chv) + 8 * (p4 & 1)), vhi = trrd(lds + ML_VI + offb(trow + 4, chv) + 8 * (p4 & 1));
                    cl[et] = __builtin_amdgcn_mfma_f32_32x32x16_bf16(kT, cat8(vlo, vhi), cl[et], 0, 0, 0); }
            }
            nl += __shfl_xor(nl, 32);
            const float decay = decay_r, factor = factor_r;
#pragma unroll
            for (int et = 0; et < 2; ++et) {
#pragma unroll
                for (int i = 0; i < 16; ++i) Cst[et][i] = decay * Cst[et][i] + factor * cl[et][i];
                const int e = 32 * (2 * eg + et) + r32;
#pragma unroll
                for (int i4 = 0; i4 < 4; ++i4) { u32x2 w; w.x = pk2(Cst[et][4 * i4], Cst[et][4 * i4 + 1]); w.y = pk2(Cst[et][4 * i4 + 2], Cst[et][4 * i4 + 3]);
                    *(LAS u32x2*)(lds + ML_CI + e * 272 + (32 * db + 8 * i4 + 4 * hi) * 2) = w; }
            }
            if (eg == 0 && hi == 0) nvec[32 * db + r32] = decay * nvec[32 * db + r32] + factor * nl;
        }
        __syncthreads();
    }
}

__device__ __forceinline__ void load_row(const float* p, int lane, f32x4 (&v)[4]) {
#pragma unroll
    for (int j = 0; j < 4; ++j) v[j] = *(const f32x4*)(p + 4 * lane + 256 * j);
}
__device__ __forceinline__ float row_rstd(const f32x4 (&v)[4]) {
    float s = 0.f;
#pragma unroll
    for (int j = 0; j < 4; ++j) s += v[j][0] * v[j][0] + v[j][1] * v[j][1] + v[j][2] * v[j][2] + v[j][3] * v[j][3];
    return __builtin_amdgcn_rsqf(wave_sum(s) * (1.f / D) + EPS);
}
__device__ __forceinline__ void norm_mod_store(const f32x4 (&v)[4], const float* g, const float* shift, const float* scale, bf16* out, fp8* out8, int lane) {
    const float rs = row_rstd(v);
    f32x4 gg4[4], sh4[4], sc4[4];
#pragma unroll
    for (int j = 0; j < 4; ++j) { const int c = 4 * lane + 256 * j; gg4[j] = *(const f32x4*)(g + c); sh4[j] = *(const f32x4*)(shift + c); sc4[j] = *(const f32x4*)(scale + c); }
#pragma unroll
    for (int j = 0; j < 4; ++j) { const int c = 4 * lane + 256 * j; const f32x4 gg = gg4[j], sh = sh4[j], sc = sc4[j];
        const f32x4 y = (v[j] * rs * gg) * (sc + 1.f) + sh;
        u32x2 w; w.x = pk2(y[0], y[1]); w.y = pk2(y[2], y[3]); *(u32x2*)(out + c) = w;
        *(unsigned*)(out8 + c) = pk4_fp8(y * 8.f); }
}

template <class MapF>
__device__ __forceinline__ void wt_item(const MapF& mf, int K, int src_ld, bf16* dst, int item, int nblk, LAS float* scr, int lane) {
    const float* dummy = mf.base();
    const int kb = item / nblk, nb = item % nblk, k0 = 64 * kb, n0 = 32 * nb;
    const float* sp; float sc; mf(n0 + (lane & 31), sp, sc);
    if (!sp) { sp = dummy; sc = 0.f; }
    float tv[32];
#pragma unroll
    for (int i = 0; i < 32; ++i) tv[i] = sp[(size_t)(k0 + 2 * i + (lane >> 5)) * src_ld];
#pragma unroll
    for (int i = 0; i < 32; ++i) { const int kk = 2 * i + (lane >> 5); scr[kk * 33 + (lane & 31)] = tv[i] * sc; }
    LDS_WAIT(); asm volatile("" ::: "memory");
    const int c = lane & 7;
#pragma unroll
    for (int j = 0; j < 4; ++j) { const int n = (lane >> 3) + 8 * j; const LAS float* s = scr + (8 * c) * 33 + n;
        u32x4 o; o.x = pk2(s[0 * 33], s[1 * 33]); o.y = pk2(s[2 * 33], s[3 * 33]); o.z = pk2(s[4 * 33], s[5 * 33]); o.w = pk2(s[6 * 33], s[7 * 33]);
        *(u32x4*)(dst + (size_t)(n0 + n) * K + k0 + 8 * c) = o; }
    LDS_WAIT(); asm volatile("" ::: "memory");
}
template <class MapF>
__device__ __forceinline__ void wt_item8(const MapF& mf, int K, int src_ld, fp8* dst, int item, int nblk, float scale, LAS float* scr, int lane) {
    const float* dummy = mf.base();
    const int kb = item / nblk, nb = item % nblk, k0 = 64 * kb, n0 = 32 * nb;
    const float* sp; float sc; mf(n0 + (lane & 31), sp, sc); sc *= scale;
    if (!sp) { sp = dummy; sc = 0.f; }
    float tv[32];
#pragma unroll
    for (int i = 0; i < 32; ++i) tv[i] = sp[(size_t)(k0 + 2 * i + (lane >> 5)) * src_ld];
#pragma unroll
    for (int i = 0; i < 32; ++i) { const int kk = 2 * i + (lane >> 5); scr[kk * 33 + (lane & 31)] = tv[i] * sc; }
    LDS_WAIT(); asm volatile("" ::: "memory");
    const int c = lane & 7;
#pragma unroll
    for (int j = 0; j < 4; ++j) { const int n = (lane >> 3) + 8 * j; const LAS float* s = scr + (8 * c) * 33 + n;
        u32x2 o; o.x = pk4_fp8((f32x4){s[0 * 33], s[1 * 33], s[2 * 33], s[3 * 33]}); o.y = pk4_fp8((f32x4){s[4 * 33], s[5 * 33], s[6 * 33], s[7 * 33]});
        *(u32x2*)(dst + (size_t)(n0 + n) * K + k0 + 8 * c) = o; }
    LDS_WAIT(); asm volatile("" ::: "memory");
}
__device__ __forceinline__ int permd(int p) { const int i = p >> 3, w = p & 7; return (i < 4 ? 0 : 32) + (w < 4 ? 0 : 16) + 4 * (i & 3) + (w & 3); }
struct MapWin { const float* w;
    __device__ __forceinline__ const float* base() const { return w; }
    __device__ __forceinline__ void operator()(int n, const float*& sp, float& sc) const {
        if (n >= 4368) { sp = nullptr; sc = 0.f; return; }
        int col = n; sc = 1.f;
        if (n < 640 || (n >= 768 && n < 1792)) col = (n & ~63) + permd(n & 63);
        if (n < 512 || (n >= 768 && n < 1280)) sc = 0.125f * LOG2E;
        if (n >= 2816 && n < 3328) sc = 0.08838834764831845f;
        sp = w + col; } };
struct MapLin { const float* w; int off, nvalid;
    __device__ __forceinline__ const float* base() const { return w; }
    __device__ __forceinline__ void operator()(int n, const float*& sp, float& sc) const { sc = 1.f; sp = n < nvalid ? w + off + n : nullptr; } };
struct MapGU { const float* g; long du;
    __device__ __forceinline__ const float* base() const { return g; }
    __device__ __forceinline__ void operator()(int n, const float*& sp, float& sc) const { const int i = n >> 3, w = n & 7, j = 4 * i + (w & 3); sc = w < 4 ? -LOG2E : -4.f / LOG2E; sp = g + (j + (w < 4 ? 0l : du)); } };

__global__ void __launch_bounds__(512, 2) fwd_kernel(Args args) {
    extern __shared__ __attribute__((aligned(16))) unsigned char lds_raw[];
    LAS unsigned char* lds = (LAS unsigned char*)lds_raw;
    const int G = gridDim.x, bx = blockIdx.x, NGW = G * 8;
    GAS unsigned char* const ws0 = args.ws;
    unsigned* ctl = (unsigned*)(ws0 + WS_CTL);
#define PH_BEGIN int tid_p = threadIdx.x; asm volatile("" : "+v"(tid_p)); const int tid = tid_p, lane = tid & 63, wid = __builtin_amdgcn_readfirstlane(tid >> 6), gw = bx * 8 + wid; \
    GAS unsigned char* ws = ws0; asm volatile("" : "+s"(ws)); (void)lane; (void)gw;
    volatile LAS unsigned* MISC = (volatile LAS unsigned*)(lds + LDS_MISC);
    LAS int* tab = (LAS int*)(lds + LDS_TAB);
    if (threadIdx.x < 32) MISC[threadIdx.x] = 0u;
    __syncthreads();
#if ONE_LAUNCH
    XcdBarrier bar = xcd_barrier_post(ctl + CW_BAR, MISC + 8);
#define GRID_BAR() xcd_barrier(bar)
#else
#define GRID_BAR() do {} while (0)
#endif
    const int lo = args.lo, hi_ = args.hi;
#define IN(k) (lo <= (k) && (k) < hi_)
    CArgsP akp = (CArgsP)__builtin_amdgcn_kernarg_segment_ptr();
#define AIN(i) ((const float*)(launder_args(akp)->in[i]))
    unsigned long long pr_prev = 0ull, pr_acc = 0ull;
    if (PROBE_MASK) pr_prev = __builtin_amdgcn_s_memrealtime();
#define SEAM(k) do { if (IN(k) && IN((k) + 1)) GRID_BAR(); if (PROBE_MASK) { const unsigned long long _t = __builtin_amdgcn_s_memrealtime(); const int _b = (k) == 0 ? 16 : (((k) - 1) % NPH); \
        if ((PROBE_MASK >> _b) & 1) pr_acc += _t - pr_prev; pr_prev = _t; } } while (0)

#define x_in AIN(0)
#define c_in AIN(1)
#define ctx_in AIN(2)
#define cctx_in AIN(3)
#define mods ((float*)(ws + WS_MODS))
#define rope ((float*)(ws + WS_ROPE))
#define lamv ((float*)(ws + WS_LAM))
#define HL ((bf16*)(ws + WS_HL))
#define XS ((bf16*)(ws + WS_XS))
#define OUTF ((float*)(launder_args(akp)->out))
#define QA ((bf16*)(ws + WS_QA))
#define QB ((bf16*)(ws + WS_QB))
#define QC ((bf16*)(ws + WS_QC))
#define OA ((bf16*)(ws + WS_HL))
#define OB (((bf16*)(ws + WS_HL)) + (size_t)MA * 512)
#define HF ((bf16*)(ws + WS_HF))
#define HB ((bf16*)(ws + WS_HB))
#define GT ((unsigned char*)(launder_args(akp)->out))
#define Y ((bf16*)(ws + WS_Y))
#define CG ((float*)(ws + WS_CG))
#define LOG ((float*)(ws + WS_LOG))
#define TOKE ((int*)(ws + WS_TOKE))
#define TOKP ((int*)(ws + WS_TOKP))
#define ELIST ((int*)(ws + WS_ELIST))
#define WLIST ((float*)(ws + WS_WLIST))
#define TOKW ((float*)(ws + WS_LOG))
#define WIN ((bf16*)(ws + WS_WIN))
#define WIN8 ((fp8*)(ws + WS_WIN + 5 * MiB))
#define WGT ((fp8*)(ws + WS_WGT))
#define HL8 ((fp8*)(ws + WS_Y))
#define WA ((bf16*)(ws + WS_WA))
#define WB ((bf16*)(ws + WS_WB))
#define WC ((bf16*)(ws + WS_WC))
#define WO ((bf16*)(ws + WS_WO))
#define WR ((bf16*)(ws + WS_WR))
#define WGU ((fp8*)(ws + WS_WGU))
#define H8 ((fp8*)(ws + WS_HF))
#define WD ((fp8*)(ws + WS_WD))
#define A2 ((fp8*)(ws + WS_A2))
#define Y2 ((fp8*)(ws + WS_Y2))
    if (IN(0)) {
        PH_BEGIN
        LAS float* sc = (LAS float*)lds;
        for (int i = tid; i < 9 * 1024; i += 512) { const int b = i >> 10, k = i & 1023; const float cv = b < 8 ? c_in[b * 1024 + k] : cctx_in[k]; sc[i] = cv * sigm(cv); }
        __syncthreads();
        LAS float* red = sc + 9 * 1024;
        for (int unit = bx; unit < 192; unit += G) {
            const int l = unit / 96, n0 = (unit % 96) * 64, cl = tid & 63, ks = tid >> 6;
            float acc[9];
#pragma unroll
            for (int b = 0; b < 9; ++b) acc[b] = 0.f;
            const float* w = AIN(4) + (size_t)l * 1024 * 6144 + n0 + cl;
#pragma unroll 16
            for (int k = 128 * ks; k < 128 * ks + 128; ++k) { const float wv = w[(size_t)k * 6144];
#pragma unroll
                for (int b = 0; b < 9; ++b) acc[b] += sc[b * 1024 + k] * wv; }
#pragma unroll
            for (int b = 0; b < 9; ++b) red[(ks * 9 + b) * 64 + cl] = acc[b];
            __syncthreads();
            for (int i = tid; i < 9 * 64; i += 512) { const int b = i >> 6, c2 = i & 63; float s = 0.f;
#pragma unroll
                for (int k2 = 0; k2 < 8; ++k2) s += red[(k2 * 9 + b) * 64 + c2];
                mods[(size_t)(l * 9 + b) * 6144 + n0 + c2] = s + AIN(5)[l * 6144 + n0 + c2]; }
            __syncthreads();
        }
        if (bx == G - 1) {
            for (int i = tid; i < 1024; i += 512) { const int pos = i >> 4, j = i & 15; const float inv = ex2(-(float)j * (13.287712379549449f / 16.f)); const float ang = (float)pos * inv;
                rope[i] = __cosf(ang); rope[1024 + i] = __sinf(ang); }
            if (wid == 0) {
#pragma unroll
                for (int l = 0; l < 2; ++l) { const float a = wave_sum(AIN(11)[l * 64 + lane] * AIN(12)[l * 64 + lane]), b2 = wave_sum(AIN(13)[l * 64 + lane] * AIN(14)[l * 64 + lane]);
                    const float li = 0.8f - 0.6f * __expf(-0.3f * (float)l);
                    if (lane == 0) lamv[l] = __expf(a) - __expf(b2) + li; }
            }
        }
    }
    SEAM(0);

#define CONV_A(L_) do { \
            LAS float* scr = (LAS float*)(lds + wid * 8448); \
            const float* w_in = AIN(8) + (size_t)(L_) * 1024 * NIN; \
            for (int it = gw; it < 5248; it += NGW) { \
                int r = it; \
                if (r < 2304) { MapWin mf{w_in}; const int nb = r % 144; \
                    if (nb < 56) wt_item(mf, 1024, NIN, WIN, r, 144, scr, lane); \
                    else if (nb < 136) wt_item8(mf, 1024, NIN, WIN8 - (size_t)1792 * 1024, r, 144, 64.f, scr, lane); \
                    else wt_item(mf, 1024, NIN, WIN - (size_t)(4352 - 1792) * 1024, r, 144, scr, lane); \
                    continue; } r -= 2304; \
                if (r < 1536) { MapLin mf{w_in, 4368, 3072}; wt_item8(mf, 1024, NIN, WGT, r, 96, -64.f * LOG2E, scr, lane); continue; } r -= 1536; \
                if (r < 768) { const int which = r >> 8; const float* src = AIN(17 + which) + (size_t)(L_) * 512 * 1024; MapLin mf{src, 0, 1024}; \
                    wt_item(mf, 512, 1024, which == 0 ? WA : (which == 1 ? WB : WC), r & 255, 32, scr, lane); continue; } r -= 768; \
                if (r < 512) { MapLin mf{AIN(20) + (size_t)(L_) * 1024 * 1024, 0, 1024}; wt_item(mf, 1024, 1024, WO, r, 32, scr, lane); continue; } r -= 512; \
                { MapLin mf{AIN(21) + (size_t)(L_) * 1024 * 64, 0, 64}; wt_item(mf, 1024, 64, WR, r, 8, scr, lane); } \
            } \
            } while (0)
#define CONV_B(FIRST_, LAST_, W_, NW_) do { \
            LAS float* scr = (LAS float*)(lds + wid * 8448); \
            for (int it = (FIRST_) + (W_); it < (LAST_); it += (NW_)) { \
                if (it < 16640) { const int e = it >> 8, r = it & 255; \
                    const float* gsrc = e < 64 ? AIN(23) + (size_t)(layer * 64 + e) * 1024 * 256 : AIN(26) + (size_t)layer * 1024 * 256; \
                    const float* usrc = e < 64 ? AIN(24) + (size_t)(layer * 64 + e) * 1024 * 256 : AIN(27) + (size_t)layer * 1024 * 256; \
                    MapGU mf{gsrc, (long)(usrc - gsrc)}; wt_item8(mf, 1024, 256, WGU + (size_t)e * 512 * 1024, r, 16, 64.f, scr, lane); } \
                else { const int r2 = it - 16640, e = r2 >> 7, r = r2 & 127; \
                    const float* src = e < 64 ? AIN(25) + (size_t)(layer * 64 + e) * 256 * 1024 : AIN(28) + (size_t)layer * 256 * 1024; \
                    MapLin mf{src, 0, 1024}; wt_item8(mf, 256, 1024, WD + (size_t)e * 1024 * 256, r, 32, 32.f, scr, lane); } \
            } } while (0)
    for (int layer = 0; layer < 2; ++layer) {
        const int P0 = 1 + layer * NPH;
        const bool need_ctx = layer == 0;
        const int n6items = (need_ctx && G == 256) ? 10240 : 0;
        const int Mx = need_ctx ? MA : ML;
        const int Mh = Mx / 2;
#define modl (mods + (size_t)layer * 9 * 6144)
        const float lam_init = 0.8f - 0.6f * __expf(-0.3f * (float)layer);

        if (IN(P0 + 0) && layer == 0) {
            PH_BEGIN
            CONV_A(0);
            if (layer == 0) {
                for (int m = gw; m < MA; m += NGW) {
                    const float* xr = m < ML ? x_in + (size_t)m * D : ctx_in + (size_t)(m - ML) * D;
                    const float* mv = modl + (m < ML ? (m >> 12) : 8) * 6144;
                    f32x4 v[4]; load_row(xr, lane, v);
                    norm_mod_store(v, AIN(6) + layer * D, mv, mv + 1024, HL + (size_t)m * D, HL8 + (size_t)m * D, lane);
                }
            }
        }
        if (layer == 0) SEAM(P0 + 0);

        if (IN(P0 + 1)) {
            PH_BEGIN
            for (int rep = 0; rep < REP_G1; ++rep) {
            { pg8::DenseSched S; S.init(HL, WIN, MA, 2048, 1024, G, bx);
              EpiG1 E{QA, QB, QC, CG, rope, 0};
              pg8::gemm_phase(lds, 1024, S, E); }
            { const int rot = ((MA / 256 * 8) % G) & ~7;
              pg8::DenseSched S; S.init(HL8, WIN8, MA, 2560, 512, G, (bx - rot + G) % G);
              if (rot > 0 && rot < G) { S.isplit = (S.nwg - (G - rot)) / G; if (S.isplit < 1) S.isplit = 1; S.G2 = G - rot; }
              EpiG1 E{QA, QB, QC, CG, rope, 1};
              pg8::gemm_phase<EpiG1, pg8::DenseSched, true, 0x7C7C7C7C, 0x79797979>(lds, 512, S, E); }
            {
              const int rot3 = G == 256 ? 208 : 0;
              pg8::DenseSched S; S.init(HL8, WGT, Mx, NGT, 512, G, (bx - rot3 + G) % G);
              EpiSig8 E{GT, NGT};
              pg8::gemm_phase<EpiSig8, pg8::DenseSched, true, 0x7C7C7C7C, 0x79797979>(lds, 512, S, E); } }
        }
        SEAM(P0 + 1);

        if (IN(P0 + 2)) {
            PH_BEGIN
            for (int rep = 0; rep < REP_C; ++rep) {
            unsigned* wq = ctl + CW_WQ + 64 * ((layer * 2 + rep) * 4);
            for (;;) {
                if (tid == 0) MISC[0] = atomicAdd(wq, 1u);
                __syncthreads();
                const int u = (int)MISC[0];
                __syncthreads();
                if (u >= 64) break;
                mlstm_unit(lds, u, QC, CG, AIN(9) + layer * 16, HF, HB, need_ctx);
            } }
            const int nB = need_ctx ? 1088 : 1024;
            const float lam = lamv[layer];
            for (int rep = 0; rep < REP_B; ++rep) {
            unsigned* wq = ctl + CW_WQ + 64 * ((layer * 2 + rep) * 4);
            for (;;) {
                if (tid == 0) MISC[0] = atomicAdd(wq + 64, 1u);
                __syncthreads();
                const int u = (int)MISC[0];
                __syncthreads();
                if (u >= nB) break;
                mixB_unit(lds, u, QB, OB, AIN(15) + layer * 128, lam, lam_init);
            } }
            for (int rep = 0; rep < REP_A; ++rep) {
            unsigned* wq = ctl + CW_WQ + 64 * ((layer * 2 + rep) * 4);
            for (;;) {
                if (tid == 0) MISC[0] = atomicAdd(wq + 128, 1u);
                __syncthreads();
                const int u = (int)MISC[0];
                __syncthreads();
                if (u >= nB) break;
                mixA_unit(lds, u, QA, OA, AIN(10) + layer * 8);
                __syncthreads();
            } }
        }
        SEAM(P0 + 2);

        if (IN(P0 + 3)) {
            PH_BEGIN
            {
            const float* gm = AIN(16) + layer * 512;
            for (int m = gw; m < Mx; m += NGW) {
                const u32x4 a = *(const u32x4*)(HF + (size_t)m * 512 + 8 * lane), b = *(const u32x4*)(HB + (size_t)m * 512 + 8 * lane);
                const u32x4 co = *(const u32x4*)(QC + (size_t)m * LDC_ + 1536 + 8 * lane);
                float v[8];
                v[0] = bflo(a.x) + bflo(b.x); v[1] = bfhi(a.x) + bfhi(b.x); v[2] = bflo(a.y) + bflo(b.y); v[3] = bfhi(a.y) + bfhi(b.y);
                v[4] = bflo(a.z) + bflo(b.z); v[5] = bfhi(a.z) + bfhi(b.z); v[6] = bflo(a.w) + bflo(b.w); v[7] = bfhi(a.w) + bfhi(b.w);
                float ss = 0.f;
#pragma unroll
                for (int k = 0; k < 8; ++k) ss += v[k] * v[k];
                ss += __shfl_xor(ss, 1); ss += __shfl_xor(ss, 2); ss += __shfl_xor(ss, 4); ss += __shfl_xor(ss, 8);
                const float rs = __builtin_amdgcn_rsqf(ss * (1.f / 128.f) + EPS);
                const f32x4 g0 = *(const f32x4*)(gm + 8 * lane), g1v = *(const f32x4*)(gm + 8 * lane + 4);
                u32x4 w;
                w.x = pk2(v[0] * rs * g0[0] * sigm(bflo(co.x)), v[1] * rs * g0[1] * sigm(bfhi(co.x)));
                w.y = pk2(v[2] * rs * g0[2] * sigm(bflo(co.y)), v[3] * rs * g0[3] * sigm(bfhi(co.y)));
                w.z = pk2(v[4] * rs * g1v[0] * sigm(bflo(co.z)), v[5] * rs * g1v[1] * sigm(bfhi(co.z)));
                w.w = pk2(v[6] * rs * g1v[2] * sigm(bflo(co.w)), v[7] * rs * g1v[3] * sigm(bfhi(co.w)));
                *(u32x4*)(HF + (size_t)m * 512 + 8 * lane) = w;
            }
            }
        }
        SEAM(P0 + 3);

        if (IN(P0 + 4)) {
            PH_BEGIN
            pg8::Gate3Sched S; S.A = (const char*)OA; S.Bt = (const char*)WA; S.dA1 = (const char*)OB - (const char*)OA; S.dA2 = (const char*)HF - (const char*)OA;
            S.dB1 = (const char*)WB - (const char*)WA; S.dB2 = (const char*)WC - (const char*)WA; S.K = 512; S.nM = ML / 256; S.nN = 4; S.nwg = S.nM * 4; S.G = G; S.c = bx;
            EpiGate3 E{GT, Y, 0};
            pg8::gemm_phase(lds, 512, S, E);
        }
        SEAM(P0 + 4);

        if (IN(P0 + 5)) {
            PH_BEGIN
            const bool split = need_ctx;
            const int nA = (2 * (G - 32) < 512 ? 2 * (G - 32) : 512) & ~7;
            if (split && bx < 32) {
                pg8::Gate3Sched S; S.A = (const char*)(OA + (size_t)ML * 512); S.Bt = (const char*)WA; S.dA1 = (const char*)OB - (const char*)OA; S.dA2 = (const char*)HF - (const char*)OA;
                S.dB1 = (const char*)WB - (const char*)WA; S.dB2 = (const char*)WC - (const char*)WA; S.K = 512; S.nM = MC / 256; S.nN = 4; S.nwg = S.nM * 4; S.G = 32; S.c = bx;
                EpiGate3 E{GT, Y, ML};
                pg8::gemm_phase(lds, 512, S, E);
            } else {
                pg8::DenseSched S; S.init(Y, WO, ML, 1024, 1024, split ? G - 32 : G, split ? bx - 32 : bx);
                if (split) S.last = nA;
                EpiRes E{layer == 0 ? x_in : (const float*)nullptr, ctx_in, XS, modl + 2 * 1024, 0};
                pg8::gemm_phase(lds, 1024, S, E);
            }
        }
        SEAM(P0 + 5);

        if (IN(P0 + 6) && need_ctx) {
            PH_BEGIN
            const int nA = (2 * (G - 32) < 512 ? 2 * (G - 32) : 512) & ~7;
            {
                { pg8::DenseSched S; S.init(Y, WO, ML, 1024, 1024, G, bx); S.first = nA;
                  EpiRes E{x_in, ctx_in, XS, modl + 2 * 1024, 0};
                  pg8::gemm_phase(lds, 1024, S, E); }
                { pg8::DenseSched S; S.init(Y + (size_t)ML * 1024, WO, MC, 1024, 1024, G, (bx - 64 + G) % G);
                  EpiRes E{x_in, ctx_in, XS, modl + 2 * 1024, ML};
                  pg8::gemm_phase(lds, 1024, S, E); }
                if (n6items && bx >= 96) CONV_B(0, n6items, (bx - 96) * 8 + wid, (G - 96) * 8);
            }
        }
        if (need_ctx) SEAM(P0 + 6);

        if (IN(P0 + 7)) {
            PH_BEGIN
            const int tpb7 = (Mx + G - 1) / G, m07 = bx * tpb7, m17 = (m07 + tpb7 <= Mx) ? m07 + tpb7 : (Mx > m07 ? Mx : m07);
            for (int m = m07 + wid; m < m17; m += 8) {
                const bf16* xr = XS + (size_t)m * D;
                const float* mv = modl + (m < ML ? (m >> 12) : 8) * 6144;
                f32x4 v[4];
#pragma unroll
                for (int g2 = 0; g2 < 2; ++g2) { const u32x4 r = *(const u32x4*)(xr + g2 * 512 + 8 * lane);
                    v[2 * g2] = (f32x4){bflo(r.x), bfhi(r.x), bflo(r.y), bfhi(r.y)}; v[2 * g2 + 1] = (f32x4){bflo(r.z), bfhi(r.z), bflo(r.w), bfhi(r.w)}; }
                const float rs = row_rstd(v);
                f32x4 gg4[4], sh4[4], sc4[4];
#pragma unroll
                for (int j = 0; j < 4; ++j) { const int c = (j >> 1) * 512 + 8 * lane + 4 * (j & 1); gg4[j] = *(const f32x4*)(AIN(7) + layer * D + c); sh4[j] = *(const f32x4*)(mv + 3 * 1024 + c); sc4[j] = *(const f32x4*)(mv + 4 * 1024 + c); }
#pragma unroll
                for (int g2 = 0; g2 < 2; ++g2) { u32x4 w; u32x2 w8;
#pragma unroll
                    for (int q = 0; q < 2; ++q) { const f32x4 gg = gg4[2 * g2 + q], sh = sh4[2 * g2 + q], sc = sc4[2 * g2 + q];
                        const f32x4 y = (v[2 * g2 + q] * rs * gg) * (sc + 1.f) + sh;
                        if (q == 0) { w.x = pk2(y[0], y[1]); w.y = pk2(y[2], y[3]); w8.x = pk4_fp8(y * 8.f); } else { w.z = pk2(y[0], y[1]); w.w = pk2(y[2], y[3]); w8.y = pk4_fp8(y * 8.f); } }
                    *(u32x4*)(HL + (size_t)m * D + g2 * 512 + 8 * lane) = w;
                    *(u32x2*)(H8 + (size_t)m * D + g2 * 512 + 8 * lane) = w8; }
            }
            __threadfence_block();
            __syncthreads();
            {
            LAS int* lcnt = (LAS int*)lds; LAS int* lbase = lcnt + 128;
            LAS unsigned* st_e = (LAS unsigned*)(lds + 1024); LAS float* st_w = (LAS float*)(lds + 1024 + 8192);
            const int tpb = (Mx + G - 1) / G, m0 = bx * tpb, ntok = (m0 + tpb <= Mx) ? tpb : (Mx > m0 ? Mx - m0 : 0);
            if (tid < 128) lcnt[tid] = 0;
            LAS float* llog = (LAS float*)(lds + 32768);
            {
                const int r32 = lane & 31, hi = lane >> 5;
                const int tl = wid * 32 + r32, tlc = tl < ntok ? tl : (ntok > 0 ? ntok - 1 : 0);
                const bf16* hp = HL + (size_t)(m0 + tlc < Mx ? m0 + tlc : 0) * D + 8 * hi;
                LAS unsigned char* wl = lds + 69632;
                f32x16 c0, c1;
#pragma unroll
                for (int i = 0; i < 16; ++i) { c0[i] = 0.f; c1[i] = 0.f; }
#pragma unroll 1
                for (int kh = 0; kh < 2; ++kh) {
                    __syncthreads();
                    u32x4 wtmp[8];
#pragma unroll
                    for (int pp = 0; pp < 8; ++pp) { const int idx = tid + 512 * pp, row = idx >> 6, ch = idx & 63; wtmp[pp] = *(const u32x4*)(WR + (size_t)row * 1024 + kh * 512 + ch * 8); }
#pragma unroll
                    for (int pp = 0; pp < 8; ++pp) { const int idx = tid + 512 * pp, row = idx >> 6, ch = idx & 63; *(LAS u32x4*)(wl + row * 1040 + ch * 16) = wtmp[pp]; }
                    __syncthreads();
                    if (wid * 32 < ntok) {
#pragma unroll 1
                        for (int kb = 0; kb < 512; kb += 256) {
                            bf16x8 a[16];
#pragma unroll
                            for (int q = 0; q < 16; ++q) a[q] = *(const bf16x8*)(hp + kh * 512 + kb + 16 * q);
#pragma unroll
                            for (int q = 0; q < 16; ++q) { const LAS unsigned char* bp = wl + r32 * 1040 + (kb * 2) + (2 * q + hi) * 16;
                                const bf16x8 b0 = *(const LAS bf16x8*)bp, b1 = *(const LAS bf16x8*)(bp + 32 * 1040);
                                c0 = __builtin_amdgcn_mfma_f32_32x32x16_bf16(b0, a[q], c0, 0, 0, 0); c1 = __builtin_amdgcn_mfma_f32_32x32x16_bf16(b1, a[q], c1, 0, 0, 0); }
                        }
                    }
                }
                if (tl < ntok) {
#pragma unroll
                    for (int i = 0; i < 16; ++i) { llog[tl * 64 + crow(i, hi)] = c0[i]; llog[tl * 64 + 32 + crow(i, hi)] = c1[i]; }
                }
            }
            __syncthreads();
            const float* br = AIN(22) + layer * 64;
            const float bias = br[lane];
            for (int tl = wid; tl < ntok; tl += 8) {
                const int m = m0 + tl;
                const int half = m >= Mh ? 1 : 0;
                const float sg = sigm(llog[tl * 64 + lane]);
                const float sel = sg + bias;
                const float m1 = max8(sel);
                const unsigned long long bm = __ballot(sel == m1);
                const unsigned gmask = (unsigned)(bm >> (lane & 56)) & 0xffu;
                const int first = __builtin_ctz(gmask);
                float v2 = ((lane & 7) == first) ? -3.0e38f : sel;
                v2 = max8(v2);
                const float gsc = m1 + v2; const int g = lane >> 3;
                int gr = 0;
#pragma unroll
                for (int g2 = 0; g2 < 8; ++g2) { const float o = __int_as_float(__builtin_amdgcn_readlane(__float_as_int(gsc), 8 * g2)); gr += (o > gsc || (o == gsc && g2 < g)) ? 1 : 0; }
                const bool gsel = gr < 4;
                const float mv = gsel ? sel : -3.0e38f;
                const unsigned ub = (unsigned)__float_as_int(mv);
                const unsigned key = ((ub ^ ((ub >> 31) ? 0xFFFFFFFFu : 0x80000000u)) & ~63u) | (unsigned)(63 - lane);
                const unsigned long long gb = __ballot(gsel);
                unsigned rem = (unsigned)(((gb & 0x0101010101010101ull) * 0x0102040810204080ull) >> 56);
                int rank = 0;
#pragma unroll
                for (int sgi = 0; sgi < 4; ++sgi) { const int gi8 = 8 * __builtin_ctz(rem); rem &= rem - 1u;
#pragma unroll
                    for (int t8 = 0; t8 < 8; ++t8) { const unsigned ok = (unsigned)__builtin_amdgcn_readlane((int)key, gi8 + t8); rank += ok > key ? 1 : 0; }
                    asm volatile("" : "+v"(rank)); }
                const bool chosen = gsel && rank < 8;
                const float ssum = wave_sum_dpp(chosen ? sg : 0.f);
                if (chosen) {
                    const int lpos = __hip_atomic_fetch_add(lcnt + half * 64 + lane, 1, __ATOMIC_RELAXED, __HIP_MEMORY_SCOPE_WORKGROUP);
                    st_e[tl * 8 + rank] = (unsigned)lane | ((unsigned)lpos << 8); st_w[tl * 8 + rank] = sg / ssum * 2.5f;
                }
            }
            __syncthreads();
            if (tid < 128) { const int c = lcnt[tid]; lbase[tid] = c ? (int)atomicAdd(ctl + CW_CNT + 16 * ((layer * 2 + (tid >> 6)) * 64 + (tid & 63)), (unsigned)c) : 0; }
            __syncthreads();
            for (int idx = tid; idx < ntok * 8; idx += 512) {
                const int m = m0 + (idx >> 3), slot = idx & 7, half = m >= Mh ? 1 : 0;
                const unsigned v = st_e[idx]; const int e = (int)(v & 0xffu), pos = lbase[half * 64 + e] + (int)(v >> 8);
                ELIST[((size_t)half * 64 + e) * CAP + pos] = m; TOKW[(size_t)m * 8 + slot] = st_w[idx];
                TOKE[(size_t)m * 8 + slot] = e; TOKP[(size_t)m * 8 + slot] = pos;
            }
            }
            __syncthreads();
            CONV_B(n6items, 24960, gw, NGW);
        }
        SEAM(P0 + 7);


        for (int half = 0; half < 2; ++half) {
            const int PH = P0 + 10 + 3 * half;
            const int hbase = half * Mh;
#define BUILD_TAB(h_) do { __syncthreads(); if (wid == 0) { \
                    const int c = (int)__hip_atomic_load(ctl + CW_CNT + 16 * ((layer * 2 + (h_)) * 64 + lane), __ATOMIC_RELAXED, __HIP_MEMORY_SCOPE_AGENT); \
                    const int pad = (c + 255) & ~255; \
                    int inc = pad; \
                    _Pragma("unroll") for (int o = 1; o < 64; o <<= 1) { const int a = __shfl_up(inc, o); if (lane >= o) inc += a; } \
                    tab[lane] = c; tab[65 + lane] = inc - pad; \
                    if (lane == 63) { tab[64] = Mh; tab[65 + 64] = inc; } } \
                __syncthreads(); } while (0)
            if (IN(PH) || IN(PH + 1) || IN(PH + 2)) {
                PH_BEGIN
                BUILD_TAB(half);
            }
            if (IN(PH) && half == 0) {
                PH_BEGIN
                int rot = 0;
                for (int h2 = 0; h2 < 2; ++h2) {
                    if (h2) BUILD_TAB(1);
                    if (wid == 0) {
                        tab[130 + lane] = (tab[65 + lane] >> 8) * 2; if (lane == 63) { tab[130 + 64] = (tab[65 + 64] >> 8) * 2; tab[195] = ((tab[65 + 64] + Mh) >> 8) * 2; } }
                    __syncthreads();
                    pg8::MoeSched<2, true> S; S.Abase = (const char*)H8; S.Bbase = (const char*)WGU; S.bstride = (size_t)512 * 1024; S.K = 512; S.elist = ELIST + (size_t)h2 * 64 * CAP; S.tab = tab;
                    S.hbase = h2 * Mh; S.nU = tab[195]; S.G = G; S.c = (bx - rot + G) % G; S.NE = 65; S.ehint = 0;
                    EpiSwiGLU E{A2 + (size_t)h2 * A2_HALF};
                    pg8::gemm_phase<EpiSwiGLU, pg8::MoeSched<2, true>, true, 0x7C7C7C7C, 0x79797979>(lds, 512, S, E);
                    rot = (S.nU % G) & ~7;
                }
                BUILD_TAB(0);
            }
            if (half == 0) SEAM(PH);
            if (IN(PH + 1) && !DBG_H) {
                PH_BEGIN
                __syncthreads();
                if (wid == 0) { tab[130 + lane] = (tab[65 + lane] >> 8) * 4; if (lane == 63) { tab[194] = (tab[65 + 64] >> 8) * 4; tab[195] = (tab[65 + 64] >> 8) * 4; } }
                __syncthreads();
                {
                    pg8::MoeSched<4, false> S; S.Abase = (const char*)(A2 + (size_t)half * A2_HALF); S.Bbase = (const char*)WD; S.bstride = (size_t)1024 * 256; S.K = 128; S.elist = nullptr; S.tab = tab;
                    S.hbase = hbase; S.nU = tab[195]; S.G = G; S.c = bx; S.NE = 64; S.ehint = 0;
                    EpiY2 E{Y2};
                    pg8::gemm_phase<EpiY2, pg8::MoeSched<4, false>, true, 0x7D7D7D7D, 0x7A7A7A7A>(lds, 128, S, E);
                }
                {
                    const int rot2 = (tab[195] % G) & ~7;
                    pg8::DenseSched S; S.init(A2 + (size_t)half * A2_HALF + (size_t)tab[65 + 64] * 256, WD + (size_t)64 * 1024 * 256, Mh, 1024, 128, G, (bx - rot2 + G) % G);
                    EpiRes E{nullptr, nullptr, XS, modl + 5 * 1024, hbase};
                    pg8::gemm_phase<EpiRes, pg8::DenseSched, true, 0x7D7D7D7D, 0x7A7A7A7A>(lds, 128, S, E);
                }
            }
            SEAM(PH + 1);
            if (IN(PH + 2)) {
                PH_BEGIN
                for (int m = hbase + gw; m < hbase + Mh; m += NGW) {
                    bf16* xr = XS + (size_t)m * D;
                    const float* mv = modl + (m < ML ? (m >> 12) : 8) * 6144;
                    f32x4 v[4], s4[4];
#pragma unroll
                    for (int g2 = 0; g2 < 2; ++g2) { const u32x4 r = *(const u32x4*)(xr + g2 * 512 + 8 * lane);
                        v[2 * g2] = (f32x4){bflo(r.x), bfhi(r.x), bflo(r.y), bfhi(r.y)}; v[2 * g2 + 1] = (f32x4){bflo(r.z), bfhi(r.z), bflo(r.w), bfhi(r.w)}; s4[2 * g2] = s4[2 * g2 + 1] = (f32x4){0.f, 0.f, 0.f, 0.f}; }
                    u32x2 yv[8][2];
                    float tw[8];
#pragma unroll
                    for (int k = 0; k < 8; ++k) tw[k] = TOKW[(size_t)m * 8 + k];
#pragma unroll
                    for (int k = 0; k < 8; ++k) {
                        const int e = TOKE[(size_t)m * 8 + k], pos = TOKP[(size_t)m * 8 + k];
                        const fp8* yr = Y2 + (size_t)(tab[65 + e] + pos) * 1024 + 8 * lane;
                        yv[k][0] = *(const u32x2*)yr; yv[k][1] = *(const u32x2*)(yr + 512);
                    }
#pragma unroll
                    for (int k = 0; k < 8; ++k)
#pragma unroll
                        for (int g2 = 0; g2 < 2; ++g2) {
                            const f32x2 a = __builtin_amdgcn_cvt_pk_f32_fp8((int)yv[k][g2].x, false), b = __builtin_amdgcn_cvt_pk_f32_fp8((int)yv[k][g2].x, true);
                            const f32x2 c = __builtin_amdgcn_cvt_pk_f32_fp8((int)yv[k][g2].y, false), d = __builtin_amdgcn_cvt_pk_f32_fp8((int)yv[k][g2].y, true);
                            const float wk = tw[k];
                            s4[2 * g2][0] += wk * a[0]; s4[2 * g2][1] += wk * a[1]; s4[2 * g2][2] += wk * b[0]; s4[2 * g2][3] += wk * b[1];
                            s4[2 * g2 + 1][0] += wk * c[0]; s4[2 * g2 + 1][1] += wk * c[1]; s4[2 * g2 + 1][2] += wk * d[0]; s4[2 * g2 + 1][3] += wk * d[1];
                        }
#pragma unroll
                    for (int j = 0; j < 4; ++j) { const f32x4 m5 = *(const f32x4*)(mv + 5 * 1024 + (j >> 1) * 512 + 8 * lane + 4 * (j & 1)); v[j] = v[j] + m5 * (s4[j] * 0.0625f); }
                    const float rs = row_rstd(v);
                    if (layer == 0) {
                        const float* mn = mods + (size_t)9 * 6144 + (m < ML ? (m >> 12) : 8) * 6144;
                        const float* g = AIN(6) + D;
                        f32x4 gg4[4], sh4[4], sc4[4];
#pragma unroll
                        for (int j = 0; j < 4; ++j) { const int c = (j >> 1) * 512 + 8 * lane + 4 * (j & 1); gg4[j] = *(const f32x4*)(g + c); sh4[j] = *(const f32x4*)(mn + c); sc4[j] = *(const f32x4*)(mn + 1024 + c); }
#pragma unroll
                        for (int g2 = 0; g2 < 2; ++g2) { u32x4 w; w.x = pk2(v[2 * g2][0], v[2 * g2][1]); w.y = pk2(v[2 * g2][2], v[2 * g2][3]); w.z = pk2(v[2 * g2 + 1][0], v[2 * g2 + 1][1]); w.w = pk2(v[2 * g2 + 1][2], v[2 * g2 + 1][3]);
                            *(u32x4*)(xr + g2 * 512 + 8 * lane) = w; }
#pragma unroll
                        for (int g2 = 0; g2 < 2; ++g2) { u32x4 w; u32x2 w8;
#pragma unroll
                            for (int q = 0; q < 2; ++q) { const f32x4 gg = gg4[2 * g2 + q], sh = sh4[2 * g2 + q], sc = sc4[2 * g2 + q];
                                const f32x4 y = (v[2 * g2 + q] * rs * gg) * (sc + 1.f) + sh;
                                if (q == 0) { w.x = pk2(y[0], y[1]); w.y = pk2(y[2], y[3]); w8.x = pk4_fp8(y * 8.f); } else { w.z = pk2(y[0], y[1]); w.w = pk2(y[2], y[3]); w8.y = pk4_fp8(y * 8.f); } }
                            *(u32x4*)(HL + (size_t)m * D + g2 * 512 + 8 * lane) = w; *(u32x2*)(HL8 + (size_t)m * D + g2 * 512 + 8 * lane) = w8; }
                    } else {
                        f32x4 gf4[4];
#pragma unroll
                        for (int j = 0; j < 4; ++j) gf4[j] = *(const f32x4*)(AIN(29) + (j >> 1) * 512 + 8 * lane + 4 * (j & 1));
#pragma unroll
                        for (int j = 0; j < 4; ++j) { const int c = (j >> 1) * 512 + 8 * lane + 4 * (j & 1); *(f32x4*)(OUTF + (size_t)m * D + c) = v[j] * rs * gf4[j]; }
                    }
                }
                if (layer == 0 && half == 1) CONV_A(1);
            }
            SEAM(PH + 2);
        }
    }
    if (PROBE_MASK && bx == 0) { const unsigned long long t0 = __builtin_amdgcn_s_memrealtime(); while (__builtin_amdgcn_s_memrealtime() - t0 < 4ull * pr_acc) __builtin_amdgcn_s_sleep(8); }
}

#if DBG_AMP
__global__ void dbg_sum(const unsigned* buf, size_t nwords, unsigned long long* acc) {
    unsigned long long s = 0;
    for (size_t i = (size_t)blockIdx.x * blockDim.x + threadIdx.x; i < nwords; i += (size_t)gridDim.x * blockDim.x) s += (unsigned long long)buf[i] * (unsigned long long)(i * 2654435761ull + 12345ull);
    for (int o = 32; o > 0; o >>= 1) s += __shfl_xor(s, o);
    if ((threadIdx.x & 63) == 0) atomicAdd(acc, s);
}
__global__ void dbg_fill(float* o, size_t off, size_t n, const unsigned long long* acc, float weight) {
    const unsigned long long a = *acc;
    for (size_t i = (size_t)blockIdx.x * blockDim.x + threadIdx.x; i < n; i += (size_t)gridDim.x * blockDim.x) {
        unsigned long long h = (a + i) * 0x9E3779B97F4A7C15ull; h ^= h >> 29; h *= 0xBF58476D1CE4E5B9ull; h ^= h >> 32;
        o[off + i] = weight * (float)(h & 0xffffff) * (1.f / 16777216.f); }
}
#endif
extern "C" void kernel_launch(void* const* d_in, const int* in_sizes, int n_in, void* d_out, int out_size, void* d_ws, size_t ws_size, hipStream_t stream) {
    static int grid = 0;
    if (grid == 0) {
        if (n_in != 30 || out_size != ML * D || ws_size < WS_END) { fprintf(stderr, "kernel_launch: unexpected problem (n_in %d, out %d, ws %zu < %zu)\n", n_in, out_size, ws_size, (size_t)WS_END); grid = -1; return; }
        int dev = 0, cus = 0, per_cu = 0;
        if (hipGetDevice(&dev) != hipSuccess || hipDeviceGetAttribute(&cus, hipDeviceAttributeMultiprocessorCount, dev) != hipSuccess) { grid = -1; return; }
        if (hipFuncSetAttribute((const void*)fwd_kernel, hipFuncAttributeMaxDynamicSharedMemorySize, LDS_BYTES) != hipSuccess) { fprintf(stderr, "kernel_launch: hipFuncSetAttribute failed\n"); grid = -1; return; }
        if (hipOccupancyMaxActiveBlocksPerMultiprocessor(&per_cu, (const void*)fwd_kernel, 512, LDS_BYTES) != hipSuccess || per_cu < 1) fprintf(stderr, "kernel_launch: occupancy query reports %d\n", per_cu);
        (void)hipGetLastError();
        grid = cus;
        if (grid < 96 || (grid & 7)) { fprintf(stderr, "kernel_launch: %d CUs: this kernel's phase partition needs at least 96 workgroups in multiples of 8\n", grid); grid = -1; return; }
    }
    if (grid < 0) return;
    (void)hipMemsetAsync((char*)d_ws + WS_CTL, 0, 1 * MiB, stream);
    Args a{};
    for (int i = 0; i < 30; ++i) a.in[i] = (const GAS float*)d_in[i];
    a.out = (GAS float*)d_out; a.ws = (GAS unsigned char*)d_ws;
#if ONE_LAUNCH
    a.lo = 0; a.hi = NPHASE;
    hipLaunchKernelGGL(fwd_kernel, dim3(grid), dim3(512), LDS_BYTES, stream, a);
#else
#ifndef DBG_NPH
#define DBG_NPH NPHASE
#endif
    for (int p = 0; p < DBG_NPH; ++p) { a.lo = p; a.hi = p + 1; hipLaunchKernelGGL(fwd_kernel, dim3(grid), dim3(512), LDS_BYTES, stream, a); }
#if DBG_AMP
    {
        unsigned long long* accs = (unsigned long long*)((char*)d_ws + 2048);
        const size_t seg = (size_t)ML * D / 4;
        const size_t offs[4] = {DBG_B0, DBG_B1, DBG_B2, DBG_B3}; const size_t lens[4] = {DBG_L0, DBG_L1, DBG_L2, DBG_L3}; const float wts[4] = {1.f, 0.3f, 0.09f, 0.027f};
        for (int k = 0; k < 4; ++k) {
            hipLaunchKernelGGL(dbg_sum, dim3(2048), dim3(256), 0, stream, (const unsigned*)((char*)d_ws + offs[k]), lens[k] / 4, accs + k);
            hipLaunchKernelGGL(dbg_fill, dim3(2048), dim3(256), 0, stream, (float*)d_out, seg * k, seg, accs + k, wts[k]);
        }
    }
#endif
#endif
}
```
